# Optimizing an MI355X kernel written in HIP

```python
import math
import jax, jax.numpy as jnp
from jax import lax
import numpy as np

D_MODEL = 1024
BATCH = 8
SEQ = 4096
DEPTH = 2

BRANCH_WIDTH = 512
N_BRANCHES = 4
RET_HEADS = 4
RET_QK_DIM = 64
RET_V_DIM = 128
RET_CHUNK = 128
SWA_Q_HEADS = 8
SWA_KV_HEADS = 2
SWA_HEAD_DIM = 64
SWA_WINDOW = 128
SWA_BLOCK = 128
POOL_WINDOWS = (2, 4, 8, 16)
POOL_GROUP_DIM = BRANCH_WIDTH // 4
M_HEAD_DIM = 64
M_HEADS = BRANCH_WIDTH // M_HEAD_DIM
M_GROUPS = 2
M_STATE = 128
M_CONV = 4
M_CHUNK = 128
M_BC_W = M_GROUPS * M_STATE
M_CONV_DIM = BRANCH_WIDTH + 2 * M_BC_W
EPS = 1e-6

RET_QK_W = RET_HEADS * RET_QK_DIM
RET_V_W = RET_HEADS * RET_V_DIM
SWA_Q_W = SWA_Q_HEADS * SWA_HEAD_DIM
SWA_KV_W = SWA_KV_HEADS * SWA_HEAD_DIM
IN_SPLIT_SIZES = (RET_QK_W, RET_QK_W, RET_V_W, BRANCH_WIDTH,
                  SWA_Q_W, SWA_KV_W, SWA_KV_W, BRANCH_WIDTH,
                  BRANCH_WIDTH, BRANCH_WIDTH,
                  M_CONV_DIM, BRANCH_WIDTH, M_HEADS,
                  N_BRANCHES * D_MODEL)
D_IN = sum(IN_SPLIT_SIZES)

kernel_name = 'hybrid_gated_retention_swa_pool_ssd'


def _rms(x):
    xf = x.astype(jnp.float32)
    return xf * lax.rsqrt(jnp.mean(xf * xf, axis=-1, keepdims=True) + EPS)


def rms_norm(x, w):
    return (_rms(x) * w.astype(jnp.float32)).astype(x.dtype)


def alibi_slopes(n):
    return 2.0 ** (-8.0 * jnp.arange(1, n + 1, dtype=jnp.float32) / n)


def retention(q, k, v):
    b, s, h, dk = q.shape
    dv = v.shape[-1]
    L = RET_CHUNK
    nc = s // L
    log_g = jnp.log(1.0 - 2.0 ** (-5.0 - jnp.arange(h, dtype=jnp.float32)))
    pos = jnp.arange(L, dtype=jnp.float32)
    diff = pos[:, None] - pos[None, :]
    causal = diff >= 0
    inner_decay = jnp.where(causal, jnp.exp(log_g[:, None, None] * jnp.where(causal, diff, 0.0)), 0.0)
    q_decay = jnp.exp(log_g[:, None] * (pos + 1.0))
    k_decay = jnp.exp(log_g[:, None] * (L - 1.0 - pos))
    chunk_decay = jnp.exp(log_g * L)
    qc = q.reshape(b, nc, L, h, dk)
    kc = (k * dk ** -0.5).reshape(b, nc, L, h, dk)
    vc = v.reshape(b, nc, L, h, dv)
    scores = jnp.einsum('bclhd,bcshd->bchls', qc, kc) * inner_decay
    inner = jnp.einsum('bchls,bcshe->bclhe', scores, vc)

    def step(state, inp):
        q_i, k_i, v_i = inp
        cross = jnp.einsum('blhd,bhde,hl->blhe', q_i, state, q_decay)
        new = state * chunk_decay[None, :, None, None] + jnp.einsum('blhd,hl,blhe->bhde', k_i, k_decay, v_i)
        return new, cross

    init = jnp.zeros((b, h, dk, dv), jnp.float32)
    _, cross = lax.scan(step, init, (jnp.moveaxis(qc, 1, 0), jnp.moveaxis(kc, 1, 0), jnp.moveaxis(vc, 1, 0)))
    out = inner + jnp.moveaxis(cross, 0, 1)
    return out.reshape(b, s, h, dv)


def sliding_window_attention(q, k, v, sinks):
    b, s, hq, d = q.shape
    hkv = k.shape[2]
    g = hq // hkv
    L = SWA_BLOCK
    nb = s // L
    qb = (q * d ** -0.5).reshape(b, nb, L, hkv, g, d)

    def with_prev(t):
        tb = t.reshape(b, nb, L, hkv, d)
        prev = jnp.concatenate([jnp.zeros_like(tb[:, :1]), tb[:, :-1]], axis=1)
        return jnp.concatenate([prev, tb], axis=2)

    kb = with_prev(k)
    vb = with_prev(v)
    scores = jnp.einsum('bnqhgd,bnkhd->bnhgqk', qb, kb).astype(jnp.float32)
    qi = jnp.arange(L)
    kj = jnp.arange(2 * L)
    delta = L + qi[:, None] - kj[None, :]
    key_pos = (jnp.arange(nb)[:, None] - 1) * L + kj[None, :]
    valid = ((delta >= 0) & (delta < SWA_WINDOW))[None] & (key_pos >= 0)[:, None, :]
    slopes = alibi_slopes(hq).reshape(hkv, g)
    scores = scores - slopes[:, :, None, None] * delta.astype(jnp.float32)
    scores = jnp.where(valid[None, :, None, None], scores, -jnp.inf)
    sink = sinks.astype(jnp.float32).reshape(hkv, g)[None, None, :, :, None, None]
    m = jnp.maximum(scores.max(axis=-1, keepdims=True), sink)
    p = jnp.exp(scores - m)
    probs = p / (p.sum(axis=-1, keepdims=True) + jnp.exp(sink - m))
    out = jnp.einsum('bnhgqk,bnkhd->bnqhgd', probs.astype(v.dtype), vb)
    return out.reshape(b, s, hq * d)


def multiscale_pool(u, w_grp, scale):
    b, s, cdim = u.shape
    gd = cdim // len(POOL_WINDOWS)
    uf = u.astype(jnp.float32)
    cs = jnp.cumsum(uf, axis=1)
    t = jnp.arange(s)
    outs = []
    for i, w in enumerate(POOL_WINDOWS):
        cs_g = cs[..., i * gd:(i + 1) * gd]
        lag = jnp.pad(cs_g, ((0, 0), (w, 0), (0, 0)))[:, :s]
        count = jnp.minimum(t + 1, w).astype(jnp.float32)[None, :, None]
        outs.append((cs_g - lag) / count - uf[..., i * gd:(i + 1) * gd])
    diff = jnp.stack(outs, axis=2)
    y = jnp.einsum('bsgc,gce->bsge', diff, w_grp).reshape(b, s, cdim)
    return y * scale


def causal_depthwise_conv(u, w, bias):
    k, ch = w.shape
    out = lax.conv_general_dilated(u, w[:, None, :].astype(u.dtype), window_strides=(1,),
                                   padding=((k - 1, 0),), dimension_numbers=('NWC', 'WIO', 'NWC'),
                                   feature_group_count=ch)
    return out + bias


def ssd_scan(x, dt, a, bmat, cmat, d_skip):
    b, s, h, p = x.shape
    grp, n = bmat.shape[2], bmat.shape[3]
    r = h // grp
    L = M_CHUNK
    nc = s // L
    xc = x.reshape(b, nc, L, grp, r, p)
    dtc = dt.reshape(b, nc, L, grp, r)
    acs = jnp.cumsum(dtc * a.reshape(grp, r), axis=2)
    bc = bmat.reshape(b, nc, L, grp, n)
    cc = cmat.reshape(b, nc, L, grp, n)
    xdt = xc * dtc[..., None]
    acs_t = jnp.moveaxis(acs, 2, -1)
    causal = jnp.tril(jnp.ones((L, L), dtype=bool))
    seg = acs_t[..., :, None] - acs_t[..., None, :]
    lmat = jnp.exp(jnp.where(causal, seg, -jnp.inf))
    cb = jnp.einsum('bclgn,bcsgn->bcgls', cc, bc)
    y_diag = jnp.einsum('bcgls,bcgrls,bcsgrp->bclgrp', cb, lmat, xdt)
    decay_to_end = jnp.exp(acs[:, :, -1:] - acs)

    def step(state, inp):
        b_i, c_i, acs_i, dend_i, xdt_i = inp
        y_off = jnp.einsum('blgn,bgrpn,blgr->blgrp', c_i, state, jnp.exp(acs_i))
        new = state * jnp.exp(acs_i[:, -1])[..., None, None] + jnp.einsum('blgn,blgr,blgrp->bgrpn', b_i, dend_i, xdt_i)
        return new, y_off

    init = jnp.zeros((b, grp, r, p, n), jnp.float32)
    xs = (jnp.moveaxis(bc, 1, 0), jnp.moveaxis(cc, 1, 0), jnp.moveaxis(acs, 1, 0),
          jnp.moveaxis(decay_to_end, 1, 0), jnp.moveaxis(xdt, 1, 0))
    _, y_off = lax.scan(step, init, xs)
    y = y_diag + jnp.moveaxis(y_off, 0, 1) + xc * d_skip.reshape(grp, r)[:, :, None]
    return y.reshape(b, s, h * p)


def hybrid_layer(x, c, ada_w, ada_b, norm_w, w_in, sinks, pool_w, pool_scale,
                 conv_w, conv_b, dt_bias, a_log, d_skip, ssm_norm_w, w_up, w_out):
    b, s, _ = x.shape
    mod = jnp.einsum('bd,de->be', jax.nn.silu(c), ada_w) + ada_b
    shift, scale, gate = jnp.split(mod, 3, axis=-1)
    h = rms_norm(x, norm_w) * (1.0 + scale[:, None, :]) + shift[:, None, :]
    proj = jnp.einsum('bsd,de->bse', h, w_in)
    offsets = np.cumsum(IN_SPLIT_SIZES)[:-1].tolist()
    (rq, rk, rv, rg, sq, sk, sv, sg, px, pg, mxbc, mz, mdt, mg) = jnp.split(proj, offsets, axis=-1)

    ret = retention(rq.reshape(b, s, RET_HEADS, RET_QK_DIM), rk.reshape(b, s, RET_HEADS, RET_QK_DIM),
                    rv.reshape(b, s, RET_HEADS, RET_V_DIM))
    ret = _rms(ret).reshape(b, s, BRANCH_WIDTH) * jax.nn.silu(rg.astype(jnp.float32))

    att = sliding_window_attention(sq.reshape(b, s, SWA_Q_HEADS, SWA_HEAD_DIM),
                                   sk.reshape(b, s, SWA_KV_HEADS, SWA_HEAD_DIM),
                                   sv.reshape(b, s, SWA_KV_HEADS, SWA_HEAD_DIM), sinks)
    att = att * jax.nn.silu(sg)

    pool = multiscale_pool(px, pool_w, pool_scale) * jax.nn.silu(pg.astype(jnp.float32))

    xbc = jax.nn.silu(causal_depthwise_conv(mxbc, conv_w, conv_b))
    mx, mb, mc = jnp.split(xbc, [BRANCH_WIDTH, BRANCH_WIDTH + M_BC_W], axis=-1)
    dt = jax.nn.softplus(mdt.astype(jnp.float32) + dt_bias.astype(jnp.float32))
    a = -jnp.exp(a_log.astype(jnp.float32))
    y = ssd_scan(mx.reshape(b, s, M_HEADS, M_HEAD_DIM), dt, a,
                 mb.reshape(b, s, M_GROUPS, M_STATE), mc.reshape(b, s, M_GROUPS, M_STATE), d_skip)
    yz = (y * jax.nn.silu(mz.astype(jnp.float32))).reshape(b, s, M_GROUPS, BRANCH_WIDTH // M_GROUPS)
    ssm = _rms(yz).reshape(b, s, BRANCH_WIDTH) * ssm_norm_w.astype(jnp.float32)

    branches = jnp.stack([ret.astype(x.dtype), att.astype(x.dtype), pool.astype(x.dtype), ssm.astype(x.dtype)], axis=2)
    up = jnp.einsum('bsne,ned->bsnd', branches, w_up)
    gates = jax.nn.sigmoid(mg.astype(jnp.float32)).reshape(b, s, N_BRANCHES, D_MODEL)
    merged = jnp.sum(gates * up, axis=2).astype(x.dtype)
    out = jnp.einsum('bsd,de->bse', merged, w_out)
    return x + gate[:, None, :] * out


def setup_inputs(seed: int = 0) -> dict:
    key = jax.random.key(seed)
    ks = jax.random.split(key, 20)
    f32 = jnp.float32
    gd = POOL_GROUP_DIM
    dt_u = jax.random.uniform(ks[11], (DEPTH, M_HEADS), f32)
    dt0 = jnp.exp(dt_u * (math.log(0.1) - math.log(0.001)) + math.log(0.001))
    return {
        'x': jax.random.normal(ks[0], (BATCH, SEQ, D_MODEL), f32),
        'c': jax.random.normal(ks[1], (BATCH, D_MODEL), f32),
        'ada_w': jax.random.normal(ks[2], (DEPTH, D_MODEL, 3 * D_MODEL), f32) * D_MODEL ** -0.5,
        'ada_b': jax.random.normal(ks[3], (DEPTH, 3 * D_MODEL), f32) * 0.02,
        'norm_w': 1.0 + 0.02 * jax.random.normal(ks[4], (DEPTH, D_MODEL), f32),
        'w_in': jax.random.normal(ks[5], (DEPTH, D_MODEL, D_IN), f32) * D_MODEL ** -0.5,
        'swa_sinks': jax.random.normal(ks[6], (DEPTH, SWA_Q_HEADS), f32),
        'pool_w': jax.random.normal(ks[7], (DEPTH, len(POOL_WINDOWS), gd, gd), f32) * gd ** -0.5,
        'pool_scale': 1.0 + 0.02 * jax.random.normal(ks[8], (DEPTH, BRANCH_WIDTH), f32),
        'conv_w': jax.random.normal(ks[9], (DEPTH, M_CONV, M_CONV_DIM), f32) * M_CONV ** -0.5,
        'conv_b': jax.random.normal(ks[10], (DEPTH, M_CONV_DIM), f32) * 0.02,
        'dt_bias': dt0 + jnp.log(-jnp.expm1(-dt0)),
        'a_log': jnp.log(jax.random.uniform(ks[12], (DEPTH, M_HEADS), f32, minval=1.0, maxval=16.0)),
        'd_skip': 1.0 + 0.02 * jax.random.normal(ks[13], (DEPTH, M_HEADS), f32),
        'ssm_norm_w': 1.0 + 0.02 * jax.random.normal(ks[14], (DEPTH, BRANCH_WIDTH), f32),
        'w_up': jax.random.normal(ks[15], (DEPTH, N_BRANCHES, BRANCH_WIDTH, D_MODEL), f32) * BRANCH_WIDTH ** -0.5,
        'w_out': jax.random.normal(ks[16], (DEPTH, D_MODEL, D_MODEL), f32) * D_MODEL ** -0.5,
        'final_norm_w': 1.0 + 0.02 * jax.random.normal(ks[17], (D_MODEL,), f32),
    }


def reference(x, c, ada_w, ada_b, norm_w, w_in, swa_sinks, pool_w, pool_scale, conv_w, conv_b,
              dt_bias, a_log, d_skip, ssm_norm_w, w_up, w_out, final_norm_w):
    for l in range(DEPTH):
        x = hybrid_layer(x, c, ada_w[l], ada_b[l], norm_w[l], w_in[l], swa_sinks[l], pool_w[l],
                         pool_scale[l], conv_w[l], conv_b[l], dt_bias[l], a_log[l], d_skip[l],
                         ssm_norm_w[l], w_up[l], w_out[l])
    return rms_norm(x, final_norm_w)
```

```cpp
#include <hip/hip_runtime.h>
#include <hip/hip_cooperative_groups.h>
#include <cstdio>
#include <cstdint>
namespace cg = cooperative_groups;

#define LAS __attribute__((address_space(3)))
#define DI __device__ __forceinline__
typedef unsigned short bf16;
typedef short bf16x8 __attribute__((ext_vector_type(8)));
typedef short s16x4 __attribute__((ext_vector_type(4)));
typedef short v4i16_t __attribute__((ext_vector_type(4)));
typedef float f32x2 __attribute__((ext_vector_type(2)));
typedef float f32x4 __attribute__((ext_vector_type(4)));
typedef float f32x16 __attribute__((ext_vector_type(16)));
typedef unsigned u32x2 __attribute__((ext_vector_type(2)));
typedef unsigned u32x4 __attribute__((ext_vector_type(4)));
typedef __bf16 bf2_t __attribute__((ext_vector_type(2)));
typedef int v4i_t __attribute__((ext_vector_type(4)));
typedef int v8i_t __attribute__((ext_vector_type(8)));

constexpr int BATCH = 8, SEQ = 4096, T = BATCH * SEQ, D = 1024, DIN = 9480, LDP = 5376;
constexpr float EPS = 1e-6f;
constexpr int TP = 256;
constexpr size_t TS = (size_t)T * 256;
constexpr int C_RG = 0, C_SG = 512, C_PG = 1024, C_MZ = 1536, C_RQ = 2048, C_RK = 2304, C_RV = 2560, C_SQ = 3072, C_SK = 3584, C_SV = 3712, C_PX = 3840, C_MX = 4352;
constexpr int S_RQ = 0, S_RK = 256, S_RV = 512, S_RG = 1024, S_SQ = 1536, S_SK = 2048, S_SV = 2176, S_SG = 2304, S_PX = 2816, S_PG = 3328, S_MX = 3840, S_MZ = 4864, S_DT = 5376, S_MG = 5384;
constexpr int WIN_ROWS = 9472;

constexpr size_t MiB = 1u << 20;
constexpr size_t WS_CTL = 0, CTL_BYTES = 64 * 1024;
constexpr size_t WS_MOD = 1 * MiB;
constexpr size_t WS_DT = 2 * MiB;
constexpr size_t WS_CD = 3 * MiB;
constexpr size_t WS_WIN = 4 * MiB;
constexpr size_t WIN_L = (size_t)WIN_ROWS * 1024;
constexpr size_t WS_WUP = 41 * MiB;
constexpr size_t WS_WOUT = 49 * MiB;
constexpr size_t WS_POOL = 53 * MiB;
constexpr size_t WS_H = 54 * MiB;
constexpr size_t WS_PROJ = 118 * MiB;
constexpr size_t WS_EXT = 454 * MiB;
constexpr size_t WS_WMG8 = 502 * MiB;
constexpr size_t WS_SW = 510 * MiB;
constexpr size_t WS_SH = 510 * MiB + 65536;
constexpr size_t WS_END = 511 * MiB;
constexpr size_t ST_RET = 0, ST_SSD = 16 * MiB;

constexpr int LDS_BYTES = 163840;

DI unsigned pk2(float lo, float hi) { f32x2 v = {lo, hi}; bf2_t b = __builtin_convertvector(v, bf2_t); return __builtin_bit_cast(unsigned, b); }
DI float bflo(unsigned u) { return __uint_as_float(u << 16); }
DI float bfhi(unsigned u) { return __uint_as_float(u & 0xffff0000u); }
DI float bf2f(bf16 v) { return __uint_as_float(((unsigned)v) << 16); }
DI unsigned pk4_i8(float a, float b, float c, float d) {
    const int ia = (int)rintf(fminf(fmaxf(a, -127.f), 127.f)), ib = (int)rintf(fminf(fmaxf(b, -127.f), 127.f)), ic = (int)rintf(fminf(fmaxf(c, -127.f), 127.f)), id = (int)rintf(fminf(fmaxf(d, -127.f), 127.f));
    return (unsigned)(ia & 255) | ((unsigned)(ib & 255) << 8) | ((unsigned)(ic & 255) << 16) | ((unsigned)id << 24);
}
DI float silu_f(float x) { return x * __builtin_amdgcn_rcpf(1.f + __expf(-x)); }
DI float sigm_f(float x) { return __builtin_amdgcn_rcpf(1.f + __expf(-x)); }
DI float lane_xor(float v, int o, int lane) { return __int_as_float(__builtin_amdgcn_ds_bpermute((lane ^ o) << 2, __float_as_int(v))); }
DI float lane_up(float v, int o, int lane) { const int src = lane >= o ? lane - o : lane; return __int_as_float(__builtin_amdgcn_ds_bpermute(src << 2, __float_as_int(v))); }
DI float wave_sum(float v, int lane) {
#pragma unroll
    for (int o = 1; o < 64; o <<= 1) v += lane_xor(v, o, lane);
    return v;
}
DI bf16* pcol(bf16* proj, int c) { return proj + (size_t)(c >> 8) * TS + (c & 255); }
DI const bf16* pcol(const bf16* proj, int c) { return proj + (size_t)(c >> 8) * TS + (c & 255); }
DI int crow(int r, int h) { return (r & 3) + 8 * (r >> 2) + 4 * h; }
#define MFMA32(a, b, c) __builtin_amdgcn_mfma_f32_32x32x16_bf16((a), (b), (c), 0, 0, 0)
DI bf16x8 pack8(float a0, float a1, float a2, float a3, float a4, float a5, float a6, float a7) {
    u32x4 p; p.x = pk2(a0, a1); p.y = pk2(a2, a3); p.z = pk2(a4, a5); p.w = pk2(a6, a7); return __builtin_bit_cast(bf16x8, p);
}
DI u32x4 zero4() { unsigned z = 0u; asm volatile("" : "+v"(z)); return (u32x4){z, z, z, z}; }
DI s16x4 trr(const LAS unsigned char* p) { return __builtin_bit_cast(s16x4, __builtin_amdgcn_ds_read_tr16_b64_v4i16((LAS v4i16_t*)p)); }
DI bf16x8 tr_frag(const LAS unsigned char* img, int stride, int klo, int khi, int col0, int lane) {
    const int i16 = lane & 15, q = i16 >> 2, p = i16 & 3, blk = (lane >> 4) & 1;
    const LAS unsigned char* a = img + q * stride + (col0 + 16 * blk + 4 * p) * 2;
    const s16x4 lo = trr(a + klo * stride), hi = trr(a + khi * stride);
    return (bf16x8){lo[0], lo[1], lo[2], lo[3], hi[0], hi[1], hi[2], hi[3]};
}
DI u32x4 gate8(u32x4 ov, u32x4 gv) {
    u32x4 r;
    r.x = pk2(bflo(ov.x) * bflo(gv.x), bfhi(ov.x) * bfhi(gv.x)); r.y = pk2(bflo(ov.y) * bflo(gv.y), bfhi(ov.y) * bfhi(gv.y));
    r.z = pk2(bflo(ov.z) * bflo(gv.z), bfhi(ov.z) * bfhi(gv.z)); r.w = pk2(bflo(ov.w) * bflo(gv.w), bfhi(ov.w) * bfhi(gv.w));
    return r;
}
DI void unpack8(u32x4 w, float* f) { f[0] = bflo(w.x); f[1] = bfhi(w.x); f[2] = bflo(w.y); f[3] = bfhi(w.y); f[4] = bflo(w.z); f[5] = bfhi(w.z); f[6] = bflo(w.w); f[7] = bfhi(w.w); }

namespace pg8 {
constexpr int BM = 256, BK = 64, HALF = 128, HTB = HALF * BK * 2, STAGE_BYTES = 8 * HTB, NXCD = 8, WGM = 8;
__host__ __device__ __forceinline__ int lds_byte(int r, int c) { const int st = (r >> 4) * 2 + (c >> 5), rr = r & 15, cc = c & 31, ob = rr * 64 + cc * 2; return st * 1024 + (ob ^ (((ob >> 9) & 1) << 5)); }
__host__ __device__ __forceinline__ void stage_rc(int b, int& R, int& C) { const int st = b / 1024, sb = b % 1024, swz = sb ^ (((sb >> 9) & 1) << 5); R = (st >> 1) * 16 + swz / 64; C = (st & 1) * 32 + (swz % 64) / 2; }
__host__ __device__ __forceinline__ int perm32(int rho) { const int n = rho >> 4, i = rho & 15; return 8 * (i >> 2) + 4 * n + (i & 3); }

struct Unit { int pm, pn; };
template <int LDA_, int LDB_, int K_, int NM_, int NN_, int ASH_, long long AGS_, long long AKTS_, bool FP8_ = false> struct Gemm { const bf16* A; const bf16* Bt; static constexpr bool fp8 = FP8_; static constexpr int lda = LDA_, ldb = LDB_, K = K_, nM = NM_, nN = NN_, a_shift = ASH_; static constexpr long long a_gstride = AGS_, a_kts = AKTS_; };

template <int nM, int nN> struct StaticOrder {
    static constexpr int nwg = nM * nN; int G, c;
    __device__ void init(int G_, int c_) { G = G_; c = c_; }
    __device__ bool next(int i, Unit& u) const {
        const long L = (long)i * G + c; if (L >= nwg) return false;
        int wgid = (int)L; { const int q = nwg / NXCD, r = nwg % NXCD, xcd = wgid % NXCD, off = wgid / NXCD; wgid = (xcd < r ? xcd * (q + 1) : r * (q + 1) + (xcd - r) * q) + off; }
        const int nig = WGM * nN, gid = wgid / nig, fm = gid * WGM, gsz = (nM - fm) < WGM ? (nM - fm) : WGM;
        u.pm = fm + ((wgid % nig) % gsz); u.pn = (wgid % nig) / gsz; return true;
    }
};

template <class GemmT, class Epi>
__device__ __forceinline__ void gemm_phase(LAS unsigned char* lds, const GemmT g, int G_, int c_, const Epi& E, const int tid) {
    StaticOrder<GemmT::nM, GemmT::nN> S; S.init(G_, c_);
    const int wid = __builtin_amdgcn_readfirstlane(tid >> 6), lane = tid & 63, wr = wid >> 2, wc = wid & 3, fr = lane & 15, fq = lane >> 4;
    constexpr int nt = GemmT::K / BK;
    unsigned voffA[2], voffB[2];
#pragma unroll
    for (int i = 0; i < 2; ++i) { int R, C; stage_rc(tid * 16 + i * 8192, R, C); const int Rb = Epi::PERM ? ((R & ~31) + perm32(R & 31)) : R;
        voffA[i] = (unsigned)(R * g.lda + C) * 2u; voffB[i] = (unsigned)(Rb * g.ldb + C) * 2u; }
    const size_t kstep = (size_t)(BK * 2);
    const size_t hstepA = (size_t)HALF * g.lda * 2, hstepB = (size_t)HALF * g.ldb * 2;
    const unsigned ldsw = (unsigned)wid * 1024u;
    const int aoff = lds_byte(wr * 64 + fr, fq * 8), boff = lds_byte(wc * 32 + fr, fq * 8);
#define PG8_SA(b, h) (((b) * 2 + (h)) * HTB)
#define PG8_SB(b, h) ((4 + (b) * 2 + (h)) * HTB)
#define PG8_STAGE(bufoff, gbase, voff) do { _Pragma("unroll") for (int _i = 0; _i < 2; ++_i) \
        __builtin_amdgcn_global_load_lds((const unsigned*)((const char*)(gbase) + (voff)[_i]), (LAS unsigned*)(lds + (bufoff) + ldsw + _i * 8192), 16, 0, 0); } while (0)
#define PG8_LDA(dst, b, h) do { _Pragma("unroll") for (int m = 0; m < 4; ++m) _Pragma("unroll") for (int k = 0; k < 2; ++k) dst[m][k] = *(const LAS bf16x8*)(lds + PG8_SA(b, h) + aoff + m * 2048 + k * 1024); } while (0)
#define PG8_LDB(dst, b, h) do { _Pragma("unroll") for (int n = 0; n < 2; ++n) _Pragma("unroll") for (int k = 0; k < 2; ++k) dst[n][k] = *(const LAS bf16x8*)(lds + PG8_SB(b, h) + boff + n * 2048 + k * 1024); } while (0)
#define PG8_CAT8(x0, x1) __builtin_shufflevector(__builtin_bit_cast(v4i_t, (x0)), __builtin_bit_cast(v4i_t, (x1)), 0, 1, 2, 3, 4, 5, 6, 7)
#define PG8_MMA(ai, bj, At, Bt) do { __builtin_amdgcn_s_setprio(1); _Pragma("unroll") for (int m = 0; m < 4; ++m) _Pragma("unroll") for (int n = 0; n < 2; ++n) { \
        if constexpr (GemmT::fp8) { _Pragma("unroll") for (int k = 0; k < 2; ++k) acc[ai][bj][m][n] = __builtin_bit_cast(f32x4, __builtin_amdgcn_mfma_i32_16x16x64_i8(__builtin_bit_cast(v4i_t, Bt[n][k]), __builtin_bit_cast(v4i_t, At[m][k]), __builtin_bit_cast(v4i_t, acc[ai][bj][m][n]), 0, 0, 0)); } \
        else { _Pragma("unroll") for (int k = 0; k < 2; ++k) acc[ai][bj][m][n] = __builtin_amdgcn_mfma_f32_16x16x32_bf16(Bt[n][k], At[m][k], acc[ai][bj][m][n], 0, 0, 0); } } \
        __builtin_amdgcn_s_setprio(0); } while (0)
#define PG8_WAIT_V(n) asm volatile("s_waitcnt vmcnt(" #n ")" ::: "memory")
#define PG8_WAIT_L(n) asm volatile("s_waitcnt lgkmcnt(" #n ")" ::: "memory")
#define PG8_BAR __builtin_amdgcn_s_barrier()
#define PG8_SCHED __builtin_amdgcn_sched_barrier(0)
#define PG8_APTR(u) ((const char*)g.A + 2 * ((size_t)(u).pm * 256 * g.lda + (size_t)((u).pn >> g.a_shift) * g.a_gstride))
#define PG8_BPTR(u) ((const char*)g.Bt + 2 * ((size_t)(u).pn * 256 * g.ldb))
    Unit cur, nxt; int ui = 0;
    if (!S.next(0, cur)) return;
    f32x4 acc[2][2][4][2];
#pragma unroll
    for (int a = 0; a < 2; ++a)
#pragma unroll
        for (int b = 0; b < 2; ++b)
#pragma unroll
            for (int m = 0; m < 4; ++m)
#pragma unroll
                for (int n = 0; n < 2; ++n) acc[a][b][m][n] = (f32x4){0.f, 0.f, 0.f, 0.f};
    bf16x8 At[4][2], B0[2][2], B1[2][2];
    unsigned pf0 = 0u, pf1 = 0u;
    const char* cA = PG8_APTR(cur); const char* cB = PG8_BPTR(cur);
    PG8_STAGE(PG8_SB(0, 0), cB, voffB); PG8_STAGE(PG8_SB(0, 1), cB + hstepB, voffB); PG8_STAGE(PG8_SA(0, 0), cA, voffA); PG8_STAGE(PG8_SA(0, 1), cA + hstepA, voffA);
    if (wr == 1) PG8_BAR;
    PG8_WAIT_V(2); PG8_BAR;
    PG8_STAGE(PG8_SB(1, 0), cB + kstep, voffB); PG8_STAGE(PG8_SA(1, 0), cA + kstep, voffA); PG8_STAGE(PG8_SB(1, 1), cB + hstepB + kstep, voffB);
    PG8_WAIT_V(6); PG8_BAR;
    for (;;) {
        const bool has_next = S.next(ui + 1, nxt);
        const char* nA = has_next ? PG8_APTR(nxt) : cA; const char* nB = has_next ? PG8_BPTR(nxt) : cB;
        constexpr int tseg = Epi::HOOK ? 8 : nt;
#pragma nounroll
        for (int t0 = 0; t0 < nt; t0 += tseg) {
        if constexpr (Epi::HOOK) { if (t0 != 0) { E.hook(acc, cur, (t0 >> 3) - 1, wr, wc, lane); asm volatile("" :: "v"(pf0), "v"(pf1)); } E.prefetch(cur, t0 >> 3, wr, wc, lane, pf0, pf1); }
#pragma nounroll
        for (int t = t0; t < t0 + tseg; t += 2) {
            const bool last = (t == nt - 2);
            const char* a1 = cA + (size_t)(t >> 2) * GemmT::a_kts + (size_t)((t & 3) + 1) * kstep;
            const char* a2 = last ? nA : cA + (size_t)((t + 2) >> 2) * GemmT::a_kts + (size_t)((t + 2) & 3) * kstep; const char* b2 = last ? nB : cB + (size_t)(t + 2) * kstep;
            const char* a3 = a2 + kstep; const char* b3 = b2 + kstep;
            PG8_LDB(B0, 0, 0); PG8_LDB(B1, 0, 1); PG8_SCHED; PG8_LDA(At, 0, 0); PG8_STAGE(PG8_SA(1, 1), a1 + hstepA, voffA);
            PG8_WAIT_V(8); PG8_WAIT_L(0); PG8_BAR; PG8_MMA(0, 0, At, B0); PG8_MMA(0, 1, At, B1); PG8_BAR; PG8_SCHED;
            PG8_LDA(At, 0, 1); PG8_STAGE(PG8_SB(0, 0), b2, voffB); PG8_STAGE(PG8_SB(0, 1), b2 + hstepB, voffB); PG8_STAGE(PG8_SA(0, 0), a2, voffA);
            PG8_WAIT_V(8); PG8_WAIT_L(0); PG8_BAR; PG8_MMA(1, 0, At, B0); PG8_MMA(1, 1, At, B1); PG8_BAR; PG8_SCHED;
            PG8_LDB(B0, 1, 0); PG8_LDB(B1, 1, 1); PG8_SCHED; PG8_LDA(At, 1, 0); PG8_STAGE(PG8_SA(0, 1), a2 + hstepA, voffA);
            PG8_WAIT_V(8); PG8_WAIT_L(0); PG8_BAR; PG8_MMA(0, 0, At, B0); PG8_MMA(0, 1, At, B1); PG8_BAR; PG8_SCHED;
            PG8_LDA(At, 1, 1); PG8_STAGE(PG8_SB(1, 0), b3, voffB); PG8_STAGE(PG8_SB(1, 1), b3 + hstepB, voffB); PG8_STAGE(PG8_SA(1, 0), a3, voffA);
            PG8_WAIT_V(8); PG8_WAIT_L(0); PG8_BAR; PG8_MMA(1, 0, At, B0); PG8_MMA(1, 1, At, B1); PG8_BAR; PG8_SCHED;
        }
        }
        if (wr == 0) PG8_BAR;
        { int le = lane; asm volatile("" : "+v"(le)); E(acc, cur, wr, wc, le & 15, le >> 4); if constexpr (Epi::HOOK) asm volatile("" :: "v"(pf0), "v"(pf1)); }
        if (!has_next) break;
#pragma unroll
        for (int a = 0; a < 2; ++a)
#pragma unroll
            for (int b = 0; b < 2; ++b)
#pragma unroll
                for (int m = 0; m < 4; ++m)
#pragma unroll
                    for (int n = 0; n < 2; ++n) acc[a][b][m][n] = (f32x4){0.f, 0.f, 0.f, 0.f};
        cur = nxt; cA = nA; cB = nB; ++ui;
        if (wr == 1) PG8_BAR;
    }
    PG8_WAIT_V(0);
    PG8_BAR;
#undef PG8_SA
#undef PG8_SB
#undef PG8_STAGE
#undef PG8_LDA
#undef PG8_LDB
#undef PG8_MMA
#undef PG8_CAT8
#undef PG8_WAIT_V
#undef PG8_WAIT_L
#undef PG8_BAR
#undef PG8_SCHED
#undef PG8_APTR
#undef PG8_BPTR
}

struct EpiProj {
    static constexpr bool PERM = true, HOOK = false;
    DI void hook(f32x4 (&)[2][2][4][2], const Unit&, int, int, int, int) const {}
    DI void prefetch(const Unit&, int, int, int, int, unsigned&, unsigned&) const {}
    bf16* O; int ldc;
    DI void operator()(const f32x4 (&acc)[2][2][4][2], const Unit& u, int wr, int wc, int fr, int fq) const {
        const int row0 = u.pm * BM + wr * 64 + fr, col0 = wc * 32 + 8 * fq;
        bf16* Ot = O + (size_t)u.pn * TS;
#pragma unroll
        for (int ai = 0; ai < 2; ++ai)
#pragma unroll
            for (int m = 0; m < 4; ++m) { bf16* rowp = Ot + (size_t)(row0 + ai * HALF + m * 16) * ldc + col0;
#pragma unroll
                for (int bj = 0; bj < 2; ++bj) { f32x4 v0 = acc[ai][bj][m][0], v1 = acc[ai][bj][m][1];
                    if (u.pn < 8) {
#pragma unroll
                        for (int j = 0; j < 4; ++j) { v0[j] = silu_f(v0[j]); v1[j] = silu_f(v1[j]); } }
                    u32x4 w; w.x = pk2(v0[0], v0[1]); w.y = pk2(v0[2], v0[3]); w.z = pk2(v1[0], v1[1]); w.w = pk2(v1[2], v1[3]);
                    __builtin_nontemporal_store(w, (u32x4*)(rowp + bj * HALF)); } }
    }
};
DI size_t r_off(int k, int pm, int dq, int ai, int bj, int m, int wr, int wc, int lane, int n) {
    return ((((((((((size_t)k * 128 + pm) * 4 + dq) * 2 + ai) * 2 + bj) * 4 + m) * 2 + wr) * 4 + wc) * 64 + lane) * 8) + n * 4;
}
struct EpiGate {
    static constexpr bool PERM = false, HOOK = false;
    bf16* R; const float* sH; const float* sW;
    DI void operator()(const f32x4 (&acc)[2][2][4][2], const Unit& u, int wr, int wcp, int fr, int fq) const {
        const int lane = fq * 16 + fr, dq = u.pn >> 2, bj = (u.pn >> 1) & 1, wc = 2 * (u.pn & 1) + (wcp >> 1), n = wcp & 1;
        f32x4 cs[4];
#pragma unroll
        for (int i = 0; i < 4; ++i) cs[i] = *(const f32x4*)(sW + u.pn * BM + (i >> 1) * HALF + wcp * 32 + (i & 1) * 16 + 4 * fq);
#pragma unroll
        for (int ai = 0; ai < 2; ++ai)
#pragma unroll
            for (int m = 0; m < 4; ++m) {
                const float rs = sH[u.pm * BM + ai * HALF + wr * 64 + m * 16 + fr];
                float e[4][4];
#pragma unroll
                for (int i = 0; i < 4; ++i)
#pragma unroll
                    for (int j = 0; j < 4; ++j) { const float gq = (float)__float_as_int(acc[ai][i >> 1][m][i & 1][j]) * rs * cs[i][j]; e[i][j] = 1.f + __expf(-fminf(fmaxf(gq, -30.f), 30.f)); }
#pragma unroll
                for (int k = 0; k < 4; ++k) { float r[4];
#pragma unroll
                    for (int j = 0; j < 4; ++j) r[j] = k < 3 ? e[k + 1][j] * __builtin_amdgcn_rcpf(e[k][j]) : __builtin_amdgcn_rcpf(e[3][j]);
                    u32x2 w; w.x = pk2(r[0], r[1]); w.y = pk2(r[2], r[3]);
                    __builtin_nontemporal_store(w, (u32x2*)(R + r_off(k, u.pm, dq, ai, bj, m, wr, wc, lane, n))); }
            }
    }
    DI void hook(f32x4 (&)[2][2][4][2], const Unit&, int, int, int, int) const {}
    DI void prefetch(const Unit&, int, int, int, int, unsigned&, unsigned&) const {}
};
struct EpiMergeUp {
    static constexpr bool PERM = true, HOOK = true;
    const bf16* R; bf16* O;
    DI void scale(f32x4 (&acc)[2][2][4][2], const Unit& u, int k, int wr, int wc, int lane) const {
        asm volatile("" : "+v"(lane));
        const bf16* base = R + r_off(k, u.pm, u.pn, 0, 0, 0, wr, wc, lane, 0);
#pragma unroll
        for (int ai = 0; ai < 2; ++ai) {
            u32x4 v[2][4];
#pragma unroll
            for (int bj = 0; bj < 2; ++bj)
#pragma unroll
                for (int m = 0; m < 4; ++m) v[bj][m] = *(const u32x4*)(base + (size_t)((ai * 2 + bj) * 4 + m) * 4096);
#pragma unroll
            for (int bj = 0; bj < 2; ++bj)
#pragma unroll
                for (int m = 0; m < 4; ++m) { const u32x4 w = v[bj][m];
                    acc[ai][bj][m][0] *= (f32x4){bflo(w.x), bfhi(w.x), bflo(w.y), bfhi(w.y)}; acc[ai][bj][m][1] *= (f32x4){bflo(w.z), bfhi(w.z), bflo(w.w), bfhi(w.w)}; }
            __builtin_amdgcn_sched_barrier(0);
        }
    }
    DI void hook(f32x4 (&acc)[2][2][4][2], const Unit& u, int k, int wr, int wc, int lane) const { scale(acc, u, k, wr, wc, lane); }
    DI void prefetch(const Unit& u, int k, int wr, int wc, int lane, unsigned& p0, unsigned& p1) const {
        asm volatile("" : "+v"(lane));
        const char* b = (const char*)(R + r_off(k, u.pm, u.pn, 0, 0, 0, wr, wc, 0, 0)) + (lane >> 3) * 8192 + (lane & 7) * 128;
        p0 = *(const unsigned*)b; p1 = *(const unsigned*)(b + 8 * 8192);
    }
    DI void operator()(f32x4 (&acc)[2][2][4][2], const Unit& u, int wr, int wc, int fr, int fq) const {
        scale(acc, u, 3, wr, wc, fq * 16 + fr);
        const int row0 = u.pm * BM + wr * 64 + fr, col0 = wc * 32 + 8 * fq;
        bf16* Ot = O + (size_t)u.pn * TS;
#pragma unroll
        for (int ai = 0; ai < 2; ++ai)
#pragma unroll
            for (int m = 0; m < 4; ++m) { bf16* rowp = Ot + (size_t)(row0 + ai * HALF + m * 16) * TP + col0;
#pragma unroll
                for (int bj = 0; bj < 2; ++bj) { const f32x4 v0 = acc[ai][bj][m][0], v1 = acc[ai][bj][m][1];
                    u32x4 w; w.x = pk2(v0[0], v0[1]); w.y = pk2(v0[2], v0[3]); w.z = pk2(v1[0], v1[1]); w.w = pk2(v1[2], v1[3]);
                    __builtin_nontemporal_store(w, (u32x4*)(rowp + bj * HALF)); } }
    }
};
template <bool IN_BF16> struct EpiOut {
    static constexpr bool PERM = true, HOOK = false;
    DI void hook(f32x4 (&)[2][2][4][2], const Unit&, int, int, int, int) const {}
    DI void prefetch(const Unit&, int, int, int, int, unsigned&, unsigned&) const {}
    const void* xin; bf16* xout; const float* gate;
    DI void operator()(const f32x4 (&acc)[2][2][4][2], const Unit& u, int wr, int wc, int fr, int fq) const {
        const int row0 = u.pm * BM + wr * 64 + fr, col0 = u.pn * BM + wc * 32 + 8 * fq;
        const float* gp = gate + (size_t)(u.pm >> 4) * 3072 + col0;
        f32x4 gv[2][2];
#pragma unroll
        for (int bj = 0; bj < 2; ++bj)
#pragma unroll
            for (int n = 0; n < 2; ++n) gv[bj][n] = *(const f32x4*)(gp + bj * HALF + n * 4);
#pragma unroll
        for (int ai = 0; ai < 2; ++ai)
#pragma unroll
            for (int m = 0; m < 4; ++m) { const size_t off = (size_t)(row0 + ai * HALF + m * 16) * D + col0;
#pragma unroll
                for (int bj = 0; bj < 2; ++bj) { f32x4 x0, x1;
                    if (IN_BF16) { const u32x4 w = *(const u32x4*)((const bf16*)xin + off + bj * HALF); x0 = (f32x4){bflo(w.x), bfhi(w.x), bflo(w.y), bfhi(w.y)}; x1 = (f32x4){bflo(w.z), bfhi(w.z), bflo(w.w), bfhi(w.w)}; }
                    else { x0 = *(const f32x4*)((const float*)xin + off + bj * HALF); x1 = *(const f32x4*)((const float*)xin + off + bj * HALF + 4); }
                    x0 += gv[bj][0] * acc[ai][bj][m][0]; x1 += gv[bj][1] * acc[ai][bj][m][1];
                    u32x4 o; o.x = pk2(x0[0], x0[1]); o.y = pk2(x0[2], x0[3]); o.z = pk2(x1[0], x1[1]); o.w = pk2(x1[2], x1[3]);
                    __builtin_nontemporal_store(o, (u32x4*)(xout + off + bj * HALF)); } }
    }
};
}

DI void lds_barrier() { asm volatile("s_waitcnt lgkmcnt(0)" ::: "memory"); __builtin_amdgcn_s_barrier(); asm volatile("" ::: "memory"); }
struct LayerP {
    const float *sinks, *pool_scale, *conv_w, *conv_b, *a_log, *d_skip, *ssm_norm_w;
    const bf16* poolT;
    bf16* proj; const float* dt; float* cd; bf16* st_ret; bf16* st_ssd;
};


DI void pf_item(const LayerP& P, int phase, int it, int tid, unsigned& p0, unsigned& p1, unsigned& p2) {
    if (it < 0) return;
    const bf16* proj = P.proj;
    if (phase == 3) {
        if (it < 512) { const int b = it >> 6, nb = (it >> 1) & 31, hkv = it & 1; const size_t t0 = (size_t)b * SEQ + (size_t)nb * 128;
            const int key = tid >> 1; const size_t krow = (nb > 0 || key >= 128) ? t0 + key - 128 : t0;
            p0 = *(const unsigned*)(pcol(proj, ((tid & 1) ? C_SV : C_SK) + hkv * 64) + krow * TP);
            p1 = *(const unsigned*)(pcol(proj, C_SQ + hkv * 256 + (tid & 3) * 64) + (t0 + (tid >> 2)) * TP);
            p2 = *(const unsigned*)(pcol(proj, C_SG + hkv * 256 + (tid & 3) * 64) + (t0 + (tid >> 2)) * TP);
        } else if (it < 1024) { const int q = it - 512, b = q >> 6, c = (q >> 1) & 31, grp = q & 1; const size_t t0 = (size_t)b * SEQ + (size_t)c * 128;
            p0 = *(const unsigned*)(pcol(proj, C_MX + grp * 256 + (tid & 3) * 64) + (t0 + (tid >> 2)) * TP);
            p1 = *(const unsigned*)(pcol(proj, C_MX + 512 + grp * 128 + (tid & 1) * 64) + (t0 + ((tid & 255) >> 1)) * TP);
        } else if (it < 2048) { const int q = it - 1024, b = q >> 7, c = (q >> 2) & 31, h = q & 3; const size_t t0 = (size_t)b * SEQ + (size_t)c * 128;
            p0 = *(const unsigned*)(pcol(proj, C_RV + h * 128 + (tid & 1) * 64) + (t0 + ((tid & 255) >> 1)) * TP);
            p1 = *(const unsigned*)(pcol(proj, C_RK + h * 64) + (t0 + (tid & 127)) * TP);
        } else { const int q = it - 2048, tile = q >> 2, g = q & 3; const size_t t0 = (size_t)tile * 128;
            p0 = *(const unsigned*)(pcol(proj, ((tid & 256) ? C_PG : C_PX) + g * 128 + (tid & 1) * 64) + (t0 + ((tid & 255) >> 1)) * TP);
        }
    } else {
        if (it < 512) { const int b = it >> 6, c = (it >> 1) & 31, grp = it & 1; const size_t t0 = (size_t)b * SEQ + (size_t)c * 128;
            p0 = *(const unsigned*)(pcol(proj, C_MX + grp * 256 + (tid & 3) * 64) + (t0 + (tid >> 2)) * TP);
            p1 = *(const unsigned*)(pcol(proj, C_MX + ((tid & 256) ? 768 : 512) + grp * 128 + (tid & 1) * 64) + (t0 + ((tid & 255) >> 1)) * TP);
            p2 = *(const unsigned*)(pcol(proj, C_MZ + grp * 256 + (tid & 3) * 64) + (t0 + (tid >> 2)) * TP);
        } else { const int q = it - 512, b = q >> 7, c = (q >> 2) & 31, h = q & 3; const size_t t0 = (size_t)b * SEQ + (size_t)c * 128;
            p0 = (tid < 256) ? *(const unsigned*)(pcol(proj, ((tid & 128) ? C_RQ : C_RK) + h * 64) + (t0 + (tid & 127)) * TP)
                             : *(const unsigned*)(pcol(proj, C_RV + h * 128 + (tid & 1) * 64) + (t0 + ((tid & 255) >> 1)) * TP);
            p1 = *(const unsigned*)(pcol(proj, C_RG + h * 128 + (tid & 1) * 64) + (t0 + ((tid & 255) >> 1)) * TP);
            p2 = *(const unsigned*)(P.st_ret + ((size_t)((b * 32 + c) * 4 + h)) * 8192 + (tid & 127) * 64);
        }
    }
}
#define PF_DECL unsigned pf0_ = 0u, pf1_ = 0u, pf2_ = 0u
#define PF_ISSUE(phase) pf_item(P, (phase), nxt, tid, pf0_, pf1_, pf2_)
#define PF_DONE asm volatile("" :: "v"(pf0_), "v"(pf1_), "v"(pf2_))

DI void swa_unit(LAS unsigned char* lds, const LayerP& P, int b, int nb, int hkv, int tid, int nxt = -1) {
    asm volatile("" : "+v"(tid));
    const int lane = tid & 63, wave = tid >> 6, r32 = lane & 31, h2 = lane >> 5;
    LAS unsigned char* Ksm = lds;
    LAS unsigned char* Vsm = lds + 256 * 144;
    bf16* proj = P.proj;
    const size_t t0 = (size_t)b * SEQ + (size_t)nb * 128;
#pragma unroll
    for (int i = 0; i < 4; ++i) { const int p = tid + 512 * i, key = p >> 3, ch = p & 7;
        u32x4 kv = zero4(), vv = kv;
        if (nb > 0 || key >= 128) { const size_t ro = (t0 + key - 128) * TP + ch * 8; kv = __builtin_nontemporal_load((const u32x4*)(pcol(proj, C_SK + hkv * 64) + ro)); vv = __builtin_nontemporal_load((const u32x4*)(pcol(proj, C_SV + hkv * 64) + ro)); }
        *(LAS u32x4*)(Ksm + key * 144 + ch * 16) = kv; *(LAS u32x4*)(Vsm + key * 192 + ch * 16) = vv; }
    __builtin_amdgcn_sched_barrier(0);
    LAS unsigned char* QO = lds + 256 * 144 + 256 * 192;
    { const bf16* qsrc = pcol(proj, C_SQ + hkv * 256) + t0 * TP;
#pragma unroll
      for (int i = 0; i < 8; ++i) { const int p = tid + 512 * i, row = p >> 5, c32 = p & 31;
          *(LAS u32x4*)(QO + ((c32 >> 3) * 128 + row) * 144 + (c32 & 7) * 16) = *(const u32x4*)(qsrc + (size_t)row * TP + c32 * 8);
          if (i == 3) __builtin_amdgcn_sched_barrier(0); } }
    lds_barrier();
    PF_DECL; PF_ISSUE(3);
    const int gi = wave >> 1, hq = hkv * 4 + gi;
    const float slope2 = __builtin_amdgcn_exp2f(-(float)(hq + 1)) * 1.44269504f, sink2 = P.sinks[hq] * 1.44269504f;
#pragma nounroll
    for (int sub = 0; sub < 2; ++sub) {
        const int r0 = (wave & 1) * 64 + sub * 32, r = r0 + r32, kt0 = r0 >> 5;
        LAS unsigned char* qo_row = QO + (gi * 128 + r) * 144;
        bf16x8 qf[4];
#pragma unroll
        for (int ks = 0; ks < 4; ++ks) qf[ks] = *(const LAS bf16x8*)(qo_row + (16 * ks + 8 * h2) * 2);
        f32x16 st[5];
#pragma unroll
        for (int i = 0; i < 5; ++i) {
#pragma unroll
            for (int e = 0; e < 16; ++e) st[i][e] = 0.f;
#pragma unroll
            for (int ks = 0; ks < 4; ++ks) { const bf16x8 a = *(const LAS bf16x8*)(Ksm + (32 * (kt0 + i) + r32) * 144 + (16 * ks + 8 * h2) * 2); st[i] = MFMA32(a, qf[ks], st[i]); }
            __builtin_amdgcn_sched_barrier(0);
        }
        const int dbase = 128 + r32 - 4 * h2;
        const int lo = dbase - (nb > 0 ? 127 : min(127, r));
        const float sd = slope2 * (float)dbase, sinkr = sink2 + sd, ninf = -__builtin_inff();
#pragma unroll
        for (int i = 0; i < 5; ++i) {
#pragma unroll
            for (int e = 0; e < 16; ++e) { const int c = 32 * i + (e & 3) + 8 * (e >> 2);
                float sv = fmaf(slope2, (float)c, st[i][e]);
                if (i == 0) sv = (c >= lo) ? sv : ninf;
                if (i == 4) sv = (c <= dbase) ? sv : ninf;
                st[i][e] = sv; }
            __builtin_amdgcn_sched_barrier(0);
        }
        if (nb == 0) {
#pragma unroll
            for (int i = 1; i < 4; ++i)
#pragma unroll
                for (int e = 0; e < 16; ++e) { const int c = 32 * i + (e & 3) + 8 * (e >> 2); st[i][e] = (c >= lo) ? st[i][e] : ninf; }
        }
        float m = sinkr;
#pragma unroll
        for (int i = 0; i < 5; ++i)
#pragma unroll
            for (int e = 0; e < 16; ++e) m = fmaxf(m, st[i][e]);
        { float mt = m - sd; mt = fmaxf(mt, lane_xor(mt, 32, lane)); m = mt + sd; }
        float sum = 0.f;
#pragma unroll
        for (int i = 0; i < 5; ++i) {
#pragma unroll
            for (int e = 0; e < 16; ++e) { const float p = __builtin_amdgcn_exp2f(st[i][e] - m); st[i][e] = p; sum += p; }
            __builtin_amdgcn_sched_barrier(0);
        }
        sum += lane_xor(sum, 32, lane);
        const float inv = __builtin_amdgcn_rcpf(sum + __builtin_amdgcn_exp2f(sinkr - m));
        f32x16 o[2];
#pragma unroll
        for (int mt = 0; mt < 2; ++mt)
#pragma unroll
            for (int e = 0; e < 16; ++e) o[mt][e] = 0.f;
#pragma unroll
        for (int i = 0; i < 5; ++i)
#pragma unroll
            for (int s2 = 0; s2 < 2; ++s2) {
                const bf16x8 bp = pack8(st[i][8 * s2], st[i][8 * s2 + 1], st[i][8 * s2 + 2], st[i][8 * s2 + 3], st[i][8 * s2 + 4], st[i][8 * s2 + 5], st[i][8 * s2 + 6], st[i][8 * s2 + 7]);
                const int k0 = 32 * (kt0 + i) + 16 * s2 + 4 * h2;
#pragma unroll
                for (int mt = 0; mt < 2; ++mt) { const bf16x8 a = tr_frag(Vsm, 192, k0, k0 + 8, 32 * mt, lane); o[mt] = MFMA32(a, bp, o[mt]); }
                __builtin_amdgcn_sched_barrier(0);
            }
#pragma unroll
        for (int mt = 0; mt < 2; ++mt)
#pragma unroll
            for (int g4 = 0; g4 < 4; ++g4) { u32x2 w; w.x = pk2(o[mt][4 * g4] * inv, o[mt][4 * g4 + 1] * inv); w.y = pk2(o[mt][4 * g4 + 2] * inv, o[mt][4 * g4 + 3] * inv);
                *(LAS u32x2*)(qo_row + (32 * mt + 8 * g4 + 4 * h2) * 2) = w; }
    }
    { bf16* gbase = pcol(proj, C_SG + hq * 64) + t0 * TP + (size_t)((wave & 1) * 64 + (lane >> 3)) * TP + (lane & 7) * 8;
      u32x4 gv[8];
#pragma unroll
      for (int it = 0; it < 8; ++it) gv[it] = *(const u32x4*)(gbase + (size_t)(it * 8) * TP);
#pragma unroll
      for (int it = 0; it < 8; ++it) { const int row = (wave & 1) * 64 + it * 8 + (lane >> 3), c8 = lane & 7;
          *(u32x4*)(gbase + (size_t)(it * 8) * TP) = gate8(*(const LAS u32x4*)(QO + (gi * 128 + row) * 144 + c8 * 16), gv[it]); } }
    PF_DONE;
    lds_barrier();
}

DI void pool_unit(LAS unsigned char* lds, const LayerP& P, int tile, int g, int tid, int nxt = -1) {
    asm volatile("" : "+v"(tid));
    const int lane = tid & 63, wave = tid >> 6, r32 = lane & 31, h2 = lane >> 5;
    LAS unsigned char* Usm = lds;
    LAS unsigned char* Ysm = lds + 46080;
    LAS unsigned char* Wsm = lds + 46080 + 34816;
    bf16* proj = P.proj;
    const size_t t0 = (size_t)tile * 128; const int seq0 = (int)(t0 & (SEQ - 1)), w = 2 << g;
    for (int p = tid; p < 144 * 16; p += 512) { const int row = p >> 4, ch = p & 15, l = row - 15;
        u32x4 v = zero4();
        if (row < 143 && (l >= 0 || seq0 > 0)) v = __builtin_nontemporal_load((const u32x4*)(pcol(proj, C_PX + g * 128) + (size_t)((long)t0 + l) * TP + ch * 8));
        *(LAS u32x4*)(Usm + row * 320 + ch * 16) = v; }
#pragma unroll
    for (int i = 0; i < 4; ++i) { const int p = tid + 512 * i, e = p >> 4, ch = p & 15;
        const u32x4 wv = *(const u32x4*)(P.poolT + (size_t)(g * 128 + e) * 128 + ch * 8);
        *(LAS u32x2*)(Wsm + e * 264 + ch * 16) = (u32x2){wv.x, wv.y}; *(LAS u32x2*)(Wsm + e * 264 + ch * 16 + 8) = (u32x2){wv.z, wv.w}; }
    lds_barrier();
    PF_DECL; PF_ISSUE(3);
    const int tt = wave >> 1, et0 = 2 * (wave & 1);
    bf16x8 mf[3];
    { const int cnt = min(seq0 + 32 * tt + r32 + 1, w); const float ic = 1.f / (float)cnt;
#pragma unroll
      for (int ks = 0; ks < 3; ++ks) { float mv[8];
#pragma unroll
          for (int i = 0; i < 8; ++i) { const int dd = 16 * ks + 8 * h2 + i - 15 - r32; mv[i] = ((dd > -w && dd <= 0) ? ic : 0.f) - (dd == 0 ? 1.f : 0.f); }
          mf[ks] = pack8(mv[0], mv[1], mv[2], mv[3], mv[4], mv[5], mv[6], mv[7]); } }
    f32x16 acc[2];
#pragma unroll
    for (int et = 0; et < 2; ++et)
#pragma unroll
        for (int e = 0; e < 16; ++e) acc[et][e] = 0.f;
#pragma unroll
    for (int ct = 0; ct < 4; ++ct) {
        f32x16 Dm;
#pragma unroll
        for (int e = 0; e < 16; ++e) Dm[e] = 0.f;
#pragma unroll
        for (int ks = 0; ks < 3; ++ks) { const int k0 = 32 * tt + 16 * ks + 8 * h2; const bf16x8 a = tr_frag(Usm, 320, k0, k0 + 4, 32 * ct, lane); Dm = MFMA32(a, mf[ks], Dm); }
#pragma unroll
        for (int s2 = 0; s2 < 2; ++s2) {
            const bf16x8 bp = pack8(Dm[8 * s2], Dm[8 * s2 + 1], Dm[8 * s2 + 2], Dm[8 * s2 + 3], Dm[8 * s2 + 4], Dm[8 * s2 + 5], Dm[8 * s2 + 6], Dm[8 * s2 + 7]);
#pragma unroll
            for (int et = 0; et < 2; ++et) { const LAS unsigned char* wp = Wsm + (32 * (et0 + et) + r32) * 264 + (32 * ct + 16 * s2 + 4 * h2) * 2;
                const u32x2 lo = *(const LAS u32x2*)wp, hi = *(const LAS u32x2*)(wp + 16);
                const bf16x8 a = __builtin_bit_cast(bf16x8, (u32x4){lo.x, lo.y, hi.x, hi.y});
                acc[et] = MFMA32(a, bp, acc[et]); }
        }
    }
#pragma unroll
    for (int et = 0; et < 2; ++et)
#pragma unroll
        for (int g4 = 0; g4 < 4; ++g4) { u32x2 o; o.x = pk2(acc[et][4 * g4], acc[et][4 * g4 + 1]); o.y = pk2(acc[et][4 * g4 + 2], acc[et][4 * g4 + 3]);
            *(LAS u32x2*)(Ysm + (32 * tt + r32) * 272 + (32 * (et0 + et) + 8 * g4 + 4 * h2) * 2) = o; }
    { bf16* gbase = pcol(proj, C_PG + g * 128) + t0 * TP;
      u32x4 gvv[4];
#pragma unroll
      for (int it = 0; it < 4; ++it) gvv[it] = *(const u32x4*)(gbase + (size_t)(32 * tt + it * 8 + (lane >> 3)) * TP + 64 * (wave & 1) + (lane & 7) * 8);
#pragma unroll
      for (int it = 0; it < 4; ++it) { const int row = 32 * tt + it * 8 + (lane >> 3), ch = 64 * (wave & 1) + (lane & 7) * 8;
          bf16* gp = gbase + (size_t)row * TP + ch; const u32x4 yv = *(const LAS u32x4*)(Ysm + row * 272 + ch * 2), gv = gvv[it];
          const f32x4 s0 = *(const f32x4*)(P.pool_scale + g * 128 + ch), s1 = *(const f32x4*)(P.pool_scale + g * 128 + ch + 4);
          u32x4 o; o.x = pk2(bflo(yv.x) * s0[0] * bflo(gv.x), bfhi(yv.x) * s0[1] * bfhi(gv.x)); o.y = pk2(bflo(yv.y) * s0[2] * bflo(gv.y), bfhi(yv.y) * s0[3] * bfhi(gv.y));
          o.z = pk2(bflo(yv.z) * s1[0] * bflo(gv.z), bfhi(yv.z) * s1[1] * bfhi(gv.z)); o.w = pk2(bflo(yv.w) * s1[2] * bflo(gv.w), bfhi(yv.w) * s1[3] * bfhi(gv.w));
          *(u32x4*)gp = o; } }
    PF_DONE;
    lds_barrier();
}

DI float ret_lg(int h) { return log2f(1.f - exp2f(-5.f - (float)h)); }
DI void retU_unit(LAS unsigned char* lds, const LayerP& P, int b, int c, int h, int tid, int nxt = -1) {
    asm volatile("" : "+v"(tid));
    const int lane = tid & 63, wave = tid >> 6, r32 = lane & 31, h2 = lane >> 5;
    LAS unsigned char* Ksm = lds;
    LAS unsigned char* Vsm = lds + 128 * 192;
    const bf16* proj = P.proj; const size_t t0 = (size_t)b * SEQ + (size_t)c * 128; const float lg = ret_lg(h);
#pragma unroll
    for (int i = 0; i < 2; ++i) { const int p = tid + 512 * i, s = p >> 3, ch = p & 7; float f[8];
        unpack8(__builtin_nontemporal_load((const u32x4*)(pcol(proj, C_RK + h * 64) + (t0 + s) * TP + ch * 8)), f); const float dk = __builtin_amdgcn_exp2f(lg * (float)(127 - s));
        u32x4 o; o.x = pk2(f[0] * dk, f[1] * dk); o.y = pk2(f[2] * dk, f[3] * dk); o.z = pk2(f[4] * dk, f[5] * dk); o.w = pk2(f[6] * dk, f[7] * dk);
        *(LAS u32x4*)(Ksm + s * 192 + ch * 16) = o; }
#pragma unroll
    for (int i = 0; i < 4; ++i) { const int p = tid + 512 * i, s = p >> 4, ch = p & 15;
        *(LAS u32x4*)(Vsm + s * 320 + ch * 16) = __builtin_nontemporal_load((const u32x4*)(pcol(proj, C_RV + h * 128) + (t0 + s) * TP + ch * 8)); }
    lds_barrier();
    PF_DECL; PF_ISSUE(3);
    const int mt = wave >> 2, nt = wave & 3;
    f32x16 acc;
#pragma unroll
    for (int e = 0; e < 16; ++e) acc[e] = 0.f;
#pragma unroll
    for (int ks = 0; ks < 8; ++ks) { const int k0 = 16 * ks + 8 * h2;
        const bf16x8 a = tr_frag(Ksm, 192, k0, k0 + 4, 32 * mt, lane), bb = tr_frag(Vsm, 320, k0, k0 + 4, 32 * nt, lane);
        acc = MFMA32(a, bb, acc); }
    bf16* St = P.st_ret + ((size_t)((b * 32 + c) * 4 + h)) * 8192;
#pragma unroll
    for (int g4 = 0; g4 < 4; ++g4) { u32x2 o; o.x = pk2(acc[4 * g4], acc[4 * g4 + 1]); o.y = pk2(acc[4 * g4 + 2], acc[4 * g4 + 3]);
        *(u32x2*)(St + ((nt * 4 + 2 * mt + (g4 >> 1)) * 64 + (g4 & 1) * 32 + r32) * 8 + 4 * h2) = o; }
    PF_DONE;
    lds_barrier();
}

DI void retO_unit(LAS unsigned char* lds, const LayerP& P, int b, int c, int h, int tid, int nxt = -1) {
    asm volatile("" : "+v"(tid));
    const int lane = tid & 63, wave = tid >> 6, r32 = lane & 31, h2 = lane >> 5;
    LAS unsigned char* Ksm = lds;
    LAS unsigned char* Vsm = lds + 128 * 144;
    LAS unsigned char* Qsm = lds + 128 * 144 + 128 * 320;
    LAS unsigned char* Osm = Qsm + 128 * 144;
    LAS float* red = (LAS float*)(Osm + 128 * 272);
    bf16* proj = P.proj; const size_t t0 = (size_t)b * SEQ + (size_t)c * 128; const float lg = ret_lg(h);
#pragma unroll
    for (int i = 0; i < 2; ++i) { const int p = tid + 512 * i, s = p >> 3, ch = p & 7;
        *(LAS u32x4*)(Ksm + s * 144 + ch * 16) = __builtin_nontemporal_load((const u32x4*)(pcol(proj, C_RK + h * 64) + (t0 + s) * TP + ch * 8));
        *(LAS u32x4*)(Qsm + s * 144 + ch * 16) = __builtin_nontemporal_load((const u32x4*)(pcol(proj, C_RQ + h * 64) + (t0 + s) * TP + ch * 8)); }
#pragma unroll
    for (int i = 0; i < 4; ++i) { const int p = tid + 512 * i, s = p >> 4, ch = p & 15;
        *(LAS u32x4*)(Vsm + s * 320 + ch * 16) = __builtin_nontemporal_load((const u32x4*)(pcol(proj, C_RV + h * 128) + (t0 + s) * TP + ch * 8)); }
    lds_barrier();
    PF_DECL; PF_ISSUE(5);
    const int lt = wave >> 1, dvh = wave & 1, l = 32 * lt + r32;
    bf16x8 qf[4];
#pragma unroll
    for (int ks = 0; ks < 4; ++ks) qf[ks] = *(const LAS bf16x8*)(Qsm + l * 144 + (16 * ks + 8 * h2) * 2);
    f32x16 acc[2], cr[2];
#pragma unroll
    for (int m2 = 0; m2 < 2; ++m2)
#pragma unroll
        for (int e = 0; e < 16; ++e) { acc[m2][e] = 0.f; cr[m2][e] = 0.f; }
    for (int st = 0; st <= lt; ++st) {
        f32x16 G;
#pragma unroll
        for (int e = 0; e < 16; ++e) G[e] = 0.f;
#pragma unroll
        for (int ks = 0; ks < 4; ++ks) { const bf16x8 a = *(const LAS bf16x8*)(Ksm + (32 * st + r32) * 144 + (16 * ks + 8 * h2) * 2); G = MFMA32(a, qf[ks], G); }
#pragma unroll
        for (int e = 0; e < 16; ++e) { const int s = 32 * st + crow(e, h2); G[e] = (s <= l) ? G[e] * __builtin_amdgcn_exp2f(lg * (float)(l - s)) : 0.f; }
#pragma unroll
        for (int s2 = 0; s2 < 2; ++s2) {
            const bf16x8 bp = pack8(G[8 * s2], G[8 * s2 + 1], G[8 * s2 + 2], G[8 * s2 + 3], G[8 * s2 + 4], G[8 * s2 + 5], G[8 * s2 + 6], G[8 * s2 + 7]);
            const int k0 = 32 * st + 16 * s2 + 4 * h2;
#pragma unroll
            for (int m2 = 0; m2 < 2; ++m2) { const bf16x8 a = tr_frag(Vsm, 320, k0, k0 + 8, 32 * (2 * dvh + m2), lane); acc[m2] = MFMA32(a, bp, acc[m2]); }
        }
    }
    const bf16* St = P.st_ret + ((size_t)((b * 32 + c) * 4 + h)) * 8192;
#pragma unroll
    for (int m2 = 0; m2 < 2; ++m2)
#pragma unroll
        for (int ks = 0; ks < 4; ++ks) { const bf16x8 a = *(const bf16x8*)(St + (((2 * dvh + m2) * 4 + ks) * 64 + lane) * 8); cr[m2] = MFMA32(a, qf[ks], cr[m2]); }
    const float qd = __builtin_amdgcn_exp2f(lg * (float)(l + 1));
    float ss = 0.f;
#pragma unroll
    for (int m2 = 0; m2 < 2; ++m2)
#pragma unroll
        for (int e = 0; e < 16; ++e) { const float v = acc[m2][e] + qd * cr[m2][e]; acc[m2][e] = v; ss += v * v; }
    ss += lane_xor(ss, 32, lane);
    if (h2 == 0) red[wave * 32 + r32] = ss;
    lds_barrier();
    const float rstd = rsqrtf((red[wave * 32 + r32] + red[(wave ^ 1) * 32 + r32]) * (1.f / 128.f) + EPS);
#pragma unroll
    for (int m2 = 0; m2 < 2; ++m2)
#pragma unroll
        for (int g4 = 0; g4 < 4; ++g4) { u32x2 o; o.x = pk2(acc[m2][4 * g4] * rstd, acc[m2][4 * g4 + 1] * rstd); o.y = pk2(acc[m2][4 * g4 + 2] * rstd, acc[m2][4 * g4 + 3] * rstd);
            *(LAS u32x2*)(Osm + l * 272 + (32 * (2 * dvh + m2) + 8 * g4 + 4 * h2) * 2) = o; }
    { bf16* gbase = pcol(proj, C_RG + h * 128) + t0 * TP;
      u32x4 gvv[4];
#pragma unroll
      for (int it = 0; it < 4; ++it) gvv[it] = *(const u32x4*)(gbase + (size_t)(32 * lt + it * 8 + (lane >> 3)) * TP + 64 * dvh + (lane & 7) * 8);
#pragma unroll
      for (int it = 0; it < 4; ++it) { const int row = 32 * lt + it * 8 + (lane >> 3), dv = 64 * dvh + (lane & 7) * 8;
          bf16* gp = gbase + (size_t)row * TP + dv;
          *(u32x4*)gp = gate8(*(const LAS u32x4*)(Osm + row * 272 + dv * 2), gvv[it]); } }
    PF_DONE;
    lds_barrier();
}

constexpr int SSD_TAB = 0, SSD_ACS = 2048, SSD_SSQ = 4096;
template <int PASS>
DI void ssd_stage(LAS unsigned char* lds, const LayerP& P, int b, int c, int grp, int tid, int xoff, int boff, int bstride, int coff) {
    const int lane = tid & 63, wave = tid >> 6;
    LAS float* dtl = (LAS float*)(lds + SSD_TAB); LAS float* acs = (LAS float*)(lds + SSD_ACS);
    const size_t t0 = (size_t)b * SEQ + (size_t)c * 128;
    const int chunk = lane, seg = wave;
    const int kind = chunk < 32 ? 0 : (chunk < 48 ? 1 : 2);
    const bool active = !(PASS == 1 && kind == 2);
    const int ch0 = kind == 0 ? grp * 256 + chunk * 8 : (kind == 1 ? 512 + grp * 128 + (chunk - 32) * 8 : 768 + grp * 128 + (chunk - 48) * 8);
    u32x4 raw[19];
    { const bf16* gp = pcol(P.proj, C_MX + ch0) + (t0 + 16 * seg) * TP;
      const bool hv = (seg > 0) || (c > 0);
      const u32x4 zz = zero4();
#pragma unroll
      for (int i = 0; i < 19; ++i) { raw[i] = zz; if (active && (i >= 3 || hv)) raw[i] = *(const u32x4*)(gp + ((long)i - 3) * TP); } }
    if (wave < 4) { const int hh = grp * 4 + wave; const float a = -__expf(P.a_log[hh]);
        const float d0 = P.dt[(t0 + 2 * lane) * 8 + hh], d1 = P.dt[(t0 + 2 * lane + 1) * 8 + hh];
        const float s0 = d0 * a, s1 = s0 + d1 * a; float tot = s1;
#pragma unroll
        for (int off = 1; off < 64; off <<= 1) { const float v = lane_up(tot, off, lane); if (lane >= off) tot += v; }
        const float ex = tot - s1;
        acs[wave * 128 + 2 * lane] = ex + s0; acs[wave * 128 + 2 * lane + 1] = ex + s1; dtl[wave * 128 + 2 * lane] = d0; dtl[wave * 128 + 2 * lane + 1] = d1; }
    lds_barrier();
    if (active) {
        float cw[4][8], cb[8];
#pragma unroll
        for (int j = 0; j < 4; ++j) { const f32x4 w0 = *(const f32x4*)(P.conv_w + j * 1024 + ch0), w1 = *(const f32x4*)(P.conv_w + j * 1024 + ch0 + 4);
            cw[j][0] = w0[0]; cw[j][1] = w0[1]; cw[j][2] = w0[2]; cw[j][3] = w0[3]; cw[j][4] = w1[0]; cw[j][5] = w1[1]; cw[j][6] = w1[2]; cw[j][7] = w1[3]; }
        { const f32x4 w0 = *(const f32x4*)(P.conv_b + ch0), w1 = *(const f32x4*)(P.conv_b + ch0 + 4);
            cb[0] = w0[0]; cb[1] = w0[1]; cb[2] = w0[2]; cb[3] = w0[3]; cb[4] = w1[0]; cb[5] = w1[1]; cb[6] = w1[2]; cb[7] = w1[3]; }
        float u3[8], u2[8], u1[8], cur[8];
        unpack8(raw[0], u3); unpack8(raw[1], u2); unpack8(raw[2], u1);
        const int r = chunk >> 3;
        const float aend = acs[(r & 3) * 128 + 127];
#pragma unroll
        for (int i = 0; i < 16; ++i) { const int l = 16 * seg + i;
            unpack8(raw[3 + i], cur);
            float o[8];
#pragma unroll
            for (int e = 0; e < 8; ++e) { const float v = cb[e] + cw[0][e] * u3[e] + cw[1][e] * u2[e] + cw[2][e] * u1[e] + cw[3][e] * cur[e]; o[e] = silu_f(v); u3[e] = u2[e]; u2[e] = u1[e]; u1[e] = cur[e]; }
            if (kind == 0) { float sc = dtl[r * 128 + l]; if (PASS == 1) sc *= __expf(aend - acs[r * 128 + l]);
#pragma unroll
                for (int e = 0; e < 8; ++e) o[e] *= sc; }
            u32x4 w; w.x = pk2(o[0], o[1]); w.y = pk2(o[2], o[3]); w.z = pk2(o[4], o[5]); w.w = pk2(o[6], o[7]);
            if (kind == 0) *(LAS u32x4*)(lds + xoff + l * 576 + chunk * 16) = w;
            else if (kind == 1) *(LAS u32x4*)(lds + boff + l * bstride + (chunk - 32) * 16) = w;
            else *(LAS u32x4*)(lds + coff + l * 272 + (chunk - 48) * 16) = w; }
    }
    lds_barrier();
}

DI void ssdU_unit(LAS unsigned char* lds, const LayerP& P, int b, int c, int grp, int tid, int nxt = -1) {
    asm volatile("" : "+v"(tid));
    const int lane = tid & 63, wave = tid >> 6, r32 = lane & 31, h2 = lane >> 5;
    constexpr int XOFF = 6144, BOFF = 6144 + 128 * 576;
    ssd_stage<1>(lds, P, b, c, grp, tid, XOFF, BOFF, 320, 0);
    PF_DECL; PF_ISSUE(3);
    const int r = wave >> 1, pt = wave & 1, hh = grp * 4 + r;
    f32x16 acc[4];
#pragma unroll
    for (int nt = 0; nt < 4; ++nt)
#pragma unroll
        for (int e = 0; e < 16; ++e) acc[nt][e] = 0.f;
#pragma unroll
    for (int ks = 0; ks < 8; ++ks) { const int k0 = 16 * ks + 8 * h2;
        const bf16x8 xb = tr_frag(lds + XOFF, 576, k0, k0 + 4, r * 64 + 32 * pt, lane);
#pragma unroll
        for (int nt = 0; nt < 4; ++nt) { const bf16x8 a = tr_frag(lds + BOFF, 320, k0, k0 + 4, 32 * nt, lane); acc[nt] = MFMA32(a, xb, acc[nt]); }
    }
    bf16* Sb = P.st_ssd + ((size_t)((b * 32 + c) * 8 + hh)) * 8192;
#pragma unroll
    for (int nt = 0; nt < 4; ++nt)
#pragma unroll
        for (int g4 = 0; g4 < 4; ++g4) { u32x2 o; o.x = pk2(acc[nt][4 * g4], acc[nt][4 * g4 + 1]); o.y = pk2(acc[nt][4 * g4 + 2], acc[nt][4 * g4 + 3]);
            *(u32x2*)(Sb + ((pt * 8 + 2 * nt + (g4 >> 1)) * 64 + (g4 & 1) * 32 + r32) * 8 + 4 * h2) = o; }
    if (tid < 4) P.cd[(b * 32 + c) * 8 + grp * 4 + tid] = __expf(((LAS float*)(lds + SSD_ACS))[tid * 128 + 127]);
    PF_DONE;
    lds_barrier();
}

DI void ssdO_unit(LAS unsigned char* lds, const LayerP& P, int b, int c, int grp, int tid, int nxt = -1) {
    asm volatile("" : "+v"(tid));
    const int lane = tid & 63, wave = tid >> 6, r32 = lane & 31, h2 = lane >> 5;
    constexpr int BOFF = 6144, COFF = 6144 + 34816, XOFF = 6144 + 2 * 34816;
    ssd_stage<2>(lds, P, b, c, grp, tid, XOFF, BOFF, 272, COFF);
    PF_DECL; PF_ISSUE(5);
    LAS float* dtl = (LAS float*)(lds + SSD_TAB); LAS float* acs = (LAS float*)(lds + SSD_ACS); LAS float* ssq = (LAS float*)(lds + SSD_SSQ);
    bf16* proj = P.proj; const size_t t0 = (size_t)b * SEQ + (size_t)c * 128;
    const int r = wave >> 1, lh = wave & 1, hh = grp * 4 + r;
    const bf16* Sb = P.st_ssd + ((size_t)((b * 32 + c) * 8 + hh)) * 8192;
    const float dsk = P.d_skip[hh];
    bf16x8 sf[2][8];
#pragma unroll
    for (int pt = 0; pt < 2; ++pt)
#pragma unroll
        for (int ks = 0; ks < 8; ++ks) sf[pt][ks] = *(const bf16x8*)(Sb + ((pt * 8 + ks) * 64 + lane) * 8);
#pragma nounroll
    for (int li = 0; li < 2; ++li) {
        const int lt = 2 * lh + li, l = 32 * lt + r32;
        bf16x8 cf[8];
#pragma unroll
        for (int ks = 0; ks < 8; ++ks) cf[ks] = *(const LAS bf16x8*)(lds + COFF + l * 272 + (16 * ks + 8 * h2) * 2);
        f32x16 y[2], yo[2];
#pragma unroll
        for (int pt = 0; pt < 2; ++pt)
#pragma unroll
            for (int e = 0; e < 16; ++e) { y[pt][e] = 0.f; yo[pt][e] = 0.f; }
        const float al = acs[r * 128 + l];
        for (int st = 0; st <= lt; ++st) {
            f32x16 G;
#pragma unroll
            for (int e = 0; e < 16; ++e) G[e] = 0.f;
#pragma unroll
            for (int ks = 0; ks < 8; ++ks) { const bf16x8 a = *(const LAS bf16x8*)(lds + BOFF + (32 * st + r32) * 272 + (16 * ks + 8 * h2) * 2); G = MFMA32(a, cf[ks], G); }
#pragma unroll
            for (int e = 0; e < 16; ++e) { const int s = 32 * st + crow(e, h2); G[e] = (s <= l) ? G[e] * __expf(al - acs[r * 128 + s]) : 0.f; }
#pragma unroll
            for (int s2 = 0; s2 < 2; ++s2) {
                const bf16x8 bp = pack8(G[8 * s2], G[8 * s2 + 1], G[8 * s2 + 2], G[8 * s2 + 3], G[8 * s2 + 4], G[8 * s2 + 5], G[8 * s2 + 6], G[8 * s2 + 7]);
                const int k0 = 32 * st + 16 * s2 + 4 * h2;
#pragma unroll
                for (int pt = 0; pt < 2; ++pt) { const bf16x8 a = tr_frag(lds + XOFF, 576, k0, k0 + 8, r * 64 + 32 * pt, lane); y[pt] = MFMA32(a, bp, y[pt]); }
            }
        }
#pragma unroll
        for (int pt = 0; pt < 2; ++pt)
#pragma unroll
            for (int ks = 0; ks < 8; ++ks) yo[pt] = MFMA32(sf[pt][ks], cf[ks], yo[pt]);
        const float el = __expf(al), dti = __builtin_amdgcn_rcpf(dtl[r * 128 + l]);
        bf16* zrow = pcol(proj, C_MZ + hh * 64) + (t0 + l) * TP;
        float ss = 0.f;
#pragma unroll
        for (int pt = 0; pt < 2; ++pt)
#pragma unroll
            for (int a2 = 0; a2 < 2; ++a2) {
                f32x4 v0, v1;
#pragma unroll
                for (int j = 0; j < 4; ++j) { v0[j] = y[pt][8 * a2 + j] + el * yo[pt][8 * a2 + j]; v1[j] = y[pt][8 * a2 + 4 + j] + el * yo[pt][8 * a2 + 4 + j]; }
                const bool hi = h2 != 0;
                const f32x4 mine = hi ? v1 : v0, give = hi ? v0 : v1;
                f32x4 got;
#pragma unroll
                for (int j = 0; j < 4; ++j) got[j] = lane_xor(give[j], 32, lane);
                const f32x4 lo4 = hi ? got : mine, hi4 = hi ? mine : got;
                float v8[8];
#pragma unroll
                for (int j = 0; j < 4; ++j) { v8[j] = lo4[j]; v8[4 + j] = hi4[j]; }
                const int p0 = 32 * pt + 16 * a2 + 8 * h2;
                float xs[8], zs[8]; unpack8(*(const LAS u32x4*)(lds + XOFF + l * 576 + (r * 64 + p0) * 2), xs); unpack8(*(const u32x4*)(zrow + p0), zs);
#pragma unroll
                for (int j = 0; j < 8; ++j) { v8[j] = (v8[j] + xs[j] * dti * dsk) * zs[j]; ss += v8[j] * v8[j]; }
                u32x4 o; o.x = pk2(v8[0], v8[1]); o.y = pk2(v8[2], v8[3]); o.z = pk2(v8[4], v8[5]); o.w = pk2(v8[6], v8[7]);
                *(u32x4*)(zrow + p0) = o;
            }
        ss += lane_xor(ss, 32, lane);
        if (h2 == 0) ssq[r * 128 + l] = ss;
    }
    lds_barrier();
#pragma nounroll
    for (int li = 0; li < 2; ++li) {
        const int l = 32 * (2 * lh + li) + r32;
        const float rstd = rsqrtf((ssq[l] + ssq[128 + l] + ssq[256 + l] + ssq[384 + l]) * (1.f / 256.f) + EPS);
        bf16* orow = pcol(proj, C_MZ + hh * 64) + (t0 + l) * TP;
#pragma unroll
        for (int pt = 0; pt < 2; ++pt)
#pragma unroll
            for (int a2 = 0; a2 < 2; ++a2) { const int p0 = 32 * pt + 16 * a2 + 8 * h2; const f32x4 n0 = *(const f32x4*)(P.ssm_norm_w + hh * 64 + p0), n1 = *(const f32x4*)(P.ssm_norm_w + hh * 64 + p0 + 4);
                const u32x4 yv = *(const u32x4*)(orow + p0);
                u32x4 o; o.x = pk2(bflo(yv.x) * rstd * n0[0], bfhi(yv.x) * rstd * n0[1]); o.y = pk2(bflo(yv.y) * rstd * n0[2], bfhi(yv.y) * rstd * n0[3]);
                o.z = pk2(bflo(yv.z) * rstd * n1[0], bfhi(yv.z) * rstd * n1[1]); o.w = pk2(bflo(yv.w) * rstd * n1[2], bfhi(yv.w) * rstd * n1[3]);
                *(u32x4*)(orow + p0) = o; }
    }
    PF_DONE;
    lds_barrier();
}

DI void scan_phase(const LayerP& P, int gid) {
    bf16* base; float dec_const = 0.f; const float* cdp = nullptr; size_t cstride;
    if (gid < 32768) { const int b = gid >> 12, h = (gid >> 10) & 3, e8 = gid & 1023; base = P.st_ret + ((size_t)(b * 32 * 4 + h)) * 8192 + e8 * 8; cstride = 4 * 8192; dec_const = exp2f(128.f * ret_lg(h)); }
    else if (gid < 98304) { const int g2 = gid - 32768, b = g2 >> 13, h = (g2 >> 10) & 7, e8 = g2 & 1023; base = P.st_ssd + ((size_t)(b * 32 * 8 + h)) * 8192 + e8 * 8; cstride = 8 * 8192; cdp = P.cd + b * 32 * 8 + h; }
    else return;
    float s[8]; float zf = 0.f; asm volatile("" : "+v"(zf));
#pragma unroll
    for (int e = 0; e < 8; ++e) s[e] = zf;
#pragma unroll
    for (int c0 = 0; c0 < 32; c0 += 16) {
        u32x4 v[16]; float dc[16];
#pragma unroll
        for (int i = 0; i < 16; ++i) { v[i] = *(const u32x4*)(base + (size_t)(c0 + i) * cstride); dc[i] = cdp ? cdp[(c0 + i) * 8] : dec_const; }
#pragma unroll
        for (int i = 0; i < 16; ++i) { float u[8]; unpack8(v[i], u);
            u32x4 o; o.x = pk2(s[0], s[1]); o.y = pk2(s[2], s[3]); o.z = pk2(s[4], s[5]); o.w = pk2(s[6], s[7]); *(u32x4*)(base + (size_t)(c0 + i) * cstride) = o;
#pragma unroll
            for (int e = 0; e < 8; ++e) s[e] = s[e] * dc[i] + u[e]; }
        __builtin_amdgcn_sched_barrier(0);
    }
}

DI int win_src(int r, float& sc) {
    sc = 1.f;
    if (r < 512) return S_RG + r;
    if (r < 1024) return S_SG + r - 512;
    if (r < 1536) return S_PG + r - 1024;
    if (r < 2048) return S_MZ + r - 1536;
    if (r < 2304) return S_RQ + r - 2048;
    if (r < 2560) { sc = 0.125f; return S_RK + r - 2304; }
    if (r < 3072) return S_RV + r - 2560;
    if (r < 3584) { sc = 0.125f * 1.44269504f; return S_SQ + r - 3072; }
    if (r < 3712) return S_SK + r - 3584;
    if (r < 3840) return S_SV + r - 3712;
    if (r < 4352) return S_PX + r - 3840;
    if (r < 5376) return S_MX + r - 4352;
    const int rho = r - 5376, pn = rho >> 8, bj = (rho >> 7) & 1, wc = (rho >> 5) & 3, n = (rho >> 4) & 1, fq = (rho >> 2) & 3, j = rho & 3;
    return S_MG + (2 * bj + n) * 1024 + 64 * pn + 32 * (wc >> 1) + 8 * fq + 4 * (wc & 1) + j;
}
DI void transpose_item(const float* W, int ldw, int K, bf16* WT, int r0, int k0, int col, float sc, LAS float* scr, int lane, int kd0 = -1) {
    if (kd0 < 0) kd0 = k0;
#pragma unroll 8
    for (int i = 0; i < 32; ++i) { const int kk = 2 * i + (lane >> 5); scr[kk * 33 + (lane & 31)] = W[(size_t)(k0 + kk) * ldw + col] * sc; }
    asm volatile("s_waitcnt lgkmcnt(0)" ::: "memory");
    const int c = lane & 7;
#pragma unroll
    for (int j = 0; j < 4; ++j) { const int n = (lane >> 3) + 8 * j; const LAS float* s = scr + (8 * c) * 33 + n;
        u32x4 o; o.x = pk2(s[0 * 33], s[1 * 33]); o.y = pk2(s[2 * 33], s[3 * 33]); o.z = pk2(s[4 * 33], s[5 * 33]); o.w = pk2(s[6 * 33], s[7 * 33]);
        *(u32x4*)(WT + (size_t)(r0 + n) * K + kd0 + 8 * c) = o; }
    asm volatile("s_waitcnt lgkmcnt(0)" ::: "memory");
}

DI void transpose_item8(const float* W, int ldw, int K, unsigned char* WT8, int r0, int k0, int col, float sc, LAS float* scr, int lane) {
#pragma unroll 8
    for (int i = 0; i < 32; ++i) { const int kk = 2 * i + (lane >> 5); scr[kk * 33 + (lane & 31)] = W[(size_t)(k0 + kk) * ldw + col] * sc; }
    asm volatile("s_waitcnt lgkmcnt(0)" ::: "memory");
    const int c = lane & 7;
#pragma unroll
    for (int j = 0; j < 4; ++j) { const int n = (lane >> 3) + 8 * j; const LAS float* s = scr + (8 * c) * 33 + n;
        u32x2 o; o.x = pk4_i8(s[0 * 33], s[1 * 33], s[2 * 33], s[3 * 33]); o.y = pk4_i8(s[4 * 33], s[5 * 33], s[6 * 33], s[7 * 33]);
        *(u32x2*)(WT8 + (size_t)(r0 + n) * K + k0 + 8 * c) = o; }
    asm volatile("s_waitcnt lgkmcnt(0)" ::: "memory");
}

struct Args {
    const float* in[18]; float* out; unsigned char* ws; int ph_lo, ph_hi;
};

DI void p0_prologue(LAS unsigned char* lds, const Args& a, int tid, int G, int part) {
    const int lane = tid & 63, wave = tid >> 6;
    unsigned char* ws = a.ws;
    if (part == 0)
    for (int it = blockIdx.x; it < 96; it += G) {
        const int l = it / 48, cg = it % 48;
        LAS float* sc = (LAS float*)lds;
        LAS float* red = (LAS float*)(lds + 32768);
        for (int i = tid; i < 8192; i += 512) sc[i] = silu_f(a.in[1][i]);
        __syncthreads();
        float acc[8];
#pragma unroll
        for (int b = 0; b < 8; ++b) acc[b] = 0.f;
        const float* wp = a.in[2] + (size_t)l * 1024 * 3072 + (size_t)(wave * 128) * 3072 + cg * 64 + lane;
#pragma unroll 4
        for (int k = 0; k < 128; ++k) { const float w = wp[(size_t)k * 3072];
#pragma unroll
            for (int b = 0; b < 8; ++b) acc[b] += sc[b * 1024 + wave * 128 + k] * w; }
#pragma unroll
        for (int b = 0; b < 8; ++b) red[(wave * 8 + b) * 64 + lane] = acc[b];
        __syncthreads();
        { const int b = tid >> 6, n = tid & 63; float s = 0.f;
#pragma unroll
            for (int w = 0; w < 8; ++w) s += red[(w * 8 + b) * 64 + n];
            ((float*)(ws + WS_MOD))[(size_t)(l * 8 + b) * 3072 + cg * 64 + n] = s + a.in[3][l * 3072 + cg * 64 + n]; }
        __syncthreads();
    }
    if (part == 0) {
        LAS float* red = (LAS float*)lds;
        for (int cb = blockIdx.x; cb < 256; cb += G) { const int l = cb >> 7, rho0 = (cb & 127) * 32, cc = tid & 31, ks = tid >> 5; float dummy;
            const float* wp = a.in[5] + (size_t)l * 1024 * DIN + (size_t)(ks * 64) * DIN + win_src(5376 + rho0 + cc, dummy);
            float mx = 0.f;
#pragma unroll 8
            for (int k = 0; k < 64; ++k) mx = fmaxf(mx, fabsf(__builtin_nontemporal_load(wp + (size_t)k * DIN)));
            __syncthreads(); red[ks * 32 + cc] = mx; __syncthreads();
            if (tid < 32) { float m2 = 0.f;
#pragma unroll
                for (int q = 0; q < 16; ++q) m2 = fmaxf(m2, red[q * 32 + tid]);
                ((float*)(ws + WS_SW))[l * 4096 + rho0 + tid] = m2 > 0.f ? m2 * (1.f / 127.f) : 1.f; }
        }
        return;
    }
    LAS float* scr = (LAS float*)(lds + wave * 8448);
    const int gw = blockIdx.x * 8 + wave, NGW = G * 8;
    constexpr int I_WIN = (WIN_ROWS / 32) * 16, I_UP = 32 * 8, I_OUT = 32 * 16, I_POOL = 4 * 2;
    constexpr int NITEMS = 2 * I_WIN + 8 * I_UP + 2 * I_OUT + 8 * I_POOL;
    for (int it = gw; it < NITEMS; it += NGW) {
        int r = it;
        if (r < 2 * I_WIN) { const int l = r / I_WIN, q = r % I_WIN, rg = q >> 4, kb = q & 15; float sc; const int col = win_src(rg * 32 + (lane & 31), sc);
            if (rg * 32 >= 5376) { const float isc = 1.f / ((const float*)(ws + WS_SW))[l * 4096 + rg * 32 - 5376 + (lane & 31)];
                transpose_item8(a.in[5] + (size_t)l * 1024 * DIN, DIN, 1024, ws + WS_WMG8 + (size_t)l * 4096 * 1024, rg * 32 - 5376, kb * 64, col, isc, scr, lane); continue; }
            transpose_item(a.in[5] + (size_t)l * 1024 * DIN, DIN, 1024, (bf16*)(ws + WS_WIN) + (size_t)l * WIN_L, rg * 32, kb * 64, col, sc, scr, lane); continue; }
        r -= 2 * I_WIN;
        if (r < 8 * I_UP) { const int li = r / I_UP, q = r % I_UP, rg = q >> 3, kb = q & 7;
            transpose_item(a.in[15] + (size_t)li * 512 * 1024, 1024, 2048, (bf16*)(ws + WS_WUP) + (size_t)(li >> 2) * 1024 * 2048, rg * 32, kb * 64, rg * 32 + (lane & 31), 1.f, scr, lane, (li & 3) * 512 + kb * 64); continue; }
        r -= 8 * I_UP;
        if (r < 2 * I_OUT) { const int l = r / I_OUT, q = r % I_OUT, rg = q >> 4, kb = q & 15;
            transpose_item(a.in[16] + (size_t)l * 1024 * 1024, 1024, 1024, (bf16*)(ws + WS_WOUT) + (size_t)l * 1024 * 1024, rg * 32, kb * 64, rg * 32 + (lane & 31), 1.f, scr, lane); continue; }
        r -= 2 * I_OUT;
        { const int lg = r / I_POOL, q = r % I_POOL, rg = q >> 1, kb = q & 1;
            transpose_item(a.in[7] + (size_t)lg * 128 * 128, 128, 128, (bf16*)(ws + WS_POOL) + (size_t)lg * 128 * 128, rg * 32, kb * 64, rg * 32 + (lane & 31), 1.f, scr, lane); }
    }
}

template <bool IN_BF16>
DI void p1_norm(LAS unsigned char* lds, const Args& a, int layer, const void* xin, int tid, int G) {
    const int lane = tid & 63, wave = tid >> 6;
    LAS float* wdt = (LAS float*)lds;
    const float* win = a.in[5] + (size_t)layer * 1024 * DIN;
    for (int i = tid; i < 8192; i += 512) { const int k = i >> 3, jj = i & 7; wdt[(((k >> 8) * 4 + (k & 3)) * 64 + ((k & 255) >> 2)) * 4 + (jj & 3) + (jj >> 2) * 4096] = win[(size_t)k * DIN + S_DT + jj]; }
    __syncthreads();
    const float* nw = a.in[4] + layer * 1024; const float* mod = (const float*)(a.ws + WS_MOD) + (size_t)layer * 8 * 3072;
    bf16* H = (bf16*)(a.ws + WS_H); float* DT = (float*)(a.ws + WS_DT); const float* dtb = a.in[11] + layer * 8;
    for (int row = blockIdx.x * 8 + wave; row < T; row += G * 8) {
        const int b = row >> 12;
        f32x4 v[4]; float ss = 0.f;
#pragma unroll
        for (int j = 0; j < 4; ++j) {
            if (IN_BF16) { const u32x2 w = __builtin_nontemporal_load((const u32x2*)((const bf16*)xin + (size_t)row * D) + lane + 64 * j); v[j] = (f32x4){bflo(w.x), bfhi(w.x), bflo(w.y), bfhi(w.y)}; }
            else v[j] = __builtin_nontemporal_load((const f32x4*)((const float*)xin + (size_t)row * D) + lane + 64 * j);
            ss += (v[j][0] * v[j][0] + v[j][1] * v[j][1]) + (v[j][2] * v[j][2] + v[j][3] * v[j][3]); }
        const float rstd = rsqrtf(wave_sum(ss, lane) * (1.f / D) + EPS);
        float dacc[8]; f32x4 hq[4];
#pragma unroll
        for (int e = 0; e < 8; ++e) dacc[e] = 0.f;
#pragma unroll
        for (int j = 0; j < 4; ++j) { const int col = 256 * j + 4 * lane;
            const f32x4 w4 = *(const f32x4*)(nw + col), sc4 = *(const f32x4*)(mod + b * 3072 + 1024 + col), sh4 = *(const f32x4*)(mod + b * 3072 + col);
            const f32x4 hv = v[j] * rstd * w4 * (sc4 + 1.f) + sh4;
            u32x2 o; o.x = pk2(hv[0], hv[1]); o.y = pk2(hv[2], hv[3]);
            *(u32x2*)(H + (size_t)row * D + col) = o;
            hq[j] = hv;
#pragma unroll
            for (int e = 0; e < 4; ++e) { const f32x4 w0 = *(const LAS f32x4*)(wdt + ((j * 4 + e) * 64 + lane) * 4), w1 = *(const LAS f32x4*)(wdt + 4096 + ((j * 4 + e) * 64 + lane) * 4);
                dacc[0] += hv[e] * w0[0]; dacc[1] += hv[e] * w0[1]; dacc[2] += hv[e] * w0[2]; dacc[3] += hv[e] * w0[3];
                dacc[4] += hv[e] * w1[0]; dacc[5] += hv[e] * w1[1]; dacc[6] += hv[e] * w1[2]; dacc[7] += hv[e] * w1[3]; } }
        { float am = 0.f;
#pragma unroll
          for (int j = 0; j < 4; ++j) am = fmaxf(am, fmaxf(fmaxf(fabsf(hq[j][0]), fabsf(hq[j][1])), fmaxf(fabsf(hq[j][2]), fabsf(hq[j][3]))));
#pragma unroll
          for (int o = 1; o < 64; o <<= 1) am = fmaxf(am, lane_xor(am, o, lane));
          const float qs = am > 0.f ? 127.f / am : 0.f;
#pragma unroll
          for (int j = 0; j < 4; ++j) *(unsigned*)((unsigned char*)a.out + (size_t)T * D * 2 + (size_t)row * D + 256 * j + 4 * lane) = pk4_i8(hq[j][0] * qs, hq[j][1] * qs, hq[j][2] * qs, hq[j][3] * qs);
          if (lane == 0) ((float*)(a.ws + WS_SH))[row] = am > 0.f ? am * (1.f / 127.f) : 1.f; }
        float mine = 0.f;
#pragma unroll
        for (int e = 0; e < 8; ++e) { const float s = wave_sum(dacc[e], lane); if (lane == e) mine = s; }
        if (lane < 8) { const float z = mine + dtb[lane]; const float ez = __expf(z); DT[(size_t)row * 8 + lane] = z > 20.f ? z : (ez < 0.01f ? ez * (1.f - ez * (0.5f - ez * 0.33333334f)) : __logf(1.f + ez)); }
    }
    __syncthreads();
}

DI void p7_final(const Args& a, int tid, int G) {
    const int lane = tid & 63, wave = tid >> 6; const float* fw = a.in[17];
    const bf16* x2 = (const bf16*)(a.ws + WS_PROJ);
    for (int row = blockIdx.x * 8 + wave; row < T; row += G * 8) {
        f32x4 v[4]; float ss = 0.f;
#pragma unroll
        for (int j = 0; j < 4; ++j) { const u32x2 w = __builtin_nontemporal_load((const u32x2*)(x2 + (size_t)row * D) + lane + 64 * j); v[j] = (f32x4){bflo(w.x), bfhi(w.x), bflo(w.y), bfhi(w.y)};
            ss += (v[j][0] * v[j][0] + v[j][1] * v[j][1]) + (v[j][2] * v[j][2] + v[j][3] * v[j][3]); }
        const float rstd = rsqrtf(wave_sum(ss, lane) * (1.f / D) + EPS);
        f32x4* xr = (f32x4*)(a.out + (size_t)row * D) + lane;
#pragma unroll
        for (int j = 0; j < 4; ++j) xr[64 * j] = v[j] * rstd * *(const f32x4*)(fw + 256 * j + 4 * lane);
    }
}


#define XB_TMO      128
#define XB_XCNT(j)  (256  + 64 * (j))
#define XB_XSUB(j)  (1280 + 64 * (j))
#define XB_XGEN(j)  (2304 + 64 * (j))
#define XB_TOP      3328
#define XB_TOPGEN   3392
#define XCD_BAR_WORDS 3456
#define XB_SPIN_CAP (1u << 20)
DI unsigned xb_ld(unsigned* p)              { return __hip_atomic_load(p, __ATOMIC_RELAXED, __HIP_MEMORY_SCOPE_AGENT); }
DI unsigned xb_add(unsigned* p, unsigned v) { return __hip_atomic_fetch_add(p, v, __ATOMIC_RELAXED, __HIP_MEMORY_SCOPE_AGENT); }
DI unsigned xb_xcc_id() { return (unsigned)__builtin_amdgcn_s_getreg((3 << 11) | 20) & 0xFu; }
#define XB_SPIN(cond, bar) do { unsigned _sp = 0; while (cond) { __builtin_amdgcn_s_sleep(1); \
    if ((++_sp & 255u) == 0u) { if (xb_ld(&(bar)[XB_TMO])) break; if (_sp > XB_SPIN_CAP) { atomicAdd(&(bar)[XB_TMO], 1u); break; } } } } while (0)
struct XcdBarrier { unsigned* bar; unsigned x; volatile LAS unsigned* st; };
DI XcdBarrier xcd_barrier_post(unsigned* bar, volatile LAS unsigned* st, bool leader) {
    XcdBarrier b; b.bar = bar; b.x = xb_xcc_id(); b.st = st;
    if (leader) (void)xb_add(&bar[XB_XCNT(b.x)], 1u);
    return b;
}
DI void xcd_barrier_complete(unsigned* bar, unsigned x, unsigned& nloc, unsigned& nx) {
    const unsigned G = gridDim.x * gridDim.y * gridDim.z;
    unsigned sum, cnt, mine, sp = 0u;
    for (;;) {
        sum = 0u; cnt = 0u; mine = 0u;
#pragma unroll
        for (unsigned j = 0; j < 16; ++j) { const unsigned c = xb_ld(&bar[XB_XCNT(j)]); sum += c; cnt += (c > 0u) ? 1u : 0u; mine = (j == x) ? c : mine; }
        if (sum == G) break;
        __builtin_amdgcn_s_sleep(1);
        if ((++sp & 255u) == 0u) { if (xb_ld(&bar[XB_TMO])) break; if (sp > XB_SPIN_CAP) { atomicAdd(&bar[XB_TMO], 1u); break; } }
    }
    nloc = mine > 0u ? mine : 1u; nx = cnt > 0u ? cnt : 1u;
}
DI void xcd_barrier(const XcdBarrier& b, bool leader) {
    asm volatile("s_waitcnt vmcnt(0)" ::: "memory");
    __syncthreads();
    if (leader) {
        unsigned* bar = b.bar;
        __builtin_amdgcn_s_waitcnt(0);
        unsigned nloc = b.st[0], nx = b.st[1];
        if (nloc == 0u) { xcd_barrier_complete(bar, b.x, nloc, nx); b.st[0] = nloc; b.st[1] = nx; }
        const unsigned old = xb_add(&bar[XB_XSUB(b.x)], 1u);
        const unsigned gen = old / nloc;
        if (old + 1u == (gen + 1u) * nloc) {
            __builtin_amdgcn_fence(__ATOMIC_RELEASE, "agent");
            asm volatile("s_waitcnt vmcnt(0)" ::: "memory");
            const unsigned og = xb_add(&bar[XB_TOP], 1u);
            const unsigned tg = og / nx;
            if (og + 1u == (tg + 1u) * nx) xb_add(&bar[XB_TOPGEN], 1u);
            else XB_SPIN(xb_ld(&bar[XB_TOPGEN]) == tg, bar);
            __builtin_amdgcn_fence(__ATOMIC_ACQUIRE, "agent");
            xb_add(&bar[XB_XGEN(b.x)], 1u);
            asm volatile("s_waitcnt vmcnt(0)" ::: "memory");
        } else {
            XB_SPIN(xb_ld(&bar[XB_XGEN(b.x)]) == gen, bar);
            __builtin_amdgcn_fence(__ATOMIC_ACQUIRE, "agent");
            asm volatile("s_waitcnt vmcnt(0)" ::: "memory");
        }
    }
    __syncthreads();
}

#if defined(__HIP_DEVICE_COMPILE__)
#define LOAD_ARGS() ({ const __attribute__((address_space(4))) Args* kp_ = (const __attribute__((address_space(4))) Args*)__builtin_amdgcn_kernarg_segment_ptr(); asm volatile("" : "+s"(kp_)); *kp_; })
#else
#define LOAD_ARGS() (a_unused)
#endif
#define OPQ_TID() ({ int t_ = wave_idx * 64 + (int)__builtin_amdgcn_mbcnt_hi(~0u, __builtin_amdgcn_mbcnt_lo(~0u, 0u)); asm volatile("" : "+v"(t_)); t_; })
__global__ void __launch_bounds__(512, 2) mk_fwd(Args a_unused) {
    extern __shared__ __attribute__((aligned(16))) unsigned char lds_raw[];
    LAS unsigned char* lds = (LAS unsigned char*)lds_raw;
    cg::grid_group grid = cg::this_grid();
#define OPQ_S(x) ({ int s_ = (x); asm volatile("" : "+s"(s_)); s_; })
#ifndef LSEQ
#define LSEQ 0x87654321ull
#endif
    volatile LAS unsigned* xst = (volatile LAS unsigned*)(lds + LDS_BYTES - 512);
    if (threadIdx.x < 2) xst[threadIdx.x] = 0u;
    __syncthreads();
    const int wave_idx = __builtin_amdgcn_readfirstlane((int)(threadIdx.x >> 6));
    { const Args a = LOAD_ARGS(); (void)xcd_barrier_post((unsigned*)(a.ws + WS_CTL), xst, OPQ_TID() == 0); }
#define GRID_BARRIER() do { const Args ab_ = LOAD_ARGS(); XcdBarrier xb_; xb_.bar = (unsigned*)(ab_.ws + WS_CTL); xb_.x = xb_xcc_id(); xb_.st = (volatile LAS unsigned*)(lds + LDS_BYTES - 512); xcd_barrier(xb_, OPQ_TID() == 0); } while (0)
    { const Args a = LOAD_ARGS(); p0_prologue(lds, a, OPQ_TID(), OPQ_S(gridDim.x), 0); }
    grid.sync();
    { const Args a = LOAD_ARGS(); p0_prologue(lds, a, OPQ_TID(), OPQ_S(gridDim.x), 1); }
    { const Args a = LOAD_ARGS(); __syncthreads(); p1_norm<false>(lds, a, 0, a.in[0], OPQ_TID(), OPQ_S(gridDim.x)); }
    GRID_BARRIER();
    for (int layer = 0; layer < 2; ++layer) {
        for (unsigned long long sq = (layer == 0 ? (LSEQ >> 4) : LSEQ); sq != 0ull; sq >>= 4) {
            const int p = (int)(sq & 15ull);
            const Args a = LOAD_ARGS();
            const int G = OPQ_S(gridDim.x), bid = OPQ_S(blockIdx.x);
            unsigned char* ws = a.ws;
            bf16* proj = (bf16*)(ws + WS_PROJ); bf16* H = (bf16*)(ws + WS_H);
            bf16* Rg = proj + 8 * TS;
            const bf16* WinT = (const bf16*)(ws + WS_WIN) + (size_t)layer * WIN_L;
            if (p == 1) { if (layer == 0) p1_norm<false>(lds, a, layer, a.in[0], OPQ_TID(), G); else p1_norm<true>(lds, a, layer, a.out, OPQ_TID(), G); }
            else if (p == 2) { pg8::Gemm<1024, 1024, 1024, T / 256, 21, 31, 0, 512> g{H, WinT};
                pg8::EpiProj E{proj, TP}; pg8::gemm_phase(lds, g, G, bid, E, OPQ_TID()); }
            else if (p >= 3 && p <= 5) {
                LayerP P;
                P.sinks = a.in[6] + layer * 8; P.pool_scale = a.in[8] + layer * 512; P.conv_w = a.in[9] + layer * 4096; P.conv_b = a.in[10] + layer * 1024;
                P.a_log = a.in[12] + layer * 8; P.d_skip = a.in[13] + layer * 8; P.ssm_norm_w = a.in[14] + layer * 512;
                P.poolT = (const bf16*)(ws + WS_POOL) + (size_t)layer * 4 * 128 * 128;
                P.proj = proj; P.dt = (const float*)(ws + WS_DT); P.cd = (float*)(ws + WS_CD); P.st_ret = (bf16*)(ws + WS_EXT + ST_RET); P.st_ssd = (bf16*)(ws + WS_EXT + ST_SSD);
                const int tid = OPQ_TID();
                if (p == 3) {
                    const int nk = (3072 + G - 1) / G, rot = (bid * 5) % nk;
                    for (int k = 0; k < nk; ++k) { const int it = bid + G * ((k + rot) % nk); if (it >= 3072) continue;
                        int nxt = k + 1 < nk ? bid + G * ((k + 1 + rot) % nk) : -1; if (nxt >= 3072) nxt = -1;
                        if (it < 512) swa_unit(lds, P, it >> 6, (it >> 1) & 31, it & 1, tid, nxt);
                        else if (it < 1024) { const int q = it - 512; ssdU_unit(lds, P, q >> 6, (q >> 1) & 31, q & 1, tid, nxt); }
                        else if (it < 2048) { const int q = it - 1024; retU_unit(lds, P, q >> 7, (q >> 2) & 31, q & 3, tid, nxt); }
                        else { const int q = it - 2048; pool_unit(lds, P, q >> 2, q & 3, tid, nxt); }
                    }
                }
                else if (p == 4) scan_phase(P, bid * 512 + tid);
                else {
                    const int nk = (1536 + G - 1) / G, rot = (bid * 5) % nk;
                    for (int k = 0; k < nk; ++k) { const int it = bid + G * ((k + rot) % nk); if (it >= 1536) continue;
                        int nxt = k + 1 < nk ? bid + G * ((k + 1 + rot) % nk) : -1; if (nxt >= 1536) nxt = -1;
                        if (it < 512) ssdO_unit(lds, P, it >> 6, (it >> 1) & 31, it & 1, tid, nxt);
                        else { const int q = it - 512; retO_unit(lds, P, q >> 7, (q >> 2) & 31, q & 3, tid, nxt); }
                    }
                }
            }
            else if (p == 6) { pg8::Gemm<512, 512, 512, T / 256, 16, 31, 0, 512, true> g{(const bf16*)((unsigned char*)a.out + (size_t)T * D * 2), (const bf16*)(ws + WS_WMG8 + (size_t)layer * 4096 * 1024)};
                pg8::EpiGate E{Rg, (const float*)(ws + WS_SH), (const float*)(ws + WS_SW) + layer * 4096}; pg8::gemm_phase(lds, g, G, bid, E, OPQ_TID()); }
            else if (p == 7) { pg8::Gemm<TP, 2048, 2048, T / 256, 4, 31, 0, 2 * (long long)TS> g{proj, (const bf16*)(ws + WS_WUP) + (size_t)layer * 1024 * 2048};
                pg8::EpiMergeUp E{Rg, H}; pg8::gemm_phase(lds, g, G, bid, E, OPQ_TID()); }
            else if (p == 8) { pg8::Gemm<TP, 1024, 1024, T / 256, 4, 31, 0, 2 * (long long)TS> g{H, (const bf16*)(ws + WS_WOUT) + (size_t)layer * 1024 * 1024};
                const float* gate = (const float*)(ws + WS_MOD) + (size_t)layer * 8 * 3072 + 2048;
                if (layer == 0) { pg8::EpiOut<false> E{a.in[0], (bf16*)a.out, gate}; pg8::gemm_phase(lds, g, G, bid, E, OPQ_TID()); }
                else { pg8::EpiOut<true> E{a.out, proj, gate}; pg8::gemm_phase(lds, g, G, bid, E, OPQ_TID()); } }
            GRID_BARRIER();
        }
    }
    { const Args a = LOAD_ARGS(); p7_final(a, OPQ_TID(), OPQ_S(gridDim.x)); }
}
constexpr int N_PHASES = 1 + 2 * 8 + 1;

extern "C" void kernel_launch(void* const* d_in, const int* in_sizes, int n_in, void* d_out, int out_size, void* d_ws, size_t ws_size, hipStream_t stream) {
    static int grid = 0;
    if (grid == 0) {
        if (n_in != 18 || out_size != T * D || ws_size < WS_END) { fprintf(stderr, "kernel_launch: unexpected shapes (n_in %d out %d ws %zu); nothing launched\n", n_in, out_size, ws_size); grid = -1; return; }
        int dev = 0, cus = 0, per_cu = 0;
        if (hipGetDevice(&dev) != hipSuccess || hipDeviceGetAttribute(&cus, hipDeviceAttributeMultiprocessorCount, dev) != hipSuccess) { grid = -1; return; }
        if (hipFuncSetAttribute((const void*)mk_fwd, hipFuncAttributeMaxDynamicSharedMemorySize, LDS_BYTES) != hipSuccess) { fprintf(stderr, "kernel_launch: hipFuncSetAttribute failed\n"); grid = -1; return; }
        if (hipOccupancyMaxActiveBlocksPerMultiprocessor(&per_cu, (const void*)mk_fwd, 512, LDS_BYTES) != hipSuccess || per_cu < 1) { fprintf(stderr, "kernel_launch: occupancy query says %d\n", per_cu); per_cu = 1; }
        (void)hipGetLastError();
        grid = cus;
    }
    if (grid < 0) return;
    if (hipMemsetAsync((char*)d_ws + WS_CTL, 0, CTL_BYTES, stream) != hipSuccess) { fprintf(stderr, "kernel_launch: memset failed\n"); return; }
    Args a{};
    for (int i = 0; i < 18; ++i) a.in[i] = (const float*)d_in[i];
    a.out = (float*)d_out; a.ws = (unsigned char*)d_ws; a.ph_lo = 0; a.ph_hi = N_PHASES;
    void* args[] = {&a};
    hipError_t e = hipLaunchCooperativeKernel((void*)mk_fwd, dim3(grid), dim3(512), args, LDS_BYTES, stream);
    if (e != hipSuccess) fprintf(stderr, "cooperative launch failed: %s (grid %d)\n", hipGetErrorString(e), grid);
}
```

```cpp
#include <hip/hip_runtime.h>
#include <hip/hip_cooperative_groups.h>
#include <cstdio>
#include <cstdint>
namespace cg = cooperative_groups;

#define LAS __attribute__((address_space(3)))
#define DI __device__ __forceinline__
typedef unsigned short bf16;
typedef short bf16x8 __attribute__((ext_vector_type(8)));
typedef short s16x4 __attribute__((ext_vector_type(4)));
typedef short v4i16_t __attribute__((ext_vector_type(4)));
typedef float f32x2 __attribute__((ext_vector_type(2)));
typedef float f32x4 __attribute__((ext_vector_type(4)));
typedef float f32x16 __attribute__((ext_vector_type(16)));
typedef unsigned u32x2 __attribute__((ext_vector_type(2)));
typedef unsigned u32x4 __attribute__((ext_vector_type(4)));
typedef __bf16 bf2_t __attribute__((ext_vector_type(2)));
typedef int v4i_t __attribute__((ext_vector_type(4)));
typedef int v8i_t __attribute__((ext_vector_type(8)));

constexpr int BATCH = 8, SEQ = 4096, T = BATCH * SEQ, D = 1024, DIN = 9480, LDP = 5376;
constexpr float EPS = 1e-6f;
constexpr int TP = 256;
constexpr size_t TS = (size_t)T * 256;
constexpr int C_RG = 0, C_SG = 512, C_PG = 1024, C_MZ = 1536, C_RQ = 2048, C_RK = 2304, C_RV = 2560, C_SQ = 3072, C_SK = 3584, C_SV = 3712, C_PX = 3840, C_MX = 4352;
constexpr int S_RQ = 0, S_RK = 256, S_RV = 512, S_RG = 1024, S_SQ = 1536, S_SK = 2048, S_SV = 2176, S_SG = 2304, S_PX = 2816, S_PG = 3328, S_MX = 3840, S_MZ = 4864, S_DT = 5376, S_MG = 5384;
constexpr int WIN_ROWS = 9472;

constexpr size_t MiB = 1u << 20;
constexpr size_t WS_CTL = 0, CTL_BYTES = 64 * 1024;
constexpr size_t WS_MOD = 1 * MiB;
constexpr size_t WS_DT = 2 * MiB;
constexpr size_t WS_CD = 3 * MiB;
constexpr size_t WS_WIN = 4 * MiB;
constexpr size_t WIN_L = (size_t)WIN_ROWS * 1024;
constexpr size_t WS_WUP = 41 * MiB;
constexpr size_t WS_WOUT = 49 * MiB;
constexpr size_t WS_POOL = 53 * MiB;
constexpr size_t WS_H = 54 * MiB;
constexpr size_t WS_PROJ = 118 * MiB;
constexpr size_t WS_EXT = 454 * MiB;
constexpr size_t WS_WMG8 = 502 * MiB;
constexpr size_t WS_SW = 510 * MiB;
constexpr size_t WS_SH = 510 * MiB + 65536;
constexpr size_t WS_END = 511 * MiB;
constexpr size_t ST_RET = 0, ST_SSD = 16 * MiB;

constexpr int LDS_BYTES = 163840;

DI unsigned pk2(float lo, float hi) { f32x2 v = {lo, hi}; bf2_t b = __builtin_convertvector(v, bf2_t); return __builtin_bit_cast(unsigned, b); }
DI float bflo(unsigned u) { return __uint_as_float(u << 16); }
DI float bfhi(unsigned u) { return __uint_as_float(u & 0xffff0000u); }
DI float bf2f(bf16 v) { return __uint_as_float(((unsigned)v) << 16); }
DI unsigned pk4_i8(float a, float b, float c, float d) {
    const int ia = (int)rintf(fminf(fmaxf(a, -127.f), 127.f)), ib = (int)rintf(fminf(fmaxf(b, -127.f), 127.f)), ic = (int)rintf(fminf(fmaxf(c, -127.f), 127.f)), id = (int)rintf(fminf(fmaxf(d, -127.f), 127.f));
    return (unsigned)(ia & 255) | ((unsigned)(ib & 255) << 8) | ((unsigned)(ic & 255) << 16) | ((unsigned)id << 24);
}
DI float silu_f(float x) { return x * __builtin_amdgcn_rcpf(1.f + __expf(-x)); }
DI float sigm_f(float x) { return __builtin_amdgcn_rcpf(1.f + __expf(-x)); }
DI float lane_xor(float v, int o, int lane) { return __int_as_float(__builtin_amdgcn_ds_bpermute((lane ^ o) << 2, __float_as_int(v))); }
DI float lane_up(float v, int o, int lane) { const int src = lane >= o ? lane - o : lane; return __int_as_float(__builtin_amdgcn_ds_bpermute(src << 2, __float_as_int(v))); }
DI float wave_sum(float v, int lane) {
#pragma unroll
    for (int o = 1; o < 64; o <<= 1) v += lane_xor(v, o, lane);
    return v;
}
DI bf16* pcol(bf16* proj, int c) { return proj + (size_t)(c >> 8) * TS + (c & 255); }
DI const bf16* pcol(const bf16* proj, int c) { return proj + (size_t)(c >> 8) * TS + (c & 255); }
DI int crow(int r, int h) { return (r & 3) + 8 * (r >> 2) + 4 * h; }
#define MFMA32(a, b, c) __builtin_amdgcn_mfma_f32_32x32x16_bf16((a), (b), (c), 0, 0, 0)
DI bf16x8 pack8(float a0, float a1, float a2, float a3, float a4, float a5, float a6, float a7) {
    u32x4 p; p.x = pk2(a0, a1); p.y = pk2(a2, a3); p.z = pk2(a4, a5); p.w = pk2(a6, a7); return __builtin_bit_cast(bf16x8, p);
}
DI u32x4 zero4() { unsigned z = 0u; asm volatile("" : "+v"(z)); return (u32x4){z, z, z, z}; }
DI s16x4 trr(const LAS unsigned char* p) { return __builtin_bit_cast(s16x4, __builtin_amdgcn_ds_read_tr16_b64_v4i16((LAS v4i16_t*)p)); }
DI bf16x8 tr_frag(const LAS unsigned char* img, int stride, int klo, int khi, int col0, int lane) {
    const int i16 = lane & 15, q = i16 >> 2, p = i16 & 3, blk = (lane >> 4) & 1;
    const LAS unsigned char* a = img + q * stride + (col0 + 16 * blk + 4 * p) * 2;
    const s16x4 lo = trr(a + klo * stride), hi = trr(a + khi * stride);
    return (bf16x8){lo[0], lo[1], lo[2], lo[3], hi[0], hi[1], hi[2], hi[3]};
}
DI u32x4 gate8(u32x4 ov, u32x4 gv) {
    u32x4 r;
    r.x = pk2(bflo(ov.x) * bflo(gv.x), bfhi(ov.x) * bfhi(gv.x)); r.y = pk2(bflo(ov.y) * bflo(gv.y), bfhi(ov.y) * bfhi(gv.y));
    r.z = pk2(bflo(ov.z) * bflo(gv.z), bfhi(ov.z) * bfhi(gv.z)); r.w = pk2(bflo(ov.w) * bflo(gv.w), bfhi(ov.w) * bfhi(gv.w));
    return r;
}
DI void unpack8(u32x4 w, float* f) { f[0] = bflo(w.x); f[1] = bfhi(w.x); f[2] = bflo(w.y); f[3] = bfhi(w.y); f[4] = bflo(w.z); f[5] = bfhi(w.z); f[6] = bflo(w.w); f[7] = bfhi(w.w); }

namespace pg8 {
constexpr int BM = 256, BK = 64, HALF = 128, HTB = HALF * BK * 2, STAGE_BYTES = 8 * HTB, NXCD = 8, WGM = 8;
__host__ __device__ __forceinline__ int lds_byte(int r, int c) { const int st = (r >> 4) * 2 + (c >> 5), rr = r & 15, cc = c & 31, ob = rr * 64 + cc * 2; return st * 1024 + (ob ^ (((ob >> 9) & 1) << 5)); }
__host__ __device__ __forceinline__ void stage_rc(int b, int& R, int& C) { const int st = b / 1024, sb = b % 1024, swz = sb ^ (((sb >> 9) & 1) << 5); R = (st >> 1) * 16 + swz / 64; C = (st & 1) * 32 + (swz % 64) / 2; }
__host__ __device__ __forceinline__ int perm32(int rho) { const int n = rho >> 4, i = rho & 15; return 8 * (i >> 2) + 4 * n + (i & 3); }

struct Unit { int pm, pn; };
template <int LDA_, int LDB_, int K_, int NM_, int NN_, int ASH_, long long AGS_, long long AKTS_, bool FP8_ = false> struct Gemm { const bf16* A; const bf16* Bt; static constexpr bool fp8 = FP8_; static constexpr int lda = LDA_, ldb = LDB_, K = K_, nM = NM_, nN = NN_, a_shift = ASH_; static constexpr long long a_gstride = AGS_, a_kts = AKTS_; };

template <int nM, int nN> struct StaticOrder {
    static constexpr int nwg = nM * nN; int G, c;
    __device__ void init(int G_, int c_) { G = G_; c = c_; }
    __device__ bool next(int i, Unit& u) const {
        const long L = (long)i * G + c; if (L >= nwg) return false;
        int wgid = (int)L; { const int q = nwg / NXCD, r = nwg % NXCD, xcd = wgid % NXCD, off = wgid / NXCD; wgid = (xcd < r ? xcd * (q + 1) : r * (q + 1) + (xcd - r) * q) + off; }
        const int nig = WGM * nN, gid = wgid / nig, fm = gid * WGM, gsz = (nM - fm) < WGM ? (nM - fm) : WGM;
        u.pm = fm + ((wgid % nig) % gsz); u.pn = (wgid % nig) / gsz; return true;
    }
};

template <class GemmT, class Epi>
__device__ __forceinline__ void gemm_phase(LAS unsigned char* lds, const GemmT g, int G_, int c_, const Epi& E, const int tid) {
    StaticOrder<GemmT::nM, GemmT::nN> S; S.init(G_, c_);
    const int wid = __builtin_amdgcn_readfirstlane(tid >> 6), lane = tid & 63, wr = wid >> 2, wc = wid & 3, fr = lane & 15, fq = lane >> 4;
    constexpr int nt = GemmT::K / BK;
    unsigned voffA[2], voffB[2];
#pragma unroll
    for (int i = 0; i < 2; ++i) { int R, C; stage_rc(tid * 16 + i * 8192, R, C); const int Rb = Epi::PERM ? ((R & ~31) + perm32(R & 31)) : R;
        voffA[i] = (unsigned)(R * g.lda + C) * 2u; voffB[i] = (unsigned)(Rb * g.ldb + C) * 2u; }
    const size_t kstep = (size_t)(BK * 2);
    const size_t hstepA = (size_t)HALF * g.lda * 2, hstepB = (size_t)HALF * g.ldb * 2;
    const unsigned ldsw = (unsigned)wid * 1024u;
    const int aoff = lds_byte(wr * 64 + fr, fq * 8), boff = lds_byte(wc * 32 + fr, fq * 8);
#define PG8_SA(b, h) (((b) * 2 + (h)) * HTB)
#define PG8_SB(b, h) ((4 + (b) * 2 + (h)) * HTB)
#define PG8_STAGE(bufoff, gbase, voff) do { _Pragma("unroll") for (int _i = 0; _i < 2; ++_i) \
        __builtin_amdgcn_global_load_lds((const unsigned*)((const char*)(gbase) + (voff)[_i]), (LAS unsigned*)(lds + (bufoff) + ldsw + _i * 8192), 16, 0, 0); } while (0)
#define PG8_LDA(dst, b, h) do { _Pragma("unroll") for (int m = 0; m < 4; ++m) _Pragma("unroll") for (int k = 0; k < 2; ++k) dst[m][k] = *(const LAS bf16x8*)(lds + PG8_SA(b, h) + aoff + m * 2048 + k * 1024); } while (0)
#define PG8_LDB(dst, b, h) do { _Pragma("unroll") for (int n = 0; n < 2; ++n) _Pragma("unroll") for (int k = 0; k < 2; ++k) dst[n][k] = *(const LAS bf16x8*)(lds + PG8_SB(b, h) + boff + n * 2048 + k * 1024); } while (0)
#define PG8_CAT8(x0, x1) __builtin_shufflevector(__builtin_bit_cast(v4i_t, (x0)), __builtin_bit_cast(v4i_t, (x1)), 0, 1, 2, 3, 4, 5, 6, 7)
#define PG8_MMA(ai, bj, At, Bt) do { __builtin_amdgcn_s_setprio(1); _Pragma("unroll") for (int m = 0; m < 4; ++m) _Pragma("unroll") for (int n = 0; n < 2; ++n) { \
        if constexpr (GemmT::fp8) { _Pragma("unroll") for (int k = 0; k < 2; ++k) acc[ai][bj][m][n] = __builtin_bit_cast(f32x4, __builtin_amdgcn_mfma_i32_16x16x64_i8(__builtin_bit_cast(v4i_t, Bt[n][k]), __builtin_bit_cast(v4i_t, At[m][k]), __builtin_bit_cast(v4i_t, acc[ai][bj][m][n]), 0, 0, 0)); } \
        else { _Pragma("unroll") for (int k = 0; k < 2; ++k) acc[ai][bj][m][n] = __builtin_amdgcn_mfma_f32_16x16x32_bf16(Bt[n][k], At[m][k], acc[ai][bj][m][n], 0, 0, 0); } } \
        __builtin_amdgcn_s_setprio(0); } while (0)
#define PG8_WAIT_V(n) asm volatile("s_waitcnt vmcnt(" #n ")" ::: "memory")
#define PG8_WAIT_L(n) asm volatile("s_waitcnt lgkmcnt(" #n ")" ::: "memory")
#define PG8_BAR __builtin_amdgcn_s_barrier()
#define PG8_SCHED __builtin_amdgcn_sched_barrier(0)
#define PG8_APTR(u) ((const char*)g.A + 2 * ((size_t)(u).pm * 256 * g.lda + (size_t)((u).pn >> g.a_shift) * g.a_gstride))
#define PG8_BPTR(u) ((const char*)g.Bt + 2 * ((size_t)(u).pn * 256 * g.ldb))
    Unit cur, nxt; int ui = 0;
    if (!S.next(0, cur)) return;
    f32x4 acc[2][2][4][2];
#pragma unroll
    for (int a = 0; a < 2; ++a)
#pragma unroll
        for (int b = 0; b < 2; ++b)
#pragma unroll
            for (int m = 0; m < 4; ++m)
#pragma unroll
                for (int n = 0; n < 2; ++n) acc[a][b][m][n] = (f32x4){0.f, 0.f, 0.f, 0.f};
    bf16x8 At[4][2], B0[2][2], B1[2][2];
    unsigned pf0 = 0u, pf1 = 0u;
    const char* cA = PG8_APTR(cur); const char* cB = PG8_BPTR(cur);
    PG8_STAGE(PG8_SB(0, 0), cB, voffB); PG8_STAGE(PG8_SB(0, 1), cB + hstepB, voffB); PG8_STAGE(PG8_SA(0, 0), cA, voffA); PG8_STAGE(PG8_SA(0, 1), cA + hstepA, voffA);
    if (wr == 1) PG8_BAR;
    PG8_WAIT_V(2); PG8_BAR;
    PG8_STAGE(PG8_SB(1, 0), cB + kstep, voffB); PG8_STAGE(PG8_SA(1, 0), cA + kstep, voffA); PG8_STAGE(PG8_SB(1, 1), cB + hstepB + kstep, voffB);
    PG8_WAIT_V(6); PG8_BAR;
    for (;;) {
        const bool has_next = S.next(ui + 1, nxt);
        const char* nA = has_next ? PG8_APTR(nxt) : cA; const char* nB = has_next ? PG8_BPTR(nxt) : cB;
        constexpr int tseg = Epi::HOOK ? 8 : nt;
#pragma nounroll
        for (int t0 = 0; t0 < nt; t0 += tseg) {
        if constexpr (Epi::HOOK) { if (t0 != 0) { E.hook(acc, cur, (t0 >> 3) - 1, wr, wc, lane); asm volatile("" :: "v"(pf0), "v"(pf1)); } E.prefetch(cur, t0 >> 3, wr, wc, lane, pf0, pf1); }
#pragma nounroll
        for (int t = t0; t < t0 + tseg; t += 2) {
            const bool last = (t == nt - 2);
            const char* a1 = cA + (size_t)(t >> 2) * GemmT::a_kts + (size_t)((t & 3) + 1) * kstep;
            const char* a2 = last ? nA : cA + (size_t)((t + 2) >> 2) * GemmT::a_kts + (size_t)((t + 2) & 3) * kstep; const char* b2 = last ? nB : cB + (size_t)(t + 2) * kstep;
            const char* a3 = a2 + kstep; const char* b3 = b2 + kstep;
            PG8_LDB(B0, 0, 0); PG8_LDB(B1, 0, 1); PG8_SCHED; PG8_LDA(At, 0, 0); PG8_STAGE(PG8_SA(1, 1), a1 + hstepA, voffA);
            PG8_WAIT_V(8); PG8_WAIT_L(0); PG8_BAR; PG8_MMA(0, 0, At, B0); PG8_MMA(0, 1, At, B1); PG8_BAR; PG8_SCHED;
            PG8_LDA(At, 0, 1); PG8_STAGE(PG8_SB(0, 0), b2, voffB); PG8_STAGE(PG8_SB(0, 1), b2 + hstepB, voffB); PG8_STAGE(PG8_SA(0, 0), a2, voffA);
            PG8_WAIT_V(8); PG8_WAIT_L(0); PG8_BAR; PG8_MMA(1, 0, At, B0); PG8_MMA(1, 1, At, B1); PG8_BAR; PG8_SCHED;
            PG8_LDB(B0, 1, 0); PG8_LDB(B1, 1, 1); PG8_SCHED; PG8_LDA(At, 1, 0); PG8_STAGE(PG8_SA(0, 1), a2 + hstepA, voffA);
            PG8_WAIT_V(8); PG8_WAIT_L(0); PG8_BAR; PG8_MMA(0, 0, At, B0); PG8_MMA(0, 1, At, B1); PG8_BAR; PG8_SCHED;
            PG8_LDA(At, 1, 1); PG8_STAGE(PG8_SB(1, 0), b3, voffB); PG8_STAGE(PG8_SB(1, 1), b3 + hstepB, voffB); PG8_STAGE(PG8_SA(1, 0), a3, voffA);
            PG8_WAIT_V(8); PG8_WAIT_L(0); PG8_BAR; PG8_MMA(1, 0, At, B0); PG8_MMA(1, 1, At, B1); PG8_BAR; PG8_SCHED;
        }
        }
        if (wr == 0) PG8_BAR;
        { int le = lane; asm volatile("" : "+v"(le)); E(acc, cur, wr, wc, le & 15, le >> 4); if constexpr (Epi::HOOK) asm volatile("" :: "v"(pf0), "v"(pf1)); }
        if (!has_next) break;
#pragma unroll
        for (int a = 0; a < 2; ++a)
#pragma unroll
            for (int b = 0; b < 2; ++b)
#pragma unroll
                for (int m = 0; m < 4; ++m)
#pragma unroll
                    for (int n = 0; n < 2; ++n) acc[a][b][m][n] = (f32x4){0.f, 0.f, 0.f, 0.f};
        cur = nxt; cA = nA; cB = nB; ++ui;
        if (wr == 1) PG8_BAR;
    }
    PG8_WAIT_V(0);
    PG8_BAR;
#undef PG8_SA
#undef PG8_SB
#undef PG8_STAGE
#undef PG8_LDA
#undef PG8_LDB
#undef PG8_MMA
#undef PG8_CAT8
#undef PG8_WAIT_V
#undef PG8_WAIT_L
#undef PG8_BAR
#undef PG8_SCHED
#undef PG8_APTR
#undef PG8_BPTR
}

struct EpiProj {
    static constexpr bool PERM = true, HOOK = false;
    DI void hook(f32x4 (&)[2][2][4][2], const Unit&, int, int, int, int) const {}
    DI void prefetch(const Unit&, int, int, int, int, unsigned&, unsigned&) const {}
    bf16* O; int ldc;
    DI void operator()(const f32x4 (&acc)[2][2][4][2], const Unit& u, int wr, int wc, int fr, int fq) const {
        const int row0 = u.pm * BM + wr * 64 + fr, col0 = wc * 32 + 8 * fq;
        bf16* Ot = O + (size_t)u.pn * TS;
#pragma unroll
        for (int ai = 0; ai < 2; ++ai)
#pragma unroll
            for (int m = 0; m < 4; ++m) { bf16* rowp = Ot + (size_t)(row0 + ai * HALF + m * 16) * ldc + col0;
#pragma unroll
                for (int bj = 0; bj < 2; ++bj) { f32x4 v0 = acc[ai][bj][m][0], v1 = acc[ai][bj][m][1];
                    if (u.pn < 8) {
#pragma unroll
                        for (int j = 0; j < 4; ++j) { v0[j] = silu_f(v0[j]); v1[j] = silu_f(v1[j]); } }
                    u32x4 w; w.x = pk2(v0[0], v0[1]); w.y = pk2(v0[2], v0[3]); w.z = pk2(v1[0], v1[1]); w.w = pk2(v1[2], v1[3]);
                    __builtin_nontemporal_store(w, (u32x4*)(rowp + bj * HALF)); } }
    }
};
DI size_t r_off(int k, int pm, int dq, int ai, int bj, int m, int wr, int wc, int lane, int n) {
    return ((((((((((size_t)k * 128 + pm) * 4 + dq) * 2 + ai) * 2 + bj) * 4 + m) * 2 + wr) * 4 + wc) * 64 + lane) * 8) + n * 4;
}
struct EpiGate {
    static constexpr bool PERM = false, HOOK = false;
    bf16* R; const float* sH; const float* sW;
    DI void operator()(const f32x4 (&acc)[2][2][4][2], const Unit& u, int wr, int wcp, int fr, int fq) const {
        const int lane = fq * 16 + fr, dq = u.pn >> 2, bj = (u.pn >> 1) & 1, wc = 2 * (u.pn & 1) + (wcp >> 1), n = wcp & 1;
        f32x4 cs[4];
#pragma unroll
        for (int i = 0; i < 4; ++i) cs[i] = *(const f32x4*)(sW + u.pn * BM + (i >> 1) * HALF + wcp * 32 + (i & 1) * 16 + 4 * fq);
        float rsv[2][4];
#pragma unroll
        for (int ai = 0; ai < 2; ++ai)
#pragma unroll
            for (int m = 0; m < 4; ++m) rsv[ai][m] = sH[u.pm * BM + ai * HALF + wr * 64 + m * 16 + fr];
#pragma unroll
        for (int ai = 0; ai < 2; ++ai)
#pragma unroll
            for (int m = 0; m < 4; ++m) {
                const float rs = rsv[ai][m];
                float e[4][4];
#pragma unroll
                for (int i = 0; i < 4; ++i)
#pragma unroll
                    for (int j = 0; j < 4; ++j) { const float gq = (float)__float_as_int(acc[ai][i >> 1][m][i & 1][j]) * rs * cs[i][j]; e[i][j] = 1.f + __expf(-fminf(fmaxf(gq, -30.f), 30.f)); }
#pragma unroll
                for (int k = 0; k < 4; ++k) { float r[4];
#pragma unroll
                    for (int j = 0; j < 4; ++j) r[j] = k < 3 ? e[k + 1][j] * __builtin_amdgcn_rcpf(e[k][j]) : __builtin_amdgcn_rcpf(e[3][j]);
                    u32x2 w; w.x = pk2(r[0], r[1]); w.y = pk2(r[2], r[3]);
                    __builtin_nontemporal_store(w, (u32x2*)(R + r_off(k, u.pm, dq, ai, bj, m, wr, wc, lane, n))); }
            }
    }
    DI void hook(f32x4 (&)[2][2][4][2], const Unit&, int, int, int, int) const {}
    DI void prefetch(const Unit&, int, int, int, int, unsigned&, unsigned&) const {}
};
struct EpiMergeUp {
    static constexpr bool PERM = true, HOOK = true;
    const bf16* R; bf16* O;
    DI void scale(f32x4 (&acc)[2][2][4][2], const Unit& u, int k, int wr, int wc, int lane) const {
        asm volatile("" : "+v"(lane));
        const bf16* base = R + r_off(k, u.pm, u.pn, 0, 0, 0, wr, wc, lane, 0);
#pragma unroll
        for (int ai = 0; ai < 2; ++ai) {
            u32x4 v[2][4];
#pragma unroll
            for (int bj = 0; bj < 2; ++bj)
#pragma unroll
                for (int m = 0; m < 4; ++m) v[bj][m] = *(const u32x4*)(base + (size_t)((ai * 2 + bj) * 4 + m) * 4096);
#pragma unroll
            for (int bj = 0; bj < 2; ++bj)
#pragma unroll
                for (int m = 0; m < 4; ++m) { const u32x4 w = v[bj][m];
                    acc[ai][bj][m][0] *= (f32x4){bflo(w.x), bfhi(w.x), bflo(w.y), bfhi(w.y)}; acc[ai][bj][m][1] *= (f32x4){bflo(w.z), bfhi(w.z), bflo(w.w), bfhi(w.w)}; }
            __builtin_amdgcn_sched_barrier(0);
        }
    }
    DI void hook(f32x4 (&acc)[2][2][4][2], const Unit& u, int k, int wr, int wc, int lane) const { scale(acc, u, k, wr, wc, lane); }
    DI void prefetch(const Unit& u, int k, int wr, int wc, int lane, unsigned& p0, unsigned& p1) const {
        asm volatile("" : "+v"(lane));
        const char* b = (const char*)(R + r_off(k, u.pm, u.pn, 0, 0, 0, wr, wc, 0, 0)) + (lane >> 3) * 8192 + (lane & 7) * 128;
        p0 = *(const unsigned*)b; p1 = *(const unsigned*)(b + 8 * 8192);
    }
    DI void operator()(f32x4 (&acc)[2][2][4][2], const Unit& u, int wr, int wc, int fr, int fq) const {
        scale(acc, u, 3, wr, wc, fq * 16 + fr);
        const int row0 = u.pm * BM + wr * 64 + fr, col0 = wc * 32 + 8 * fq;
        bf16* Ot = O + (size_t)u.pn * TS;
#pragma unroll
        for (int ai = 0; ai < 2; ++ai)
#pragma unroll
            for (int m = 0; m < 4; ++m) { bf16* rowp = Ot + (size_t)(row0 + ai * HALF + m * 16) * TP + col0;
#pragma unroll
                for (int bj = 0; bj < 2; ++bj) { const f32x4 v0 = acc[ai][bj][m][0], v1 = acc[ai][bj][m][1];
                    u32x4 w; w.x = pk2(v0[0], v0[1]); w.y = pk2(v0[2], v0[3]); w.z = pk2(v1[0], v1[1]); w.w = pk2(v1[2], v1[3]);
                    __builtin_nontemporal_store(w, (u32x4*)(rowp + bj * HALF)); } }
    }
};
template <bool IN_BF16> struct EpiOut {
    static constexpr bool PERM = true, HOOK = false;
    DI void hook(f32x4 (&)[2][2][4][2], const Unit&, int, int, int, int) const {}
    DI void prefetch(const Unit&, int, int, int, int, unsigned&, unsigned&) const {}
    const void* xin; bf16* xout; const float* gate;
    DI void operator()(const f32x4 (&acc)[2][2][4][2], const Unit& u, int wr, int wc, int fr, int fq) const {
        const int row0 = u.pm * BM + wr * 64 + fr, col0 = u.pn * BM + wc * 32 + 8 * fq;
        const float* gp = gate + (size_t)(u.pm >> 4) * 3072 + col0;
        f32x4 gv[2][2];
#pragma unroll
        for (int bj = 0; bj < 2; ++bj)
#pragma unroll
            for (int n = 0; n < 2; ++n) gv[bj][n] = *(const f32x4*)(gp + bj * HALF + n * 4);
        if constexpr (IN_BF16) {
            u32x4 xb[2][4][2];
#pragma unroll
            for (int ai = 0; ai < 2; ++ai)
#pragma unroll
                for (int m = 0; m < 4; ++m)
#pragma unroll
                    for (int bj = 0; bj < 2; ++bj) xb[ai][m][bj] = *(const u32x4*)((const bf16*)xin + (size_t)(row0 + ai * HALF + m * 16) * D + col0 + bj * HALF);
#pragma unroll
            for (int ai = 0; ai < 2; ++ai)
#pragma unroll
                for (int m = 0; m < 4; ++m) { const size_t off = (size_t)(row0 + ai * HALF + m * 16) * D + col0;
#pragma unroll
                    for (int bj = 0; bj < 2; ++bj) { const u32x4 w = xb[ai][m][bj];
                        f32x4 x0 = (f32x4){bflo(w.x), bfhi(w.x), bflo(w.y), bfhi(w.y)}, x1 = (f32x4){bflo(w.z), bfhi(w.z), bflo(w.w), bfhi(w.w)};
                        x0 += gv[bj][0] * acc[ai][bj][m][0]; x1 += gv[bj][1] * acc[ai][bj][m][1];
                        u32x4 o; o.x = pk2(x0[0], x0[1]); o.y = pk2(x0[2], x0[3]); o.z = pk2(x1[0], x1[1]); o.w = pk2(x1[2], x1[3]);
                        __builtin_nontemporal_store(o, (u32x4*)(xout + off + bj * HALF)); } }
        } else {
#pragma unroll
            for (int ai = 0; ai < 2; ++ai) {
                f32x4 xf[4][2][2];
#pragma unroll
                for (int m = 0; m < 4; ++m) { const size_t off = (size_t)(row0 + ai * HALF + m * 16) * D + col0;
#pragma unroll
                    for (int bj = 0; bj < 2; ++bj) { xf[m][bj][0] = *(const f32x4*)((const float*)xin + off + bj * HALF); xf[m][bj][1] = *(const f32x4*)((const float*)xin + off + bj * HALF + 4); } }
#pragma unroll
                for (int m = 0; m < 4; ++m) { const size_t off = (size_t)(row0 + ai * HALF + m * 16) * D + col0;
#pragma unroll
                    for (int bj = 0; bj < 2; ++bj) { f32x4 x0 = xf[m][bj][0], x1 = xf[m][bj][1];
                        x0 += gv[bj][0] * acc[ai][bj][m][0]; x1 += gv[bj][1] * acc[ai][bj][m][1];
                        u32x4 o; o.x = pk2(x0[0], x0[1]); o.y = pk2(x0[2], x0[3]); o.z = pk2(x1[0], x1[1]); o.w = pk2(x1[2], x1[3]);
                        __builtin_nontemporal_store(o, (u32x4*)(xout + off + bj * HALF)); } }
            }
        }
    }
};
}

DI void lds_barrier() { asm volatile("s_waitcnt lgkmcnt(0)" ::: "memory"); __builtin_amdgcn_s_barrier(); asm volatile("" ::: "memory"); }
struct LayerP {
    const float *sinks, *pool_scale, *conv_w, *conv_b, *a_log, *d_skip, *ssm_norm_w;
    const bf16* poolT;
    bf16* proj; const float* dt; float* cd; bf16* st_ret; bf16* st_ssd;
};


DI void pf_item(const LayerP& P, int phase, int it, int tid, unsigned& p0, unsigned& p1, unsigned& p2) {
    if (it < 0) return;
    const bf16* proj = P.proj;
    if (phase == 3) {
        if (it < 512) { const int b = it >> 6, nb = (it >> 1) & 31, hkv = it & 1; const size_t t0 = (size_t)b * SEQ + (size_t)nb * 128;
            const int key = tid >> 1; const size_t krow = (nb > 0 || key >= 128) ? t0 + key - 128 : t0;
            p0 = *(const unsigned*)(pcol(proj, ((tid & 1) ? C_SV : C_SK) + hkv * 64) + krow * TP);
            p1 = *(const unsigned*)(pcol(proj, C_SQ + hkv * 256 + (tid & 3) * 64) + (t0 + (tid >> 2)) * TP);
            p2 = *(const unsigned*)(pcol(proj, C_SG + hkv * 256 + (tid & 3) * 64) + (t0 + (tid >> 2)) * TP);
        } else if (it < 1024) { const int q = it - 512, b = q >> 6, c = (q >> 1) & 31, grp = q & 1; const size_t t0 = (size_t)b * SEQ + (size_t)c * 128;
            p0 = *(const unsigned*)(pcol(proj, C_MX + grp * 256 + (tid & 3) * 64) + (t0 + (tid >> 2)) * TP);
            p1 = *(const unsigned*)(pcol(proj, C_MX + 512 + grp * 128 + (tid & 1) * 64) + (t0 + ((tid & 255) >> 1)) * TP);
        } else if (it < 2048) { const int q = it - 1024, b = q >> 7, c = (q >> 2) & 31, h = q & 3; const size_t t0 = (size_t)b * SEQ + (size_t)c * 128;
            p0 = *(const unsigned*)(pcol(proj, C_RV + h * 128 + (tid & 1) * 64) + (t0 + ((tid & 255) >> 1)) * TP);
            p1 = *(const unsigned*)(pcol(proj, C_RK + h * 64) + (t0 + (tid & 127)) * TP);
        } else { const int q = it - 2048, tile = q >> 2, g = q & 3; const size_t t0 = (size_t)tile * 128;
            p0 = *(const unsigned*)(pcol(proj, ((tid & 256) ? C_PG : C_PX) + g * 128 + (tid & 1) * 64) + (t0 + ((tid & 255) >> 1)) * TP);
        }
    } else {
        if (it < 512) { const int b = it >> 6, c = (it >> 1) & 31, grp = it & 1; const size_t t0 = (size_t)b * SEQ + (size_t)c * 128;
            p0 = *(const unsigned*)(pcol(proj, C_MX + grp * 256 + (tid & 3) * 64) + (t0 + (tid >> 2)) * TP);
            p1 = *(const unsigned*)(pcol(proj, C_MX + ((tid & 256) ? 768 : 512) + grp * 128 + (tid & 1) * 64) + (t0 + ((tid & 255) >> 1)) * TP);
            p2 = *(const unsigned*)(pcol(proj, C_MZ + grp * 256 + (tid & 3) * 64) + (t0 + (tid >> 2)) * TP);
        } else { const int q = it - 512, b = q >> 7, c = (q >> 2) & 31, h = q & 3; const size_t t0 = (size_t)b * SEQ + (size_t)c * 128;
            p0 = (tid < 256) ? *(const unsigned*)(pcol(proj, ((tid & 128) ? C_RQ : C_RK) + h * 64) + (t0 + (tid & 127)) * TP)
                             : *(const unsigned*)(pcol(proj, C_RV + h * 128 + (tid & 1) * 64) + (t0 + ((tid & 255) >> 1)) * TP);
            p1 = *(const unsigned*)(pcol(proj, C_RG + h * 128 + (tid & 1) * 64) + (t0 + ((tid & 255) >> 1)) * TP);
            p2 = *(const unsigned*)(P.st_ret + ((size_t)((b * 32 + c) * 4 + h)) * 8192 + (tid & 127) * 64);
        }
    }
}
#define PF_DECL unsigned pf0_ = 0u, pf1_ = 0u, pf2_ = 0u
#define PF_ISSUE(phase) pf_item(P, (phase), nxt, tid, pf0_, pf1_, pf2_)
#define PF_DONE asm volatile("" :: "v"(pf0_), "v"(pf1_), "v"(pf2_))

DI void swa_unit(LAS unsigned char* lds, const LayerP& P, int b, int nb, int hkv, int tid, int nxt = -1) {
    asm volatile("" : "+v"(tid));
    const int lane = tid & 63, wave = tid >> 6, r32 = lane & 31, h2 = lane >> 5;
    LAS unsigned char* Ksm = lds;
    LAS unsigned char* Vsm = lds + 256 * 144;
    bf16* proj = P.proj;
    const size_t t0 = (size_t)b * SEQ + (size_t)nb * 128;
    LAS unsigned char* QO = lds + 256 * 144 + 256 * 192;
    {
      u32x4 kr[4], vr[4], qr[8];
      const bf16* qsrc = pcol(proj, C_SQ + hkv * 256) + t0 * TP;
#pragma unroll
      for (int i = 0; i < 4; ++i) { const int p = tid + 512 * i, key = p >> 3, ch = p & 7;
          kr[i] = zero4(); vr[i] = kr[i];
          if (nb > 0 || key >= 128) { const size_t ro = (t0 + key - 128) * TP + ch * 8; kr[i] = __builtin_nontemporal_load((const u32x4*)(pcol(proj, C_SK + hkv * 64) + ro)); vr[i] = __builtin_nontemporal_load((const u32x4*)(pcol(proj, C_SV + hkv * 64) + ro)); } }
#pragma unroll
      for (int i = 0; i < 8; ++i) { const int p = tid + 512 * i, row = p >> 5, c32 = p & 31; qr[i] = *(const u32x4*)(qsrc + (size_t)row * TP + c32 * 8); }
      __builtin_amdgcn_sched_barrier(0);
#pragma unroll
      for (int i = 0; i < 4; ++i) { const int p = tid + 512 * i, key = p >> 3, ch = p & 7;
          *(LAS u32x4*)(Ksm + key * 144 + ch * 16) = kr[i]; *(LAS u32x4*)(Vsm + key * 192 + ch * 16) = vr[i]; }
#pragma unroll
      for (int i = 0; i < 8; ++i) { const int p = tid + 512 * i, row = p >> 5, c32 = p & 31;
          *(LAS u32x4*)(QO + ((c32 >> 3) * 128 + row) * 144 + (c32 & 7) * 16) = qr[i]; } }
    lds_barrier();
    PF_DECL; PF_ISSUE(3);
    const int gi = wave >> 1, hq = hkv * 4 + gi;
    const float slope2 = __builtin_amdgcn_exp2f(-(float)(hq + 1)) * 1.44269504f, sink2 = P.sinks[hq] * 1.44269504f;
#pragma nounroll
    for (int sub = 0; sub < 2; ++sub) {
        const int r0 = (wave & 1) * 64 + sub * 32, r = r0 + r32, kt0 = r0 >> 5;
        LAS unsigned char* qo_row = QO + (gi * 128 + r) * 144;
        bf16x8 qf[4];
#pragma unroll
        for (int ks = 0; ks < 4; ++ks) qf[ks] = *(const LAS bf16x8*)(qo_row + (16 * ks + 8 * h2) * 2);
        f32x16 st[5];
#pragma unroll
        for (int i = 0; i < 5; ++i) {
#pragma unroll
            for (int e = 0; e < 16; ++e) st[i][e] = 0.f;
#pragma unroll
            for (int ks = 0; ks < 4; ++ks) { const bf16x8 a = *(const LAS bf16x8*)(Ksm + (32 * (kt0 + i) + r32) * 144 + (16 * ks + 8 * h2) * 2); st[i] = MFMA32(a, qf[ks], st[i]); }
            __builtin_amdgcn_sched_barrier(0);
        }
        const int dbase = 128 + r32 - 4 * h2;
        const int lo = dbase - (nb > 0 ? 127 : min(127, r));
        const float sd = slope2 * (float)dbase, sinkr = sink2 + sd, ninf = -__builtin_inff();
#pragma unroll
        for (int i = 0; i < 5; ++i) {
#pragma unroll
            for (int e = 0; e < 16; ++e) { const int c = 32 * i + (e & 3) + 8 * (e >> 2);
                float sv = fmaf(slope2, (float)c, st[i][e]);
                if (i == 0) sv = (c >= lo) ? sv : ninf;
                if (i == 4) sv = (c <= dbase) ? sv : ninf;
                st[i][e] = sv; }
            __builtin_amdgcn_sched_barrier(0);
        }
        if (nb == 0) {
#pragma unroll
            for (int i = 1; i < 4; ++i)
#pragma unroll
                for (int e = 0; e < 16; ++e) { const int c = 32 * i + (e & 3) + 8 * (e >> 2); st[i][e] = (c >= lo) ? st[i][e] : ninf; }
        }
        float m = sinkr;
#pragma unroll
        for (int i = 0; i < 5; ++i)
#pragma unroll
            for (int e = 0; e < 16; ++e) m = fmaxf(m, st[i][e]);
        { float mt = m - sd; mt = fmaxf(mt, lane_xor(mt, 32, lane)); m = mt + sd; }
        float sum = 0.f;
#pragma unroll
        for (int i = 0; i < 5; ++i) {
#pragma unroll
            for (int e = 0; e < 16; ++e) { const float p = __builtin_amdgcn_exp2f(st[i][e] - m); st[i][e] = p; sum += p; }
            __builtin_amdgcn_sched_barrier(0);
        }
        sum += lane_xor(sum, 32, lane);
        const float inv = __builtin_amdgcn_rcpf(sum + __builtin_amdgcn_exp2f(sinkr - m));
        f32x16 o[2];
#pragma unroll
        for (int mt = 0; mt < 2; ++mt)
#pragma unroll
            for (int e = 0; e < 16; ++e) o[mt][e] = 0.f;
#pragma unroll
        for (int i = 0; i < 5; ++i)
#pragma unroll
            for (int s2 = 0; s2 < 2; ++s2) {
                const bf16x8 bp = pack8(st[i][8 * s2], st[i][8 * s2 + 1], st[i][8 * s2 + 2], st[i][8 * s2 + 3], st[i][8 * s2 + 4], st[i][8 * s2 + 5], st[i][8 * s2 + 6], st[i][8 * s2 + 7]);
                const int k0 = 32 * (kt0 + i) + 16 * s2 + 4 * h2;
#pragma unroll
                for (int mt = 0; mt < 2; ++mt) { const bf16x8 a = tr_frag(Vsm, 192, k0, k0 + 8, 32 * mt, lane); o[mt] = MFMA32(a, bp, o[mt]); }
                __builtin_amdgcn_sched_barrier(0);
            }
#pragma unroll
        for (int mt = 0; mt < 2; ++mt)
#pragma unroll
            for (int g4 = 0; g4 < 4; ++g4) { u32x2 w; w.x = pk2(o[mt][4 * g4] * inv, o[mt][4 * g4 + 1] * inv); w.y = pk2(o[mt][4 * g4 + 2] * inv, o[mt][4 * g4 + 3] * inv);
                *(LAS u32x2*)(qo_row + (32 * mt + 8 * g4 + 4 * h2) * 2) = w; }
    }
    { bf16* gbase = pcol(proj, C_SG + hq * 64) + t0 * TP + (size_t)((wave & 1) * 64 + (lane >> 3)) * TP + (lane & 7) * 8;
      u32x4 gv[8];
#pragma unroll
      for (int it = 0; it < 8; ++it) gv[it] = *(const u32x4*)(gbase + (size_t)(it * 8) * TP);
#pragma unroll
      for (int it = 0; it < 8; ++it) { const int row = (wave & 1) * 64 + it * 8 + (lane >> 3), c8 = lane & 7;
          *(u32x4*)(gbase + (size_t)(it * 8) * TP) = gate8(*(const LAS u32x4*)(QO + (gi * 128 + row) * 144 + c8 * 16), gv[it]); } }
    PF_DONE;
    lds_barrier();
}

DI void pool_unit(LAS unsigned char* lds, const LayerP& P, int tile, int g, int tid, int nxt = -1) {
    asm volatile("" : "+v"(tid));
    const int lane = tid & 63, wave = tid >> 6, r32 = lane & 31, h2 = lane >> 5;
    LAS unsigned char* Usm = lds;
    LAS unsigned char* Ysm = lds + 46080;
    LAS unsigned char* Wsm = lds + 46080 + 34816;
    bf16* proj = P.proj;
    const size_t t0 = (size_t)tile * 128; const int seq0 = (int)(t0 & (SEQ - 1)), w = 2 << g;
    {
      u32x4 ur[5], wr4[4];
#pragma unroll
      for (int i = 0; i < 5; ++i) { const int p = tid + 512 * i, row = p >> 4, ch = p & 15, l = row - 15;
          ur[i] = zero4();
          if (row < 143 && (l >= 0 || seq0 > 0)) ur[i] = __builtin_nontemporal_load((const u32x4*)(pcol(proj, C_PX + g * 128) + (size_t)((long)t0 + l) * TP + ch * 8)); }
#pragma unroll
      for (int i = 0; i < 4; ++i) { const int p = tid + 512 * i, e = p >> 4, ch = p & 15; wr4[i] = *(const u32x4*)(P.poolT + (size_t)(g * 128 + e) * 128 + ch * 8); }
      __builtin_amdgcn_sched_barrier(0);
#pragma unroll
      for (int i = 0; i < 5; ++i) { const int p = tid + 512 * i, row = p >> 4, ch = p & 15;
          if (row < 144) *(LAS u32x4*)(Usm + row * 320 + ch * 16) = ur[i]; }
#pragma unroll
      for (int i = 0; i < 4; ++i) { const int p = tid + 512 * i, e = p >> 4, ch = p & 15; const u32x4 wv = wr4[i];
          *(LAS u32x2*)(Wsm + e * 264 + ch * 16) = (u32x2){wv.x, wv.y}; *(LAS u32x2*)(Wsm + e * 264 + ch * 16 + 8) = (u32x2){wv.z, wv.w}; } }
    lds_barrier();
    PF_DECL; PF_ISSUE(3);
    const int tt = wave >> 1, et0 = 2 * (wave & 1);
    bf16x8 mf[3];
    { const int cnt = min(seq0 + 32 * tt + r32 + 1, w); const float ic = 1.f / (float)cnt;
#pragma unroll
      for (int ks = 0; ks < 3; ++ks) { float mv[8];
#pragma unroll
          for (int i = 0; i < 8; ++i) { const int dd = 16 * ks + 8 * h2 + i - 15 - r32; mv[i] = ((dd > -w && dd <= 0) ? ic : 0.f) - (dd == 0 ? 1.f : 0.f); }
          mf[ks] = pack8(mv[0], mv[1], mv[2], mv[3], mv[4], mv[5], mv[6], mv[7]); } }
    f32x16 acc[2];
#pragma unroll
    for (int et = 0; et < 2; ++et)
#pragma unroll
        for (int e = 0; e < 16; ++e) acc[et][e] = 0.f;
#pragma unroll
    for (int ct = 0; ct < 4; ++ct) {
        f32x16 Dm;
#pragma unroll
        for (int e = 0; e < 16; ++e) Dm[e] = 0.f;
#pragma unroll
        for (int ks = 0; ks < 3; ++ks) { const int k0 = 32 * tt + 16 * ks + 8 * h2; const bf16x8 a = tr_frag(Usm, 320, k0, k0 + 4, 32 * ct, lane); Dm = MFMA32(a, mf[ks], Dm); }
#pragma unroll
        for (int s2 = 0; s2 < 2; ++s2) {
            const bf16x8 bp = pack8(Dm[8 * s2], Dm[8 * s2 + 1], Dm[8 * s2 + 2], Dm[8 * s2 + 3], Dm[8 * s2 + 4], Dm[8 * s2 + 5], Dm[8 * s2 + 6], Dm[8 * s2 + 7]);
#pragma unroll
            for (int et = 0; et < 2; ++et) { const LAS unsigned char* wp = Wsm + (32 * (et0 + et) + r32) * 264 + (32 * ct + 16 * s2 + 4 * h2) * 2;
                const u32x2 lo = *(const LAS u32x2*)wp, hi = *(const LAS u32x2*)(wp + 16);
                const bf16x8 a = __builtin_bit_cast(bf16x8, (u32x4){lo.x, lo.y, hi.x, hi.y});
                acc[et] = MFMA32(a, bp, acc[et]); }
        }
    }
#pragma unroll
    for (int et = 0; et < 2; ++et)
#pragma unroll
        for (int g4 = 0; g4 < 4; ++g4) { u32x2 o; o.x = pk2(acc[et][4 * g4], acc[et][4 * g4 + 1]); o.y = pk2(acc[et][4 * g4 + 2], acc[et][4 * g4 + 3]);
            *(LAS u32x2*)(Ysm + (32 * tt + r32) * 272 + (32 * (et0 + et) + 8 * g4 + 4 * h2) * 2) = o; }
    { bf16* gbase = pcol(proj, C_PG + g * 128) + t0 * TP;
      u32x4 gvv[4];
#pragma unroll
      for (int it = 0; it < 4; ++it) gvv[it] = *(const u32x4*)(gbase + (size_t)(32 * tt + it * 8 + (lane >> 3)) * TP + 64 * (wave & 1) + (lane & 7) * 8);
      const f32x4 s0 = *(const f32x4*)(P.pool_scale + g * 128 + 64 * (wave & 1) + (lane & 7) * 8), s1 = *(const f32x4*)(P.pool_scale + g * 128 + 64 * (wave & 1) + (lane & 7) * 8 + 4);
      __builtin_amdgcn_sched_barrier(0);
#pragma unroll
      for (int it = 0; it < 4; ++it) { const int row = 32 * tt + it * 8 + (lane >> 3), ch = 64 * (wave & 1) + (lane & 7) * 8;
          bf16* gp = gbase + (size_t)row * TP + ch; const u32x4 yv = *(const LAS u32x4*)(Ysm + row * 272 + ch * 2), gv = gvv[it];
          u32x4 o; o.x = pk2(bflo(yv.x) * s0[0] * bflo(gv.x), bfhi(yv.x) * s0[1] * bfhi(gv.x)); o.y = pk2(bflo(yv.y) * s0[2] * bflo(gv.y), bfhi(yv.y) * s0[3] * bfhi(gv.y));
          o.z = pk2(bflo(yv.z) * s1[0] * bflo(gv.z), bfhi(yv.z) * s1[1] * bfhi(gv.z)); o.w = pk2(bflo(yv.w) * s1[2] * bflo(gv.w), bfhi(yv.w) * s1[3] * bfhi(gv.w));
          *(u32x4*)gp = o; } }
    PF_DONE;
    lds_barrier();
}

DI float ret_lg(int h) { return log2f(1.f - exp2f(-5.f - (float)h)); }
DI void retU_unit(LAS unsigned char* lds, const LayerP& P, int b, int c, int h, int tid, int nxt = -1) {
    asm volatile("" : "+v"(tid));
    const int lane = tid & 63, wave = tid >> 6, r32 = lane & 31, h2 = lane >> 5;
    LAS unsigned char* Ksm = lds;
    LAS unsigned char* Vsm = lds + 128 * 192;
    const bf16* proj = P.proj; const size_t t0 = (size_t)b * SEQ + (size_t)c * 128; const float lg = ret_lg(h);
    u32x4 kr[2], vr[4];
#pragma unroll
    for (int i = 0; i < 2; ++i) { const int p = tid + 512 * i, s = p >> 3, ch = p & 7; kr[i] = __builtin_nontemporal_load((const u32x4*)(pcol(proj, C_RK + h * 64) + (t0 + s) * TP + ch * 8)); }
#pragma unroll
    for (int i = 0; i < 4; ++i) { const int p = tid + 512 * i, s = p >> 4, ch = p & 15; vr[i] = __builtin_nontemporal_load((const u32x4*)(pcol(proj, C_RV + h * 128) + (t0 + s) * TP + ch * 8)); }
    __builtin_amdgcn_sched_barrier(0);
#pragma unroll
    for (int i = 0; i < 2; ++i) { const int p = tid + 512 * i, s = p >> 3, ch = p & 7; float f[8];
        unpack8(kr[i], f); const float dk = __builtin_amdgcn_exp2f(lg * (float)(127 - s));
        u32x4 o; o.x = pk2(f[0] * dk, f[1] * dk); o.y = pk2(f[2] * dk, f[3] * dk); o.z = pk2(f[4] * dk, f[5] * dk); o.w = pk2(f[6] * dk, f[7] * dk);
        *(LAS u32x4*)(Ksm + s * 192 + ch * 16) = o; }
#pragma unroll
    for (int i = 0; i < 4; ++i) { const int p = tid + 512 * i, s = p >> 4, ch = p & 15;
        *(LAS u32x4*)(Vsm + s * 320 + ch * 16) = vr[i]; }
    lds_barrier();
    PF_DECL; PF_ISSUE(3);
    const int mt = wave >> 2, nt = wave & 3;
    f32x16 acc;
#pragma unroll
    for (int e = 0; e < 16; ++e) acc[e] = 0.f;
#pragma unroll
    for (int ks = 0; ks < 8; ++ks) { const int k0 = 16 * ks + 8 * h2;
        const bf16x8 a = tr_frag(Ksm, 192, k0, k0 + 4, 32 * mt, lane), bb = tr_frag(Vsm, 320, k0, k0 + 4, 32 * nt, lane);
        acc = MFMA32(a, bb, acc); }
    bf16* St = P.st_ret + ((size_t)((b * 32 + c) * 4 + h)) * 8192;
#pragma unroll
    for (int g4 = 0; g4 < 4; ++g4) { u32x2 o; o.x = pk2(acc[4 * g4], acc[4 * g4 + 1]); o.y = pk2(acc[4 * g4 + 2], acc[4 * g4 + 3]);
        *(u32x2*)(St + ((nt * 4 + 2 * mt + (g4 >> 1)) * 64 + (g4 & 1) * 32 + r32) * 8 + 4 * h2) = o; }
    PF_DONE;
    lds_barrier();
}

DI void retO_unit(LAS unsigned char* lds, const LayerP& P, int b, int c, int h, int tid, int nxt = -1) {
    asm volatile("" : "+v"(tid));
    const int lane = tid & 63, wave = tid >> 6, r32 = lane & 31, h2 = lane >> 5;
    LAS unsigned char* Ksm = lds;
    LAS unsigned char* Vsm = lds + 128 * 144;
    LAS unsigned char* Qsm = lds + 128 * 144 + 128 * 320;
    LAS unsigned char* Osm = Qsm + 128 * 144;
    LAS float* red = (LAS float*)(Osm + 128 * 272);
    bf16* proj = P.proj; const size_t t0 = (size_t)b * SEQ + (size_t)c * 128; const float lg = ret_lg(h);
    const int lt = wave >> 1, dvh = wave & 1, l = 32 * lt + r32;
    u32x4 kr[2], qr[2], vr[4]; bf16x8 sfr[2][4];
#pragma unroll
    for (int i = 0; i < 2; ++i) { const int p = tid + 512 * i, s = p >> 3, ch = p & 7;
        kr[i] = __builtin_nontemporal_load((const u32x4*)(pcol(proj, C_RK + h * 64) + (t0 + s) * TP + ch * 8));
        qr[i] = __builtin_nontemporal_load((const u32x4*)(pcol(proj, C_RQ + h * 64) + (t0 + s) * TP + ch * 8)); }
#pragma unroll
    for (int i = 0; i < 4; ++i) { const int p = tid + 512 * i, s = p >> 4, ch = p & 15;
        vr[i] = __builtin_nontemporal_load((const u32x4*)(pcol(proj, C_RV + h * 128) + (t0 + s) * TP + ch * 8)); }
    { const bf16* St = P.st_ret + ((size_t)((b * 32 + c) * 4 + h)) * 8192;
#pragma unroll
      for (int m2 = 0; m2 < 2; ++m2)
#pragma unroll
          for (int ks = 0; ks < 4; ++ks) sfr[m2][ks] = *(const bf16x8*)(St + (((2 * dvh + m2) * 4 + ks) * 64 + lane) * 8); }
    __builtin_amdgcn_sched_barrier(0);
#pragma unroll
    for (int i = 0; i < 2; ++i) { const int p = tid + 512 * i, s = p >> 3, ch = p & 7;
        *(LAS u32x4*)(Ksm + s * 144 + ch * 16) = kr[i]; *(LAS u32x4*)(Qsm + s * 144 + ch * 16) = qr[i]; }
#pragma unroll
    for (int i = 0; i < 4; ++i) { const int p = tid + 512 * i, s = p >> 4, ch = p & 15;
        *(LAS u32x4*)(Vsm + s * 320 + ch * 16) = vr[i]; }
    lds_barrier();
    PF_DECL; PF_ISSUE(5);
    bf16x8 qf[4];
#pragma unroll
    for (int ks = 0; ks < 4; ++ks) qf[ks] = *(const LAS bf16x8*)(Qsm + l * 144 + (16 * ks + 8 * h2) * 2);
    f32x16 acc[2], cr[2];
#pragma unroll
    for (int m2 = 0; m2 < 2; ++m2)
#pragma unroll
        for (int e = 0; e < 16; ++e) { acc[m2][e] = 0.f; cr[m2][e] = 0.f; }
    for (int st = 0; st <= lt; ++st) {
        f32x16 G;
#pragma unroll
        for (int e = 0; e < 16; ++e) G[e] = 0.f;
#pragma unroll
        for (int ks = 0; ks < 4; ++ks) { const bf16x8 a = *(const LAS bf16x8*)(Ksm + (32 * st + r32) * 144 + (16 * ks + 8 * h2) * 2); G = MFMA32(a, qf[ks], G); }
#pragma unroll
        for (int e = 0; e < 16; ++e) { const int s = 32 * st + crow(e, h2); G[e] = (s <= l) ? G[e] * __builtin_amdgcn_exp2f(lg * (float)(l - s)) : 0.f; }
#pragma unroll
        for (int s2 = 0; s2 < 2; ++s2) {
            const bf16x8 bp = pack8(G[8 * s2], G[8 * s2 + 1], G[8 * s2 + 2], G[8 * s2 + 3], G[8 * s2 + 4], G[8 * s2 + 5], G[8 * s2 + 6], G[8 * s2 + 7]);
            const int k0 = 32 * st + 16 * s2 + 4 * h2;
#pragma unroll
            for (int m2 = 0; m2 < 2; ++m2) { const bf16x8 a = tr_frag(Vsm, 320, k0, k0 + 8, 32 * (2 * dvh + m2), lane); acc[m2] = MFMA32(a, bp, acc[m2]); }
        }
    }
#pragma unroll
    for (int m2 = 0; m2 < 2; ++m2)
#pragma unroll
        for (int ks = 0; ks < 4; ++ks) cr[m2] = MFMA32(sfr[m2][ks], qf[ks], cr[m2]);
    const float qd = __builtin_amdgcn_exp2f(lg * (float)(l + 1));
    float ss = 0.f;
#pragma unroll
    for (int m2 = 0; m2 < 2; ++m2)
#pragma unroll
        for (int e = 0; e < 16; ++e) { const float v = acc[m2][e] + qd * cr[m2][e]; acc[m2][e] = v; ss += v * v; }
    ss += lane_xor(ss, 32, lane);
    if (h2 == 0) red[wave * 32 + r32] = ss;
    lds_barrier();
    const float rstd = rsqrtf((red[wave * 32 + r32] + red[(wave ^ 1) * 32 + r32]) * (1.f / 128.f) + EPS);
#pragma unroll
    for (int m2 = 0; m2 < 2; ++m2)
#pragma unroll
        for (int g4 = 0; g4 < 4; ++g4) { u32x2 o; o.x = pk2(acc[m2][4 * g4] * rstd, acc[m2][4 * g4 + 1] * rstd); o.y = pk2(acc[m2][4 * g4 + 2] * rstd, acc[m2][4 * g4 + 3] * rstd);
            *(LAS u32x2*)(Osm + l * 272 + (32 * (2 * dvh + m2) + 8 * g4 + 4 * h2) * 2) = o; }
    { bf16* gbase = pcol(proj, C_RG + h * 128) + t0 * TP;
      u32x4 gvv[4];
#pragma unroll
      for (int it = 0; it < 4; ++it) gvv[it] = *(const u32x4*)(gbase + (size_t)(32 * lt + it * 8 + (lane >> 3)) * TP + 64 * dvh + (lane & 7) * 8);
#pragma unroll
      for (int it = 0; it < 4; ++it) { const int row = 32 * lt + it * 8 + (lane >> 3), dv = 64 * dvh + (lane & 7) * 8;
          bf16* gp = gbase + (size_t)row * TP + dv;
          *(u32x4*)gp = gate8(*(const LAS u32x4*)(Osm + row * 272 + dv * 2), gvv[it]); } }
    PF_DONE;
    lds_barrier();
}

constexpr int SSD_TAB = 0, SSD_ACS = 2048, SSD_SSQ = 4096;
template <int PASS>
DI void ssd_stage(LAS unsigned char* lds, const LayerP& P, int b, int c, int grp, int tid, int xoff, int boff, int bstride, int coff) {
    const int lane = tid & 63, wave = tid >> 6;
    LAS float* dtl = (LAS float*)(lds + SSD_TAB); LAS float* acs = (LAS float*)(lds + SSD_ACS);
    const size_t t0 = (size_t)b * SEQ + (size_t)c * 128;
    const int chunk = lane, seg = wave;
    const int kind = chunk < 32 ? 0 : (chunk < 48 ? 1 : 2);
    const bool active = !(PASS == 1 && kind == 2);
    const int ch0 = kind == 0 ? grp * 256 + chunk * 8 : (kind == 1 ? 512 + grp * 128 + (chunk - 32) * 8 : 768 + grp * 128 + (chunk - 48) * 8);
    u32x4 raw[19];
    { const bf16* gp = pcol(P.proj, C_MX + ch0) + (t0 + 16 * seg) * TP;
      const bool hv = (seg > 0) || (c > 0);
      const u32x4 zz = zero4();
#pragma unroll
      for (int i = 0; i < 19; ++i) { raw[i] = zz; if (active && (i >= 3 || hv)) raw[i] = *(const u32x4*)(gp + ((long)i - 3) * TP); } }
    if (wave < 4) { const int hh = grp * 4 + wave; const float a = -__expf(P.a_log[hh]);
        const float d0 = P.dt[(t0 + 2 * lane) * 8 + hh], d1 = P.dt[(t0 + 2 * lane + 1) * 8 + hh];
        const float s0 = d0 * a, s1 = s0 + d1 * a; float tot = s1;
#pragma unroll
        for (int off = 1; off < 64; off <<= 1) { const float v = lane_up(tot, off, lane); if (lane >= off) tot += v; }
        const float ex = tot - s1;
        acs[wave * 128 + 2 * lane] = ex + s0; acs[wave * 128 + 2 * lane + 1] = ex + s1; dtl[wave * 128 + 2 * lane] = d0; dtl[wave * 128 + 2 * lane + 1] = d1; }
    lds_barrier();
    if (active) {
        float cw[4][8], cb[8];
#pragma unroll
        for (int j = 0; j < 4; ++j) { const f32x4 w0 = *(const f32x4*)(P.conv_w + j * 1024 + ch0), w1 = *(const f32x4*)(P.conv_w + j * 1024 + ch0 + 4);
            cw[j][0] = w0[0]; cw[j][1] = w0[1]; cw[j][2] = w0[2]; cw[j][3] = w0[3]; cw[j][4] = w1[0]; cw[j][5] = w1[1]; cw[j][6] = w1[2]; cw[j][7] = w1[3]; }
        { const f32x4 w0 = *(const f32x4*)(P.conv_b + ch0), w1 = *(const f32x4*)(P.conv_b + ch0 + 4);
            cb[0] = w0[0]; cb[1] = w0[1]; cb[2] = w0[2]; cb[3] = w0[3]; cb[4] = w1[0]; cb[5] = w1[1]; cb[6] = w1[2]; cb[7] = w1[3]; }
        float u3[8], u2[8], u1[8], cur[8];
        unpack8(raw[0], u3); unpack8(raw[1], u2); unpack8(raw[2], u1);
        const int r = chunk >> 3;
        const float aend = acs[(r & 3) * 128 + 127];
#pragma unroll
        for (int i = 0; i < 16; ++i) { const int l = 16 * seg + i;
            unpack8(raw[3 + i], cur);
            float o[8];
#pragma unroll
            for (int e = 0; e < 8; ++e) { const float v = cb[e] + cw[0][e] * u3[e] + cw[1][e] * u2[e] + cw[2][e] * u1[e] + cw[3][e] * cur[e]; o[e] = silu_f(v); u3[e] = u2[e]; u2[e] = u1[e]; u1[e] = cur[e]; }
            if (kind == 0) { float sc = dtl[r * 128 + l]; if (PASS == 1) sc *= __expf(aend - acs[r * 128 + l]);
#pragma unroll
                for (int e = 0; e < 8; ++e) o[e] *= sc; }
            u32x4 w; w.x = pk2(o[0], o[1]); w.y = pk2(o[2], o[3]); w.z = pk2(o[4], o[5]); w.w = pk2(o[6], o[7]);
            if (kind == 0) *(LAS u32x4*)(lds + xoff + l * 576 + chunk * 16) = w;
            else if (kind == 1) *(LAS u32x4*)(lds + boff + l * bstride + (chunk - 32) * 16) = w;
            else *(LAS u32x4*)(lds + coff + l * 272 + (chunk - 48) * 16) = w; }
    }
    lds_barrier();
}

DI void ssdU_unit(LAS unsigned char* lds, const LayerP& P, int b, int c, int grp, int tid, int nxt = -1) {
    asm volatile("" : "+v"(tid));
    const int lane = tid & 63, wave = tid >> 6, r32 = lane & 31, h2 = lane >> 5;
    constexpr int XOFF = 6144, BOFF = 6144 + 128 * 576;
    ssd_stage<1>(lds, P, b, c, grp, tid, XOFF, BOFF, 320, 0);
    PF_DECL; PF_ISSUE(3);
    const int r = wave >> 1, pt = wave & 1, hh = grp * 4 + r;
    f32x16 acc[4];
#pragma unroll
    for (int nt = 0; nt < 4; ++nt)
#pragma unroll
        for (int e = 0; e < 16; ++e) acc[nt][e] = 0.f;
#pragma unroll
    for (int ks = 0; ks < 8; ++ks) { const int k0 = 16 * ks + 8 * h2;
        const bf16x8 xb = tr_frag(lds + XOFF, 576, k0, k0 + 4, r * 64 + 32 * pt, lane);
#pragma unroll
        for (int nt = 0; nt < 4; ++nt) { const bf16x8 a = tr_frag(lds + BOFF, 320, k0, k0 + 4, 32 * nt, lane); acc[nt] = MFMA32(a, xb, acc[nt]); }
    }
    bf16* Sb = P.st_ssd + ((size_t)((b * 32 + c) * 8 + hh)) * 8192;
#pragma unroll
    for (int nt = 0; nt < 4; ++nt)
#pragma unroll
        for (int g4 = 0; g4 < 4; ++g4) { u32x2 o; o.x = pk2(acc[nt][4 * g4], acc[nt][4 * g4 + 1]); o.y = pk2(acc[nt][4 * g4 + 2], acc[nt][4 * g4 + 3]);
            *(u32x2*)(Sb + ((pt * 8 + 2 * nt + (g4 >> 1)) * 64 + (g4 & 1) * 32 + r32) * 8 + 4 * h2) = o; }
    if (tid < 4) P.cd[(b * 32 + c) * 8 + grp * 4 + tid] = __expf(((LAS float*)(lds + SSD_ACS))[tid * 128 + 127]);
    PF_DONE;
    lds_barrier();
}

DI void ssdO_unit(LAS unsigned char* lds, const LayerP& P, int b, int c, int grp, int tid, int nxt = -1) {
    asm volatile("" : "+v"(tid));
    const int lane = tid & 63, wave = tid >> 6, r32 = lane & 31, h2 = lane >> 5;
    constexpr int BOFF = 6144, COFF = 6144 + 34816, XOFF = 6144 + 2 * 34816;
    ssd_stage<2>(lds, P, b, c, grp, tid, XOFF, BOFF, 272, COFF);
    PF_DECL; PF_ISSUE(5);
    LAS float* dtl = (LAS float*)(lds + SSD_TAB); LAS float* acs = (LAS float*)(lds + SSD_ACS); LAS float* ssq = (LAS float*)(lds + SSD_SSQ);
    bf16* proj = P.proj; const size_t t0 = (size_t)b * SEQ + (size_t)c * 128;
    const int r = wave >> 1, lh = wave & 1, hh = grp * 4 + r;
    const bf16* Sb = P.st_ssd + ((size_t)((b * 32 + c) * 8 + hh)) * 8192;
    const float dsk = P.d_skip[hh];
    bf16x8 sf[2][8];
#pragma unroll
    for (int pt = 0; pt < 2; ++pt)
#pragma unroll
        for (int ks = 0; ks < 8; ++ks) sf[pt][ks] = *(const bf16x8*)(Sb + ((pt * 8 + ks) * 64 + lane) * 8);
#pragma nounroll
    for (int li = 0; li < 2; ++li) {
        const int lt = 2 * lh + li, l = 32 * lt + r32;
        bf16x8 cf[8];
#pragma unroll
        for (int ks = 0; ks < 8; ++ks) cf[ks] = *(const LAS bf16x8*)(lds + COFF + l * 272 + (16 * ks + 8 * h2) * 2);
        f32x16 y[2], yo[2];
#pragma unroll
        for (int pt = 0; pt < 2; ++pt)
#pragma unroll
            for (int e = 0; e < 16; ++e) { y[pt][e] = 0.f; yo[pt][e] = 0.f; }
        const float al = acs[r * 128 + l];
        bf16* zrow = pcol(proj, C_MZ + hh * 64) + (t0 + l) * TP;
        u32x4 zr[2][2];
#pragma unroll
        for (int pt = 0; pt < 2; ++pt)
#pragma unroll
            for (int a2 = 0; a2 < 2; ++a2) zr[pt][a2] = *(const u32x4*)(zrow + 32 * pt + 16 * a2 + 8 * h2);
        __builtin_amdgcn_sched_barrier(0);
        for (int st = 0; st <= lt; ++st) {
            f32x16 G;
#pragma unroll
            for (int e = 0; e < 16; ++e) G[e] = 0.f;
#pragma unroll
            for (int ks = 0; ks < 8; ++ks) { const bf16x8 a = *(const LAS bf16x8*)(lds + BOFF + (32 * st + r32) * 272 + (16 * ks + 8 * h2) * 2); G = MFMA32(a, cf[ks], G); }
#pragma unroll
            for (int e = 0; e < 16; ++e) { const int s = 32 * st + crow(e, h2); G[e] = (s <= l) ? G[e] * __expf(al - acs[r * 128 + s]) : 0.f; }
#pragma unroll
            for (int s2 = 0; s2 < 2; ++s2) {
                const bf16x8 bp = pack8(G[8 * s2], G[8 * s2 + 1], G[8 * s2 + 2], G[8 * s2 + 3], G[8 * s2 + 4], G[8 * s2 + 5], G[8 * s2 + 6], G[8 * s2 + 7]);
                const int k0 = 32 * st + 16 * s2 + 4 * h2;
#pragma unroll
                for (int pt = 0; pt < 2; ++pt) { const bf16x8 a = tr_frag(lds + XOFF, 576, k0, k0 + 8, r * 64 + 32 * pt, lane); y[pt] = MFMA32(a, bp, y[pt]); }
            }
        }
#pragma unroll
        for (int pt = 0; pt < 2; ++pt)
#pragma unroll
            for (int ks = 0; ks < 8; ++ks) yo[pt] = MFMA32(sf[pt][ks], cf[ks], yo[pt]);
        const float el = __expf(al), dti = __builtin_amdgcn_rcpf(dtl[r * 128 + l]);
        float ss = 0.f;
#pragma unroll
        for (int pt = 0; pt < 2; ++pt)
#pragma unroll
            for (int a2 = 0; a2 < 2; ++a2) {
                f32x4 v0, v1;
#pragma unroll
                for (int j = 0; j < 4; ++j) { v0[j] = y[pt][8 * a2 + j] + el * yo[pt][8 * a2 + j]; v1[j] = y[pt][8 * a2 + 4 + j] + el * yo[pt][8 * a2 + 4 + j]; }
                const bool hi = h2 != 0;
                const f32x4 mine = hi ? v1 : v0, give = hi ? v0 : v1;
                f32x4 got;
#pragma unroll
                for (int j = 0; j < 4; ++j) got[j] = lane_xor(give[j], 32, lane);
                const f32x4 lo4 = hi ? got : mine, hi4 = hi ? mine : got;
                float v8[8];
#pragma unroll
                for (int j = 0; j < 4; ++j) { v8[j] = lo4[j]; v8[4 + j] = hi4[j]; }
                const int p0 = 32 * pt + 16 * a2 + 8 * h2;
                float xs[8], zs[8]; unpack8(*(const LAS u32x4*)(lds + XOFF + l * 576 + (r * 64 + p0) * 2), xs); unpack8(zr[pt][a2], zs);
#pragma unroll
                for (int j = 0; j < 8; ++j) { v8[j] = (v8[j] + xs[j] * dti * dsk) * zs[j]; ss += v8[j] * v8[j]; }
                u32x4 o; o.x = pk2(v8[0], v8[1]); o.y = pk2(v8[2], v8[3]); o.z = pk2(v8[4], v8[5]); o.w = pk2(v8[6], v8[7]);
                *(u32x4*)(zrow + p0) = o;
            }
        ss += lane_xor(ss, 32, lane);
        if (h2 == 0) ssq[r * 128 + l] = ss;
    }
    f32x4 nw[2][2][2];
#pragma unroll
    for (int pt = 0; pt < 2; ++pt)
#pragma unroll
        for (int a2 = 0; a2 < 2; ++a2) { const int p0 = 32 * pt + 16 * a2 + 8 * h2; nw[pt][a2][0] = *(const f32x4*)(P.ssm_norm_w + hh * 64 + p0); nw[pt][a2][1] = *(const f32x4*)(P.ssm_norm_w + hh * 64 + p0 + 4); }
    lds_barrier();
#pragma nounroll
    for (int li = 0; li < 2; ++li) {
        const int l = 32 * (2 * lh + li) + r32;
        const float rstd = rsqrtf((ssq[l] + ssq[128 + l] + ssq[256 + l] + ssq[384 + l]) * (1.f / 256.f) + EPS);
        bf16* orow = pcol(proj, C_MZ + hh * 64) + (t0 + l) * TP;
        u32x4 yr[2][2];
#pragma unroll
        for (int pt = 0; pt < 2; ++pt)
#pragma unroll
            for (int a2 = 0; a2 < 2; ++a2) yr[pt][a2] = *(const u32x4*)(orow + 32 * pt + 16 * a2 + 8 * h2);
        __builtin_amdgcn_sched_barrier(0);
#pragma unroll
        for (int pt = 0; pt < 2; ++pt)
#pragma unroll
            for (int a2 = 0; a2 < 2; ++a2) { const int p0 = 32 * pt + 16 * a2 + 8 * h2; const f32x4 n0 = nw[pt][a2][0], n1 = nw[pt][a2][1];
                const u32x4 yv = yr[pt][a2];
                u32x4 o; o.x = pk2(bflo(yv.x) * rstd * n0[0], bfhi(yv.x) * rstd * n0[1]); o.y = pk2(bflo(yv.y) * rstd * n0[2], bfhi(yv.y) * rstd * n0[3]);
                o.z = pk2(bflo(yv.z) * rstd * n1[0], bfhi(yv.z) * rstd * n1[1]); o.w = pk2(bflo(yv.w) * rstd * n1[2], bfhi(yv.w) * rstd * n1[3]);
                *(u32x4*)(orow + p0) = o; }
    }
    PF_DONE;
    lds_barrier();
}

DI void scan_phase(const LayerP& P, int gid) {
    bf16* base; float dec_const = 0.f; const float* cdp = nullptr; size_t cstride;
    if (gid < 32768) { const int b = gid >> 12, h = (gid >> 10) & 3, e8 = gid & 1023; base = P.st_ret + ((size_t)(b * 32 * 4 + h)) * 8192 + e8 * 8; cstride = 4 * 8192; dec_const = exp2f(128.f * ret_lg(h)); }
    else if (gid < 98304) { const int g2 = gid - 32768, b = g2 >> 13, h = (g2 >> 10) & 7, e8 = g2 & 1023; base = P.st_ssd + ((size_t)(b * 32 * 8 + h)) * 8192 + e8 * 8; cstride = 8 * 8192; cdp = P.cd + b * 32 * 8 + h; }
    else return;
    float s[8]; float zf = 0.f; asm volatile("" : "+v"(zf));
#pragma unroll
    for (int e = 0; e < 8; ++e) s[e] = zf;
#pragma unroll
    for (int c0 = 0; c0 < 32; c0 += 16) {
        u32x4 v[16]; float dc[16];
#pragma unroll
        for (int i = 0; i < 16; ++i) { v[i] = *(const u32x4*)(base + (size_t)(c0 + i) * cstride); dc[i] = cdp ? cdp[(c0 + i) * 8] : dec_const; }
#pragma unroll
        for (int i = 0; i < 16; ++i) { float u[8]; unpack8(v[i], u);
            u32x4 o; o.x = pk2(s[0], s[1]); o.y = pk2(s[2], s[3]); o.z = pk2(s[4], s[5]); o.w = pk2(s[6], s[7]); *(u32x4*)(base + (size_t)(c0 + i) * cstride) = o;
#pragma unroll
            for (int e = 0; e < 8; ++e) s[e] = s[e] * dc[i] + u[e]; }
        __builtin_amdgcn_sched_barrier(0);
    }
}

DI int win_src(int r, float& sc) {
    sc = 1.f;
    if (r < 512) return S_RG + r;
    if (r < 1024) return S_SG + r - 512;
    if (r < 1536) return S_PG + r - 1024;
    if (r < 2048) return S_MZ + r - 1536;
    if (r < 2304) return S_RQ + r - 2048;
    if (r < 2560) { sc = 0.125f; return S_RK + r - 2304; }
    if (r < 3072) return S_RV + r - 2560;
    if (r < 3584) { sc = 0.125f * 1.44269504f; return S_SQ + r - 3072; }
    if (r < 3712) return S_SK + r - 3584;
    if (r < 3840) return S_SV + r - 3712;
    if (r < 4352) return S_PX + r - 3840;
    if (r < 5376) return S_MX + r - 4352;
    const int rho = r - 5376, pn = rho >> 8, bj = (rho >> 7) & 1, wc = (rho >> 5) & 3, n = (rho >> 4) & 1, fq = (rho >> 2) & 3, j = rho & 3;
    return S_MG + (2 * bj + n) * 1024 + 64 * pn + 32 * (wc >> 1) + 8 * fq + 4 * (wc & 1) + j;
}
DI void transpose_item(const float* W, int ldw, int K, bf16* WT, int r0, int k0, int col, float sc, LAS float* scr, int lane, int kd0 = -1) {
    if (kd0 < 0) kd0 = k0;
#pragma unroll 8
    for (int i = 0; i < 32; ++i) { const int kk = 2 * i + (lane >> 5); scr[kk * 33 + (lane & 31)] = W[(size_t)(k0 + kk) * ldw + col] * sc; }
    asm volatile("s_waitcnt lgkmcnt(0)" ::: "memory");
    const int c = lane & 7;
#pragma unroll
    for (int j = 0; j < 4; ++j) { const int n = (lane >> 3) + 8 * j; const LAS float* s = scr + (8 * c) * 33 + n;
        u32x4 o; o.x = pk2(s[0 * 33], s[1 * 33]); o.y = pk2(s[2 * 33], s[3 * 33]); o.z = pk2(s[4 * 33], s[5 * 33]); o.w = pk2(s[6 * 33], s[7 * 33]);
        *(u32x4*)(WT + (size_t)(r0 + n) * K + kd0 + 8 * c) = o; }
    asm volatile("s_waitcnt lgkmcnt(0)" ::: "memory");
}

DI void transpose_item8(const float* W, int ldw, int K, unsigned char* WT8, int r0, int k0, int col, float sc, LAS float* scr, int lane) {
#pragma unroll 8
    for (int i = 0; i < 32; ++i) { const int kk = 2 * i + (lane >> 5); scr[kk * 33 + (lane & 31)] = W[(size_t)(k0 + kk) * ldw + col] * sc; }
    asm volatile("s_waitcnt lgkmcnt(0)" ::: "memory");
    const int c = lane & 7;
#pragma unroll
    for (int j = 0; j < 4; ++j) { const int n = (lane >> 3) + 8 * j; const LAS float* s = scr + (8 * c) * 33 + n;
        u32x2 o; o.x = pk4_i8(s[0 * 33], s[1 * 33], s[2 * 33], s[3 * 33]); o.y = pk4_i8(s[4 * 33], s[5 * 33], s[6 * 33], s[7 * 33]);
        *(u32x2*)(WT8 + (size_t)(r0 + n) * K + k0 + 8 * c) = o; }
    asm volatile("s_waitcnt lgkmcnt(0)" ::: "memory");
}

struct Args {
    const float* in[18]; float* out; unsigned char* ws; int ph_lo, ph_hi;
};

DI void p0_prologue(LAS unsigned char* lds, const Args& a, int tid, int G, int part) {
    const int lane = tid & 63, wave = tid >> 6;
    unsigned char* ws = a.ws;
    if (part == 0)
    for (int it = blockIdx.x; it < 96; it += G) {
        const int l = it / 48, cg = it % 48;
        LAS float* sc = (LAS float*)lds;
        LAS float* red = (LAS float*)(lds + 32768);
        for (int i = tid; i < 8192; i += 512) sc[i] = silu_f(a.in[1][i]);
        __syncthreads();
        float acc[8];
#pragma unroll
        for (int b = 0; b < 8; ++b) acc[b] = 0.f;
        const float* wp = a.in[2] + (size_t)l * 1024 * 3072 + (size_t)(wave * 128) * 3072 + cg * 64 + lane;
#pragma unroll 4
        for (int k = 0; k < 128; ++k) { const float w = wp[(size_t)k * 3072];
#pragma unroll
            for (int b = 0; b < 8; ++b) acc[b] += sc[b * 1024 + wave * 128 + k] * w; }
#pragma unroll
        for (int b = 0; b < 8; ++b) red[(wave * 8 + b) * 64 + lane] = acc[b];
        __syncthreads();
        { const int b = tid >> 6, n = tid & 63; float s = 0.f;
#pragma unroll
            for (int w = 0; w < 8; ++w) s += red[(w * 8 + b) * 64 + n];
            ((float*)(ws + WS_MOD))[(size_t)(l * 8 + b) * 3072 + cg * 64 + n] = s + a.in[3][l * 3072 + cg * 64 + n]; }
        __syncthreads();
    }
    if (part == 0) {
        LAS float* red = (LAS float*)lds;
        for (int cb = blockIdx.x; cb < 256; cb += G) { const int l = cb >> 7, rho0 = (cb & 127) * 32, cc = tid & 31, ks = tid >> 5; float dummy;
            const float* wp = a.in[5] + (size_t)l * 1024 * DIN + (size_t)(ks * 64) * DIN + win_src(5376 + rho0 + cc, dummy);
            float mx = 0.f;
#pragma unroll 8
            for (int k = 0; k < 64; ++k) mx = fmaxf(mx, fabsf(__builtin_nontemporal_load(wp + (size_t)k * DIN)));
            __syncthreads(); red[ks * 32 + cc] = mx; __syncthreads();
            if (tid < 32) { float m2 = 0.f;
#pragma unroll
                for (int q = 0; q < 16; ++q) m2 = fmaxf(m2, red[q * 32 + tid]);
                ((float*)(ws + WS_SW))[l * 4096 + rho0 + tid] = m2 > 0.f ? m2 * (1.f / 127.f) : 1.f; }
        }
        return;
    }
    LAS float* scr = (LAS float*)(lds + wave * 8448);
    const int gw = blockIdx.x * 8 + wave, NGW = G * 8;
    constexpr int I_WIN = (WIN_ROWS / 32) * 16, I_UP = 32 * 8, I_OUT = 32 * 16, I_POOL = 4 * 2;
    constexpr int NITEMS = 2 * I_WIN + 8 * I_UP + 2 * I_OUT + 8 * I_POOL;
    for (int it = gw; it < NITEMS; it += NGW) {
        int r = it;
        if (r < 2 * I_WIN) { const int l = r / I_WIN, q = r % I_WIN, rg = q >> 4, kb = q & 15; float sc; const int col = win_src(rg * 32 + (lane & 31), sc);
            if (rg * 32 >= 5376) { const float isc = 1.f / ((const float*)(ws + WS_SW))[l * 4096 + rg * 32 - 5376 + (lane & 31)];
                transpose_item8(a.in[5] + (size_t)l * 1024 * DIN, DIN, 1024, ws + WS_WMG8 + (size_t)l * 4096 * 1024, rg * 32 - 5376, kb * 64, col, isc, scr, lane); continue; }
            transpose_item(a.in[5] + (size_t)l * 1024 * DIN, DIN, 1024, (bf16*)(ws + WS_WIN) + (size_t)l * WIN_L, rg * 32, kb * 64, col, sc, scr, lane); continue; }
        r -= 2 * I_WIN;
        if (r < 8 * I_UP) { const int li = r / I_UP, q = r % I_UP, rg = q >> 3, kb = q & 7;
            transpose_item(a.in[15] + (size_t)li * 512 * 1024, 1024, 2048, (bf16*)(ws + WS_WUP) + (size_t)(li >> 2) * 1024 * 2048, rg * 32, kb * 64, rg * 32 + (lane & 31), 1.f, scr, lane, (li & 3) * 512 + kb * 64); continue; }
        r -= 8 * I_UP;
        if (r < 2 * I_OUT) { const int l = r / I_OUT, q = r % I_OUT, rg = q >> 4, kb = q & 15;
            transpose_item(a.in[16] + (size_t)l * 1024 * 1024, 1024, 1024, (bf16*)(ws + WS_WOUT) + (size_t)l * 1024 * 1024, rg * 32, kb * 64, rg * 32 + (lane & 31), 1.f, scr, lane); continue; }
        r -= 2 * I_OUT;
        { const int lg = r / I_POOL, q = r % I_POOL, rg = q >> 1, kb = q & 1;
            transpose_item(a.in[7] + (size_t)lg * 128 * 128, 128, 128, (bf16*)(ws + WS_POOL) + (size_t)lg * 128 * 128, rg * 32, kb * 64, rg * 32 + (lane & 31), 1.f, scr, lane); }
    }
}

template <bool IN_BF16>
DI void p1_norm(LAS unsigned char* lds, const Args& a, int layer, const void* xin, int tid, int G) {
    const int lane = tid & 63, wave = tid >> 6;
    LAS float* wdt = (LAS float*)lds;
    const float* win = a.in[5] + (size_t)layer * 1024 * DIN;
    for (int i = tid; i < 8192; i += 512) { const int k = i >> 3, jj = i & 7; wdt[(((k >> 8) * 4 + (k & 3)) * 64 + ((k & 255) >> 2)) * 4 + (jj & 3) + (jj >> 2) * 4096] = win[(size_t)k * DIN + S_DT + jj]; }
    __syncthreads();
    const float* nw = a.in[4] + layer * 1024; const float* mod = (const float*)(a.ws + WS_MOD) + (size_t)layer * 8 * 3072;
    bf16* H = (bf16*)(a.ws + WS_H); float* DT = (float*)(a.ws + WS_DT); const float* dtb = a.in[11] + layer * 8;
    f32x4 w4r[4];
#pragma unroll
    for (int j = 0; j < 4; ++j) w4r[j] = *(const f32x4*)(nw + 256 * j + 4 * lane);
    const int row0_ = blockIdx.x * 8 + wave;
    f32x4 vf[4]; u32x2 vb[4];
#pragma unroll
    for (int j = 0; j < 4; ++j) { if (IN_BF16) vb[j] = __builtin_nontemporal_load((const u32x2*)((const bf16*)xin + (size_t)row0_ * D) + lane + 64 * j); else vf[j] = __builtin_nontemporal_load((const f32x4*)((const float*)xin + (size_t)row0_ * D) + lane + 64 * j); }
    for (int row = row0_; row < T; row += G * 8) {
        const int b = row >> 12;
        f32x4 v[4]; float ss = 0.f;
#pragma unroll
        for (int j = 0; j < 4; ++j) { if (IN_BF16) v[j] = (f32x4){bflo(vb[j].x), bfhi(vb[j].x), bflo(vb[j].y), bfhi(vb[j].y)}; else v[j] = vf[j]; }
        f32x4 sc4r[4], sh4r[4];
#pragma unroll
        for (int j = 0; j < 4; ++j) { const int col = 256 * j + 4 * lane; sc4r[j] = *(const f32x4*)(mod + b * 3072 + 1024 + col); sh4r[j] = *(const f32x4*)(mod + b * 3072 + col); }
        { const int nrow = row + G * 8 < T ? row + G * 8 : row;
#pragma unroll
          for (int j = 0; j < 4; ++j) { if (IN_BF16) vb[j] = __builtin_nontemporal_load((const u32x2*)((const bf16*)xin + (size_t)nrow * D) + lane + 64 * j); else vf[j] = __builtin_nontemporal_load((const f32x4*)((const float*)xin + (size_t)nrow * D) + lane + 64 * j); } }
        __builtin_amdgcn_sched_barrier(0);
#pragma unroll
        for (int j = 0; j < 4; ++j) ss += (v[j][0] * v[j][0] + v[j][1] * v[j][1]) + (v[j][2] * v[j][2] + v[j][3] * v[j][3]);
        const float rstd = rsqrtf(wave_sum(ss, lane) * (1.f / D) + EPS);
        float dacc[8]; f32x4 hq[4];
#pragma unroll
        for (int e = 0; e < 8; ++e) dacc[e] = 0.f;
#pragma unroll
        for (int j = 0; j < 4; ++j) { const int col = 256 * j + 4 * lane;
            const f32x4 w4 = w4r[j], sc4 = sc4r[j], sh4 = sh4r[j];
            const f32x4 hv = v[j] * rstd * w4 * (sc4 + 1.f) + sh4;
            u32x2 o; o.x = pk2(hv[0], hv[1]); o.y = pk2(hv[2], hv[3]);
            *(u32x2*)(H + (size_t)row * D + col) = o;
            hq[j] = hv;
#pragma unroll
            for (int e = 0; e < 4; ++e) { const f32x4 w0 = *(const LAS f32x4*)(wdt + ((j * 4 + e) * 64 + lane) * 4), w1 = *(const LAS f32x4*)(wdt + 4096 + ((j * 4 + e) * 64 + lane) * 4);
                dacc[0] += hv[e] * w0[0]; dacc[1] += hv[e] * w0[1]; dacc[2] += hv[e] * w0[2]; dacc[3] += hv[e] * w0[3];
                dacc[4] += hv[e] * w1[0]; dacc[5] += hv[e] * w1[1]; dacc[6] += hv[e] * w1[2]; dacc[7] += hv[e] * w1[3]; } }
        { float am = 0.f;
#pragma unroll
          for (int j = 0; j < 4; ++j) am = fmaxf(am, fmaxf(fmaxf(fabsf(hq[j][0]), fabsf(hq[j][1])), fmaxf(fabsf(hq[j][2]), fabsf(hq[j][3]))));
#pragma unroll
          for (int o = 1; o < 64; o <<= 1) am = fmaxf(am, lane_xor(am, o, lane));
          const float qs = am > 0.f ? 127.f / am : 0.f;
#pragma unroll
          for (int j = 0; j < 4; ++j) *(unsigned*)((unsigned char*)a.out + (size_t)T * D * 2 + (size_t)row * D + 256 * j + 4 * lane) = pk4_i8(hq[j][0] * qs, hq[j][1] * qs, hq[j][2] * qs, hq[j][3] * qs);
          if (lane == 0) ((float*)(a.ws + WS_SH))[row] = am > 0.f ? am * (1.f / 127.f) : 1.f; }
        float mine = 0.f;
#pragma unroll
        for (int e = 0; e < 8; ++e) { const float s = wave_sum(dacc[e], lane); if (lane == e) mine = s; }
        if (lane < 8) { const float z = mine + dtb[lane]; const float ez = __expf(z); DT[(size_t)row * 8 + lane] = z > 20.f ? z : (ez < 0.01f ? ez * (1.f - ez * (0.5f - ez * 0.33333334f)) : __logf(1.f + ez)); }
    }
    __syncthreads();
}

DI void p7_final(const Args& a, int tid, int G) {
    const int lane = tid & 63, wave = tid >> 6; const float* fw = a.in[17];
    const bf16* x2 = (const bf16*)(a.ws + WS_PROJ);
    f32x4 fwr[4];
#pragma unroll
    for (int j = 0; j < 4; ++j) fwr[j] = *(const f32x4*)(fw + 256 * j + 4 * lane);
    const int row0_ = blockIdx.x * 8 + wave;
    u32x2 vb[4];
#pragma unroll
    for (int j = 0; j < 4; ++j) vb[j] = __builtin_nontemporal_load((const u32x2*)(x2 + (size_t)row0_ * D) + lane + 64 * j);
    for (int row = row0_; row < T; row += G * 8) {
        f32x4 v[4]; float ss = 0.f;
#pragma unroll
        for (int j = 0; j < 4; ++j) v[j] = (f32x4){bflo(vb[j].x), bfhi(vb[j].x), bflo(vb[j].y), bfhi(vb[j].y)};
        { const int nrow = row + G * 8 < T ? row + G * 8 : row;
#pragma unroll
          for (int j = 0; j < 4; ++j) vb[j] = __builtin_nontemporal_load((const u32x2*)(x2 + (size_t)nrow * D) + lane + 64 * j); }
        __builtin_amdgcn_sched_barrier(0);
#pragma unroll
        for (int j = 0; j < 4; ++j) ss += (v[j][0] * v[j][0] + v[j][1] * v[j][1]) + (v[j][2] * v[j][2] + v[j][3] * v[j][3]);
        const float rstd = rsqrtf(wave_sum(ss, lane) * (1.f / D) + EPS);
        f32x4* xr = (f32x4*)(a.out + (size_t)row * D) + lane;
#pragma unroll
        for (int j = 0; j < 4; ++j) __builtin_nontemporal_store(v[j] * rstd * fwr[j], xr + 64 * j);
    }
}


#define XB_TMO      128
#define XB_XCNT(j)  (256  + 64 * (j))
#define XB_XSUB(j)  (1280 + 64 * (j))
#define XB_XGEN(j)  (2304 + 64 * (j))
#define XB_TOP      3328
#define XB_TOPGEN   3392
#define XCD_BAR_WORDS 3456
#define XB_SPIN_CAP (1u << 20)
DI unsigned xb_ld(unsigned* p)              { return __hip_atomic_load(p, __ATOMIC_RELAXED, __HIP_MEMORY_SCOPE_AGENT); }
DI unsigned xb_add(unsigned* p, unsigned v) { return __hip_atomic_fetch_add(p, v, __ATOMIC_RELAXED, __HIP_MEMORY_SCOPE_AGENT); }
DI unsigned xb_xcc_id() { return (unsigned)__builtin_amdgcn_s_getreg((3 << 11) | 20) & 0xFu; }
#define XB_SPIN(cond, bar) do { unsigned _sp = 0; while (cond) { __builtin_amdgcn_s_sleep(1); \
    if ((++_sp & 255u) == 0u) { if (xb_ld(&(bar)[XB_TMO])) break; if (_sp > XB_SPIN_CAP) { atomicAdd(&(bar)[XB_TMO], 1u); break; } } } } while (0)
struct XcdBarrier { unsigned* bar; unsigned x; volatile LAS unsigned* st; };
DI XcdBarrier xcd_barrier_post(unsigned* bar, volatile LAS unsigned* st, bool leader) {
    XcdBarrier b; b.bar = bar; b.x = xb_xcc_id(); b.st = st;
    if (leader) (void)xb_add(&bar[XB_XCNT(b.x)], 1u);
    return b;
}
DI void xcd_barrier_complete(unsigned* bar, unsigned x, unsigned& nloc, unsigned& nx) {
    const unsigned G = gridDim.x * gridDim.y * gridDim.z;
    unsigned sum, cnt, mine, sp = 0u;
    for (;;) {
        sum = 0u; cnt = 0u; mine = 0u;
#pragma unroll
        for (unsigned j = 0; j < 16; ++j) { const unsigned c = xb_ld(&bar[XB_XCNT(j)]); sum += c; cnt += (c > 0u) ? 1u : 0u; mine = (j == x) ? c : mine; }
        if (sum == G) break;
        __builtin_amdgcn_s_sleep(1);
        if ((++sp & 255u) == 0u) { if (xb_ld(&bar[XB_TMO])) break; if (sp > XB_SPIN_CAP) { atomicAdd(&bar[XB_TMO], 1u); break; } }
    }
    nloc = mine > 0u ? mine : 1u; nx = cnt > 0u ? cnt : 1u;
}
DI void xcd_barrier(const XcdBarrier& b, bool leader) {
    asm volatile("s_waitcnt vmcnt(0)" ::: "memory");
    __syncthreads();
    if (leader) {
        unsigned* bar = b.bar;
        __builtin_amdgcn_s_waitcnt(0);
        unsigned nloc = b.st[0], nx = b.st[1];
        if (nloc == 0u) { xcd_barrier_complete(bar, b.x, nloc, nx); b.st[0] = nloc; b.st[1] = nx; }
        const unsigned old = xb_add(&bar[XB_XSUB(b.x)], 1u);
        const unsigned gen = old / nloc;
        if (old + 1u == (gen + 1u) * nloc) {
            __builtin_amdgcn_fence(__ATOMIC_RELEASE, "agent");
            asm volatile("s_waitcnt vmcnt(0)" ::: "memory");
            const unsigned og = xb_add(&bar[XB_TOP], 1u);
            const unsigned tg = og / nx;
            if (og + 1u == (tg + 1u) * nx) xb_add(&bar[XB_TOPGEN], 1u);
            else XB_SPIN(xb_ld(&bar[XB_TOPGEN]) == tg, bar);
            __builtin_amdgcn_fence(__ATOMIC_ACQUIRE, "agent");
            xb_add(&bar[XB_XGEN(b.x)], 1u);
            asm volatile("s_waitcnt vmcnt(0)" ::: "memory");
        } else {
            XB_SPIN(xb_ld(&bar[XB_XGEN(b.x)]) == gen, bar);
            __builtin_amdgcn_fence(__ATOMIC_ACQUIRE, "agent");
            asm volatile("s_waitcnt vmcnt(0)" ::: "memory");
        }
    }
    __syncthreads();
}

#if defined(__HIP_DEVICE_COMPILE__)
#define LOAD_ARGS() ({ const __attribute__((address_space(4))) Args* kp_ = (const __attribute__((address_space(4))) Args*)__builtin_amdgcn_kernarg_segment_ptr(); asm volatile("" : "+s"(kp_)); *kp_; })
#else
#define LOAD_ARGS() (a_unused)
#endif
#define OPQ_TID() ({ int t_ = wave_idx * 64 + (int)__builtin_amdgcn_mbcnt_hi(~0u, __builtin_amdgcn_mbcnt_lo(~0u, 0u)); asm volatile("" : "+v"(t_)); t_; })
__global__ void __launch_bounds__(512, 2) mk_fwd(Args a_unused) {
    extern __shared__ __attribute__((aligned(16))) unsigned char lds_raw[];
    LAS unsigned char* lds = (LAS unsigned char*)lds_raw;
    cg::grid_group grid = cg::this_grid();
#define OPQ_S(x) ({ int s_ = (x); asm volatile("" : "+s"(s_)); s_; })
#ifndef LSEQ
#define LSEQ 0x87654321ull
#endif
    volatile LAS unsigned* xst = (volatile LAS unsigned*)(lds + LDS_BYTES - 512);
    if (threadIdx.x < 2) xst[threadIdx.x] = 0u;
    __syncthreads();
    const int wave_idx = __builtin_amdgcn_readfirstlane((int)(threadIdx.x >> 6));
    { const Args a = LOAD_ARGS(); (void)xcd_barrier_post((unsigned*)(a.ws + WS_CTL), xst, OPQ_TID() == 0); }
#define GRID_BARRIER() do { const Args ab_ = LOAD_ARGS(); XcdBarrier xb_; xb_.bar = (unsigned*)(ab_.ws + WS_CTL); xb_.x = xb_xcc_id(); xb_.st = (volatile LAS unsigned*)(lds + LDS_BYTES - 512); xcd_barrier(xb_, OPQ_TID() == 0); } while (0)
    { const Args a = LOAD_ARGS(); p0_prologue(lds, a, OPQ_TID(), OPQ_S(gridDim.x), 0); }
    grid.sync();
    { const Args a = LOAD_ARGS(); p0_prologue(lds, a, OPQ_TID(), OPQ_S(gridDim.x), 1); }
    { const Args a = LOAD_ARGS(); __syncthreads(); p1_norm<false>(lds, a, 0, a.in[0], OPQ_TID(), OPQ_S(gridDim.x)); }
    GRID_BARRIER();
    for (int layer = 0; layer < 2; ++layer) {
        for (unsigned long long sq = (layer == 0 ? (LSEQ >> 4) : LSEQ); sq != 0ull; sq >>= 4) {
            const int p = (int)(sq & 15ull);
            const Args a = LOAD_ARGS();
            const int G = OPQ_S(gridDim.x), bid = OPQ_S(blockIdx.x);
            unsigned char* ws = a.ws;
            bf16* proj = (bf16*)(ws + WS_PROJ); bf16* H = (bf16*)(ws + WS_H);
            bf16* Rg = proj + 8 * TS;
            const bf16* WinT = (const bf16*)(ws + WS_WIN) + (size_t)layer * WIN_L;
            if (p == 1) { if (layer == 0) p1_norm<false>(lds, a, layer, a.in[0], OPQ_TID(), G); else p1_norm<true>(lds, a, layer, a.out, OPQ_TID(), G); }
            else if (p == 2) { pg8::Gemm<1024, 1024, 1024, T / 256, 21, 31, 0, 512> g{H, WinT};
                pg8::EpiProj E{proj, TP}; pg8::gemm_phase(lds, g, G, bid, E, OPQ_TID()); }
            else if (p >= 3 && p <= 5) {
                LayerP P;
                P.sinks = a.in[6] + layer * 8; P.pool_scale = a.in[8] + layer * 512; P.conv_w = a.in[9] + layer * 4096; P.conv_b = a.in[10] + layer * 1024;
                P.a_log = a.in[12] + layer * 8; P.d_skip = a.in[13] + layer * 8; P.ssm_norm_w = a.in[14] + layer * 512;
                P.poolT = (const bf16*)(ws + WS_POOL) + (size_t)layer * 4 * 128 * 128;
                P.proj = proj; P.dt = (const float*)(ws + WS_DT); P.cd = (float*)(ws + WS_CD); P.st_ret = (bf16*)(ws + WS_EXT + ST_RET); P.st_ssd = (bf16*)(ws + WS_EXT + ST_SSD);
                const int tid = OPQ_TID();
                if (p == 3) {
                    const int nk = (3072 + G - 1) / G, rot = (bid * 5) % nk;
                    for (int k = 0; k < nk; ++k) { const int it = bid + G * ((k + rot) % nk); if (it >= 3072) continue;
                        int nxt = k + 1 < nk ? bid + G * ((k + 1 + rot) % nk) : -1; if (nxt >= 3072) nxt = -1;
                        if (it < 512) swa_unit(lds, P, it >> 6, (it >> 1) & 31, it & 1, tid, nxt);
                        else if (it < 1024) { const int q = it - 512; ssdU_unit(lds, P, q >> 6, (q >> 1) & 31, q & 1, tid, nxt); }
                        else if (it < 2048) { const int q = it - 1024; retU_unit(lds, P, q >> 7, (q >> 2) & 31, q & 3, tid, nxt); }
                        else { const int q = it - 2048; pool_unit(lds, P, q >> 2, q & 3, tid, nxt); }
                    }
                }
                else if (p == 4) scan_phase(P, bid * 512 + tid);
                else {
                    const int nk = (1536 + G - 1) / G, rot = (bid * 5) % nk;
                    for (int k = 0; k < nk; ++k) { const int it = bid + G * ((k + rot) % nk); if (it >= 1536) continue;
                        int nxt = k + 1 < nk ? bid + G * ((k + 1 + rot) % nk) : -1; if (nxt >= 1536) nxt = -1;
                        if (it < 512) ssdO_unit(lds, P, it >> 6, (it >> 1) & 31, it & 1, tid, nxt);
                        else { const int q = it - 512; retO_unit(lds, P, q >> 7, (q >> 2) & 31, q & 3, tid, nxt); }
                    }
                }
            }
            else if (p == 6) { pg8::Gemm<512, 512, 512, T / 256, 16, 31, 0, 512, true> g{(const bf16*)((unsigned char*)a.out + (size_t)T * D * 2), (const bf16*)(ws + WS_WMG8 + (size_t)layer * 4096 * 1024)};
                pg8::EpiGate E{Rg, (const float*)(ws + WS_SH), (const float*)(ws + WS_SW) + layer * 4096}; pg8::gemm_phase(lds, g, G, bid, E, OPQ_TID()); }
            else if (p == 7) { pg8::Gemm<TP, 2048, 2048, T / 256, 4, 31, 0, 2 * (long long)TS> g{proj, (const bf16*)(ws + WS_WUP) + (size_t)layer * 1024 * 2048};
                pg8::EpiMergeUp E{Rg, H}; pg8::gemm_phase(lds, g, G, bid, E, OPQ_TID()); }
            else if (p == 8) { pg8::Gemm<TP, 1024, 1024, T / 256, 4, 31, 0, 2 * (long long)TS> g{H, (const bf16*)(ws + WS_WOUT) + (size_t)layer * 1024 * 1024};
                const float* gate = (const float*)(ws + WS_MOD) + (size_t)layer * 8 * 3072 + 2048;
                if (layer == 0) { pg8::EpiOut<false> E{a.in[0], (bf16*)a.out, gate}; pg8::gemm_phase(lds, g, G, bid, E, OPQ_TID()); }
                else { pg8::EpiOut<true> E{a.out, proj, gate}; pg8::gemm_phase(lds, g, G, bid, E, OPQ_TID()); } }
            GRID_BARRIER();
        }
    }
    { const Args a = LOAD_ARGS(); p7_final(a, OPQ_TID(), OPQ_S(gridDim.x)); }
}
constexpr int N_PHASES = 1 + 2 * 8 + 1;

extern "C" void kernel_launch(void* const* d_in, const int* in_sizes, int n_in, void* d_out, int out_size, void* d_ws, size_t ws_size, hipStream_t stream) {
    static int grid = 0;
    if (grid == 0) {
        if (n_in != 18 || out_size != T * D || ws_size < WS_END) { fprintf(stderr, "kernel_launch: unexpected shapes (n_in %d out %d ws %zu); nothing launched\n", n_in, out_size, ws_size); grid = -1; return; }
        int dev = 0, cus = 0, per_cu = 0;
        if (hipGetDevice(&dev) != hipSuccess || hipDeviceGetAttribute(&cus, hipDeviceAttributeMultiprocessorCount, dev) != hipSuccess) { grid = -1; return; }
        if (hipFuncSetAttribute((const void*)mk_fwd, hipFuncAttributeMaxDynamicSharedMemorySize, LDS_BYTES) != hipSuccess) { fprintf(stderr, "kernel_launch: hipFuncSetAttribute failed\n"); grid = -1; return; }
        if (hipOccupancyMaxActiveBlocksPerMultiprocessor(&per_cu, (const void*)mk_fwd, 512, LDS_BYTES) != hipSuccess || per_cu < 1) { fprintf(stderr, "kernel_launch: occupancy query says %d\n", per_cu); per_cu = 1; }
        (void)hipGetLastError();
        grid = cus;
    }
    if (grid < 0) return;
    if (hipMemsetAsync((char*)d_ws + WS_CTL, 0, CTL_BYTES, stream) != hipSuccess) { fprintf(stderr, "kernel_launch: memset failed\n"); return; }
    Args a{};
    for (int i = 0; i < 18; ++i) a.in[i] = (const float*)d_in[i];
    a.out = (float*)d_out; a.ws = (unsigned char*)d_ws; a.ph_lo = 0; a.ph_hi = N_PHASES;
    void* args[] = {&a};
    hipError_t e = hipLaunchCooperativeKernel((void*)mk_fwd, dim3(grid), dim3(512), args, LDS_BYTES, stream);
    if (e != hipSuccess) fprintf(stderr, "cooperative launch failed: %s (grid %d)\n", hipGetErrorString(e), grid);
}
```

```cpp
#include <hip/hip_runtime.h>
#include <hip/hip_cooperative_groups.h>
#include <cstdio>
#include <cstdint>
namespace cg = cooperative_groups;

#define LAS __attribute__((address_space(3)))
#define DI __device__ __forceinline__
typedef unsigned short bf16;
typedef short bf16x8 __attribute__((ext_vector_type(8)));
typedef short s16x4 __attribute__((ext_vector_type(4)));
typedef short v4i16_t __attribute__((ext_vector_type(4)));
typedef float f32x2 __attribute__((ext_vector_type(2)));
typedef float f32x4 __attribute__((ext_vector_type(4)));
typedef float f32x16 __attribute__((ext_vector_type(16)));
typedef unsigned u32x2 __attribute__((ext_vector_type(2)));
typedef unsigned u32x4 __attribute__((ext_vector_type(4)));
typedef __bf16 bf2_t __attribute__((ext_vector_type(2)));
typedef int v4i_t __attribute__((ext_vector_type(4)));
typedef int v8i_t __attribute__((ext_vector_type(8)));

constexpr int BATCH = 8, SEQ = 4096, T = BATCH * SEQ, D = 1024, DIN = 9480, LDP = 5376;
constexpr float EPS = 1e-6f;
constexpr int TP = 256;
constexpr size_t TS = (size_t)T * 256;
constexpr int C_RG = 0, C_SG = 512, C_PG = 1024, C_MZ = 1536, C_RQ = 2048, C_RK = 2304, C_RV = 2560, C_SQ = 3072, C_SK = 3584, C_SV = 3712, C_PX = 3840, C_MX = 4352;
constexpr int S_RQ = 0, S_RK = 256, S_RV = 512, S_RG = 1024, S_SQ = 1536, S_SK = 2048, S_SV = 2176, S_SG = 2304, S_PX = 2816, S_PG = 3328, S_MX = 3840, S_MZ = 4864, S_DT = 5376, S_MG = 5384;
constexpr int WIN_ROWS = 9472;

constexpr size_t MiB = 1u << 20;
constexpr size_t WS_CTL = 0, CTL_BYTES = 64 * 1024;
constexpr size_t WS_MOD = 1 * MiB;
constexpr size_t WS_DT = 2 * MiB;
constexpr size_t WS_CD = 3 * MiB;
constexpr size_t WS_WIN = 4 * MiB;
constexpr size_t WIN_L = (size_t)WIN_ROWS * 1024;
constexpr size_t WS_WUP = 41 * MiB;
constexpr size_t WS_WOUT = 49 * MiB;
constexpr size_t WS_POOL = 53 * MiB;
constexpr size_t WS_H = 54 * MiB;
constexpr size_t WS_PROJ = 118 * MiB;
constexpr size_t WS_EXT = 454 * MiB;
constexpr size_t WS_WMG8 = 502 * MiB;
constexpr size_t WS_SW = 510 * MiB;
constexpr size_t WS_SH = 510 * MiB + 65536;
constexpr size_t WS_END = 511 * MiB;
constexpr size_t ST_RET = 0, ST_SSD = 16 * MiB;

constexpr int LDS_BYTES = 163840;

DI unsigned pk2(float lo, float hi) { f32x2 v = {lo, hi}; bf2_t b = __builtin_convertvector(v, bf2_t); return __builtin_bit_cast(unsigned, b); }
DI float bflo(unsigned u) { return __uint_as_float(u << 16); }
DI float bfhi(unsigned u) { return __uint_as_float(u & 0xffff0000u); }
DI float bf2f(bf16 v) { return __uint_as_float(((unsigned)v) << 16); }
DI unsigned pk4_i8(float a, float b, float c, float d) {
    const int ia = (int)rintf(fminf(fmaxf(a, -127.f), 127.f)), ib = (int)rintf(fminf(fmaxf(b, -127.f), 127.f)), ic = (int)rintf(fminf(fmaxf(c, -127.f), 127.f)), id = (int)rintf(fminf(fmaxf(d, -127.f), 127.f));
    return (unsigned)(ia & 255) | ((unsigned)(ib & 255) << 8) | ((unsigned)(ic & 255) << 16) | ((unsigned)id << 24);
}
DI float silu_f(float x) { return x * __builtin_amdgcn_rcpf(1.f + __expf(-x)); }
DI float sigm_f(float x) { return __builtin_amdgcn_rcpf(1.f + __expf(-x)); }
DI float lane_xor(float v, int o, int lane) { return __int_as_float(__builtin_amdgcn_ds_bpermute((lane ^ o) << 2, __float_as_int(v))); }
DI float lane_up(float v, int o, int lane) { const int src = lane >= o ? lane - o : lane; return __int_as_float(__builtin_amdgcn_ds_bpermute(src << 2, __float_as_int(v))); }
DI float wave_sum(float v, int lane) {
#pragma unroll
    for (int o = 1; o < 64; o <<= 1) v += lane_xor(v, o, lane);
    return v;
}
DI bf16* pcol(bf16* proj, int c) { return proj + (size_t)(c >> 8) * TS + (c & 255); }
DI const bf16* pcol(const bf16* proj, int c) { return proj + (size_t)(c >> 8) * TS + (c & 255); }
DI int crow(int r, int h) { return (r & 3) + 8 * (r >> 2) + 4 * h; }
#define MFMA32(a, b, c) __builtin_amdgcn_mfma_f32_32x32x16_bf16((a), (b), (c), 0, 0, 0)
DI bf16x8 pack8(float a0, float a1, float a2, float a3, float a4, float a5, float a6, float a7) {
    u32x4 p; p.x = pk2(a0, a1); p.y = pk2(a2, a3); p.z = pk2(a4, a5); p.w = pk2(a6, a7); return __builtin_bit_cast(bf16x8, p);
}
DI u32x4 zero4() { unsigned z = 0u; asm volatile("" : "+v"(z)); return (u32x4){z, z, z, z}; }
DI s16x4 trr(const LAS unsigned char* p) { return __builtin_bit_cast(s16x4, __builtin_amdgcn_ds_read_tr16_b64_v4i16((LAS v4i16_t*)p)); }
DI bf16x8 tr_frag(const LAS unsigned char* img, int stride, int klo, int khi, int col0, int lane) {
    const int i16 = lane & 15, q = i16 >> 2, p = i16 & 3, blk = (lane >> 4) & 1;
    const LAS unsigned char* a = img + q * stride + (col0 + 16 * blk + 4 * p) * 2;
    const s16x4 lo = trr(a + klo * stride), hi = trr(a + khi * stride);
    return (bf16x8){lo[0], lo[1], lo[2], lo[3], hi[0], hi[1], hi[2], hi[3]};
}
DI u32x4 gate8(u32x4 ov, u32x4 gv) {
    u32x4 r;
    r.x = pk2(bflo(ov.x) * bflo(gv.x), bfhi(ov.x) * bfhi(gv.x)); r.y = pk2(bflo(ov.y) * bflo(gv.y), bfhi(ov.y) * bfhi(gv.y));
    r.z = pk2(bflo(ov.z) * bflo(gv.z), bfhi(ov.z) * bfhi(gv.z)); r.w = pk2(bflo(ov.w) * bflo(gv.w), bfhi(ov.w) * bfhi(gv.w));
    return r;
}
DI void unpack8(u32x4 w, float* f) { f[0] = bflo(w.x); f[1] = bfhi(w.x); f[2] = bflo(w.y); f[3] = bfhi(w.y); f[4] = bflo(w.z); f[5] = bfhi(w.z); f[6] = bflo(w.w); f[7] = bfhi(w.w); }

namespace pg8 {
constexpr int BM = 256, BK = 64, HALF = 128, HTB = HALF * BK * 2, STAGE_BYTES = 8 * HTB, NXCD = 8, WGM = 8;
__host__ __device__ __forceinline__ int lds_byte(int r, int c) { const int st = (r >> 4) * 2 + (c >> 5), rr = r & 15, cc = c & 31, ob = rr * 64 + cc * 2; return st * 1024 + (ob ^ (((ob >> 9) & 1) << 5)); }
__host__ __device__ __forceinline__ void stage_rc(int b, int& R, int& C) { const int st = b / 1024, sb = b % 1024, swz = sb ^ (((sb >> 9) & 1) << 5); R = (st >> 1) * 16 + swz / 64; C = (st & 1) * 32 + (swz % 64) / 2; }
__host__ __device__ __forceinline__ int perm32(int rho) { const int n = rho >> 4, i = rho & 15; return 8 * (i >> 2) + 4 * n + (i & 3); }

struct Unit { int pm, pn; };
template <int LDA_, int LDB_, int K_, int NM_, int NN_, int ASH_, long long AGS_, long long AKTS_, bool FP8_ = false> struct Gemm { const bf16* A; const bf16* Bt; static constexpr bool fp8 = FP8_; static constexpr int lda = LDA_, ldb = LDB_, K = K_, nM = NM_, nN = NN_, a_shift = ASH_; static constexpr long long a_gstride = AGS_, a_kts = AKTS_; };

template <int nM, int nN> struct StaticOrder {
    static constexpr int nwg = nM * nN; int G, c;
    __device__ void init(int G_, int c_) { G = G_; c = c_; }
    __device__ bool next(int i, Unit& u) const {
        const long L = (long)i * G + c; if (L >= nwg) return false;
        int wgid = (int)L; { const int q = nwg / NXCD, r = nwg % NXCD, xcd = wgid % NXCD, off = wgid / NXCD; wgid = (xcd < r ? xcd * (q + 1) : r * (q + 1) + (xcd - r) * q) + off; }
        const int nig = WGM * nN, gid = wgid / nig, fm = gid * WGM, gsz = (nM - fm) < WGM ? (nM - fm) : WGM;
        u.pm = fm + ((wgid % nig) % gsz); u.pn = (wgid % nig) / gsz; return true;
    }
};

template <class GemmT, class Epi>
__device__ __forceinline__ void gemm_phase(LAS unsigned char* lds, const GemmT g, int G_, int c_, const Epi& E, const int tid) {
    StaticOrder<GemmT::nM, GemmT::nN> S; S.init(G_, c_);
    const int wid = __builtin_amdgcn_readfirstlane(tid >> 6), lane = tid & 63, wr = wid >> 2, wc = wid & 3, fr = lane & 15, fq = lane >> 4;
    constexpr int nt = GemmT::K / BK;
    unsigned voffA[2], voffB[2];
#pragma unroll
    for (int i = 0; i < 2; ++i) { int R, C; stage_rc(tid * 16 + i * 8192, R, C); const int Rb = Epi::PERM ? ((R & ~31) + perm32(R & 31)) : R;
        voffA[i] = (unsigned)(R * g.lda + C) * 2u; voffB[i] = (unsigned)(Rb * g.ldb + C) * 2u; }
    const size_t kstep = (size_t)(BK * 2);
    const size_t hstepA = (size_t)HALF * g.lda * 2, hstepB = (size_t)HALF * g.ldb * 2;
    const unsigned ldsw = (unsigned)wid * 1024u;
    const int aoff = lds_byte(wr * 64 + fr, fq * 8), boff = lds_byte(wc * 32 + fr, fq * 8);
#define PG8_SA(b, h) (((b) * 2 + (h)) * HTB)
#define PG8_SB(b, h) ((4 + (b) * 2 + (h)) * HTB)
#define PG8_STAGE(bufoff, gbase, voff) do { _Pragma("unroll") for (int _i = 0; _i < 2; ++_i) \
        __builtin_amdgcn_global_load_lds((const unsigned*)((const char*)(gbase) + (voff)[_i]), (LAS unsigned*)(lds + (bufoff) + ldsw + _i * 8192), 16, 0, 0); } while (0)
#define PG8_LDA(dst, b, h) do { _Pragma("unroll") for (int m = 0; m < 4; ++m) _Pragma("unroll") for (int k = 0; k < 2; ++k) dst[m][k] = *(const LAS bf16x8*)(lds + PG8_SA(b, h) + aoff + m * 2048 + k * 1024); } while (0)
#define PG8_LDB(dst, b, h) do { _Pragma("unroll") for (int n = 0; n < 2; ++n) _Pragma("unroll") for (int k = 0; k < 2; ++k) dst[n][k] = *(const LAS bf16x8*)(lds + PG8_SB(b, h) + boff + n * 2048 + k * 1024); } while (0)
#define PG8_CAT8(x0, x1) __builtin_shufflevector(__builtin_bit_cast(v4i_t, (x0)), __builtin_bit_cast(v4i_t, (x1)), 0, 1, 2, 3, 4, 5, 6, 7)
#define PG8_MMA(ai, bj, At, Bt) do { __builtin_amdgcn_s_setprio(1); _Pragma("unroll") for (int m = 0; m < 4; ++m) _Pragma("unroll") for (int n = 0; n < 2; ++n) { \
        if constexpr (GemmT::fp8) { _Pragma("unroll") for (int k = 0; k < 2; ++k) acc[ai][bj][m][n] = __builtin_bit_cast(f32x4, __builtin_amdgcn_mfma_i32_16x16x64_i8(__builtin_bit_cast(v4i_t, Bt[n][k]), __builtin_bit_cast(v4i_t, At[m][k]), __builtin_bit_cast(v4i_t, acc[ai][bj][m][n]), 0, 0, 0)); } \
        else { _Pragma("unroll") for (int k = 0; k < 2; ++k) acc[ai][bj][m][n] = __builtin_amdgcn_mfma_f32_16x16x32_bf16(Bt[n][k], At[m][k], acc[ai][bj][m][n], 0, 0, 0); } } \
        __builtin_amdgcn_s_setprio(0); } while (0)
#define PG8_WAIT_V(n) asm volatile("s_waitcnt vmcnt(" #n ")" ::: "memory")
#define PG8_WAIT_L(n) asm volatile("s_waitcnt lgkmcnt(" #n ")" ::: "memory")
#define PG8_BAR __builtin_amdgcn_s_barrier()
#define PG8_SCHED __builtin_amdgcn_sched_barrier(0)
#define PG8_APTR(u) ((const char*)g.A + 2 * ((size_t)(u).pm * 256 * g.lda + (size_t)((u).pn >> g.a_shift) * g.a_gstride))
#define PG8_BPTR(u) ((const char*)g.Bt + 2 * ((size_t)(u).pn * 256 * g.ldb))
    Unit cur, nxt; int ui = 0;
    if (!S.next(0, cur)) return;
    f32x4 acc[2][2][4][2];
#pragma unroll
    for (int a = 0; a < 2; ++a)
#pragma unroll
        for (int b = 0; b < 2; ++b)
#pragma unroll
            for (int m = 0; m < 4; ++m)
#pragma unroll
                for (int n = 0; n < 2; ++n) acc[a][b][m][n] = (f32x4){0.f, 0.f, 0.f, 0.f};
    bf16x8 At[4][2], B0[2][2], B1[2][2];
    unsigned pf0 = 0u, pf1 = 0u;
    const char* cA = PG8_APTR(cur); const char* cB = PG8_BPTR(cur);
    PG8_STAGE(PG8_SB(0, 0), cB, voffB); PG8_STAGE(PG8_SB(0, 1), cB + hstepB, voffB); PG8_STAGE(PG8_SA(0, 0), cA, voffA); PG8_STAGE(PG8_SA(0, 1), cA + hstepA, voffA);
    if (wr == 1) PG8_BAR;
    PG8_WAIT_V(2); PG8_BAR;
    PG8_STAGE(PG8_SB(1, 0), cB + kstep, voffB); PG8_STAGE(PG8_SA(1, 0), cA + kstep, voffA); PG8_STAGE(PG8_SB(1, 1), cB + hstepB + kstep, voffB);
    PG8_WAIT_V(6); PG8_BAR;
    for (;;) {
        const bool has_next = S.next(ui + 1, nxt);
        const char* nA = has_next ? PG8_APTR(nxt) : cA; const char* nB = has_next ? PG8_BPTR(nxt) : cB;
        constexpr int tseg = Epi::HOOK ? 8 : nt;
#pragma nounroll
        for (int t0 = 0; t0 < nt; t0 += tseg) {
        if constexpr (Epi::HOOK) { if (t0 != 0) { E.hook(acc, cur, (t0 >> 3) - 1, wr, wc, lane); asm volatile("" :: "v"(pf0), "v"(pf1)); } E.prefetch(cur, t0 >> 3, wr, wc, lane, pf0, pf1); }
#pragma nounroll
        for (int t = t0; t < t0 + tseg; t += 2) {
            const bool last = (t == nt - 2);
            const char* a1 = cA + (size_t)(t >> 2) * GemmT::a_kts + (size_t)((t & 3) + 1) * kstep;
            const char* a2 = last ? nA : cA + (size_t)((t + 2) >> 2) * GemmT::a_kts + (size_t)((t + 2) & 3) * kstep; const char* b2 = last ? nB : cB + (size_t)(t + 2) * kstep;
            const char* a3 = a2 + kstep; const char* b3 = b2 + kstep;
            PG8_LDB(B0, 0, 0); PG8_LDB(B1, 0, 1); PG8_SCHED; PG8_LDA(At, 0, 0); PG8_STAGE(PG8_SA(1, 1), a1 + hstepA, voffA);
            PG8_WAIT_V(8); PG8_WAIT_L(0); PG8_BAR; PG8_MMA(0, 0, At, B0); PG8_MMA(0, 1, At, B1); PG8_BAR; PG8_SCHED;
            PG8_LDA(At, 0, 1); PG8_STAGE(PG8_SB(0, 0), b2, voffB); PG8_STAGE(PG8_SB(0, 1), b2 + hstepB, voffB); PG8_STAGE(PG8_SA(0, 0), a2, voffA);
            PG8_WAIT_V(8); PG8_WAIT_L(0); PG8_BAR; PG8_MMA(1, 0, At, B0); PG8_MMA(1, 1, At, B1); PG8_BAR; PG8_SCHED;
            PG8_LDB(B0, 1, 0); PG8_LDB(B1, 1, 1); PG8_SCHED; PG8_LDA(At, 1, 0); PG8_STAGE(PG8_SA(0, 1), a2 + hstepA, voffA);
            PG8_WAIT_V(8); PG8_WAIT_L(0); PG8_BAR; PG8_MMA(0, 0, At, B0); PG8_MMA(0, 1, At, B1); PG8_BAR; PG8_SCHED;
            PG8_LDA(At, 1, 1); PG8_STAGE(PG8_SB(1, 0), b3, voffB); PG8_STAGE(PG8_SB(1, 1), b3 + hstepB, voffB); PG8_STAGE(PG8_SA(1, 0), a3, voffA);
            PG8_WAIT_V(8); PG8_WAIT_L(0); PG8_BAR; PG8_MMA(1, 0, At, B0); PG8_MMA(1, 1, At, B1); PG8_BAR; PG8_SCHED;
        }
        }
        if (wr == 0) PG8_BAR;
        { int le = lane; asm volatile("" : "+v"(le)); E(acc, cur, wr, wc, le & 15, le >> 4); if constexpr (Epi::HOOK) asm volatile("" :: "v"(pf0), "v"(pf1)); }
        if (!has_next) break;
#pragma unroll
        for (int a = 0; a < 2; ++a)
#pragma unroll
            for (int b = 0; b < 2; ++b)
#pragma unroll
                for (int m = 0; m < 4; ++m)
#pragma unroll
                    for (int n = 0; n < 2; ++n) acc[a][b][m][n] = (f32x4){0.f, 0.f, 0.f, 0.f};
        cur = nxt; cA = nA; cB = nB; ++ui;
        if (wr == 1) PG8_BAR;
    }
    PG8_WAIT_V(0);
    PG8_BAR;
#undef PG8_SA
#undef PG8_SB
#undef PG8_STAGE
#undef PG8_LDA
#undef PG8_LDB
#undef PG8_MMA
#undef PG8_CAT8
#undef PG8_WAIT_V
#undef PG8_WAIT_L
#undef PG8_BAR
#undef PG8_SCHED
#undef PG8_APTR
#undef PG8_BPTR
}

struct EpiProj {
    static constexpr bool PERM = true, HOOK = false;
    DI void hook(f32x4 (&)[2][2][4][2], const Unit&, int, int, int, int) const {}
    DI void prefetch(const Unit&, int, int, int, int, unsigned&, unsigned&) const {}
    bf16* O; int ldc;
    DI void operator()(const f32x4 (&acc)[2][2][4][2], const Unit& u, int wr, int wc, int fr, int fq) const {
        const int row0 = u.pm * BM + wr * 64 + fr, col0 = wc * 32 + 8 * fq;
        bf16* Ot = O + (size_t)u.pn * TS;
#pragma unroll
        for (int ai = 0; ai < 2; ++ai)
#pragma unroll
            for (int m = 0; m < 4; ++m) { bf16* rowp = Ot + (size_t)(row0 + ai * HALF + m * 16) * ldc + col0;
#pragma unroll
                for (int bj = 0; bj < 2; ++bj) { f32x4 v0 = acc[ai][bj][m][0], v1 = acc[ai][bj][m][1];
                    if (u.pn < 8) {
#pragma unroll
                        for (int j = 0; j < 4; ++j) { v0[j] = silu_f(v0[j]); v1[j] = silu_f(v1[j]); } }
                    u32x4 w; w.x = pk2(v0[0], v0[1]); w.y = pk2(v0[2], v0[3]); w.z = pk2(v1[0], v1[1]); w.w = pk2(v1[2], v1[3]);
                    __builtin_nontemporal_store(w, (u32x4*)(rowp + bj * HALF)); } }
    }
};
DI size_t r_off(int k, int pm, int dq, int ai, int bj, int m, int wr, int wc, int lane, int n) {
    return ((((((((((size_t)k * 128 + pm) * 4 + dq) * 2 + ai) * 2 + bj) * 4 + m) * 2 + wr) * 4 + wc) * 64 + lane) * 8) + n * 4;
}
struct EpiGate {
    static constexpr bool PERM = false, HOOK = false;
    bf16* R; const float* sH; const float* sW;
    DI void operator()(const f32x4 (&acc)[2][2][4][2], const Unit& u, int wr, int wcp, int fr, int fq) const {
        const int lane = fq * 16 + fr, dq = u.pn >> 2, bj = (u.pn >> 1) & 1, wc = 2 * (u.pn & 1) + (wcp >> 1), n = wcp & 1;
        f32x4 cs[4];
#pragma unroll
        for (int i = 0; i < 4; ++i) cs[i] = *(const f32x4*)(sW + u.pn * BM + (i >> 1) * HALF + wcp * 32 + (i & 1) * 16 + 4 * fq);
        float rsv[2][4];
#pragma unroll
        for (int ai = 0; ai < 2; ++ai)
#pragma unroll
            for (int m = 0; m < 4; ++m) rsv[ai][m] = sH[u.pm * BM + ai * HALF + wr * 64 + m * 16 + fr];
#pragma unroll
        for (int ai = 0; ai < 2; ++ai)
#pragma unroll
            for (int m = 0; m < 4; ++m) {
                const float rs = rsv[ai][m];
                float e[4][4];
#pragma unroll
                for (int i = 0; i < 4; ++i)
#pragma unroll
                    for (int j = 0; j < 4; ++j) { const float gq = (float)__float_as_int(acc[ai][i >> 1][m][i & 1][j]) * rs * cs[i][j]; e[i][j] = 1.f + __expf(-fminf(fmaxf(gq, -30.f), 30.f)); }
#pragma unroll
                for (int k = 0; k < 4; ++k) { float r[4];
#pragma unroll
                    for (int j = 0; j < 4; ++j) r[j] = k < 3 ? e[k + 1][j] * __builtin_amdgcn_rcpf(e[k][j]) : __builtin_amdgcn_rcpf(e[3][j]);
                    u32x2 w; w.x = pk2(r[0], r[1]); w.y = pk2(r[2], r[3]);
                    __builtin_nontemporal_store(w, (u32x2*)(R + r_off(k, u.pm, dq, ai, bj, m, wr, wc, lane, n))); }
            }
    }
    DI void hook(f32x4 (&)[2][2][4][2], const Unit&, int, int, int, int) const {}
    DI void prefetch(const Unit&, int, int, int, int, unsigned&, unsigned&) const {}
};
struct EpiMergeUp {
    static constexpr bool PERM = true, HOOK = true;
    const bf16* R; bf16* O;
    DI void scale(f32x4 (&acc)[2][2][4][2], const Unit& u, int k, int wr, int wc, int lane) const {
        asm volatile("" : "+v"(lane));
        const bf16* base = R + r_off(k, u.pm, u.pn, 0, 0, 0, wr, wc, lane, 0);
#pragma unroll
        for (int ai = 0; ai < 2; ++ai) {
            u32x4 v[2][4];
#pragma unroll
            for (int bj = 0; bj < 2; ++bj)
#pragma unroll
                for (int m = 0; m < 4; ++m) v[bj][m] = *(const u32x4*)(base + (size_t)((ai * 2 + bj) * 4 + m) * 4096);
#pragma unroll
            for (int bj = 0; bj < 2; ++bj)
#pragma unroll
                for (int m = 0; m < 4; ++m) { const u32x4 w = v[bj][m];
                    acc[ai][bj][m][0] *= (f32x4){bflo(w.x), bfhi(w.x), bflo(w.y), bfhi(w.y)}; acc[ai][bj][m][1] *= (f32x4){bflo(w.z), bfhi(w.z), bflo(w.w), bfhi(w.w)}; }
            __builtin_amdgcn_sched_barrier(0);
        }
    }
    DI void hook(f32x4 (&acc)[2][2][4][2], const Unit& u, int k, int wr, int wc, int lane) const { scale(acc, u, k, wr, wc, lane); }
    DI void prefetch(const Unit& u, int k, int wr, int wc, int lane, unsigned& p0, unsigned& p1) const {
        asm volatile("" : "+v"(lane));
        const char* b = (const char*)(R + r_off(k, u.pm, u.pn, 0, 0, 0, wr, wc, 0, 0)) + (lane >> 3) * 8192 + (lane & 7) * 128;
        p0 = *(const unsigned*)b; p1 = *(const unsigned*)(b + 8 * 8192);
    }
    DI void operator()(f32x4 (&acc)[2][2][4][2], const Unit& u, int wr, int wc, int fr, int fq) const {
        scale(acc, u, 3, wr, wc, fq * 16 + fr);
        const int row0 = u.pm * BM + wr * 64 + fr, col0 = wc * 32 + 8 * fq;
        bf16* Ot = O + (size_t)u.pn * TS;
#pragma unroll
        for (int ai = 0; ai < 2; ++ai)
#pragma unroll
            for (int m = 0; m < 4; ++m) { bf16* rowp = Ot + (size_t)(row0 + ai * HALF + m * 16) * TP + col0;
#pragma unroll
                for (int bj = 0; bj < 2; ++bj) { const f32x4 v0 = acc[ai][bj][m][0], v1 = acc[ai][bj][m][1];
                    u32x4 w; w.x = pk2(v0[0], v0[1]); w.y = pk2(v0[2], v0[3]); w.z = pk2(v1[0], v1[1]); w.w = pk2(v1[2], v1[3]);
                    __builtin_nontemporal_store(w, (u32x4*)(rowp + bj * HALF)); } }
    }
};
template <bool IN_BF16> struct EpiOut {
    static constexpr bool PERM = true, HOOK = false;
    DI void hook(f32x4 (&)[2][2][4][2], const Unit&, int, int, int, int) const {}
    DI void prefetch(const Unit&, int, int, int, int, unsigned&, unsigned&) const {}
    const void* xin; bf16* xout; const float* gate;
    DI void operator()(const f32x4 (&acc)[2][2][4][2], const Unit& u, int wr, int wc, int fr, int fq) const {
        const int row0 = u.pm * BM + wr * 64 + fr, col0 = u.pn * BM + wc * 32 + 8 * fq;
        const float* gp = gate + (size_t)(u.pm >> 4) * 3072 + col0;
        f32x4 gv[2][2];
#pragma unroll
        for (int bj = 0; bj < 2; ++bj)
#pragma unroll
            for (int n = 0; n < 2; ++n) gv[bj][n] = *(const f32x4*)(gp + bj * HALF + n * 4);
        if constexpr (IN_BF16) {
            u32x4 xb[2][4][2];
#pragma unroll
            for (int ai = 0; ai < 2; ++ai)
#pragma unroll
                for (int m = 0; m < 4; ++m)
#pragma unroll
                    for (int bj = 0; bj < 2; ++bj) xb[ai][m][bj] = *(const u32x4*)((const bf16*)xin + (size_t)(row0 + ai * HALF + m * 16) * D + col0 + bj * HALF);
#pragma unroll
            for (int ai = 0; ai < 2; ++ai)
#pragma unroll
                for (int m = 0; m < 4; ++m) { const size_t off = (size_t)(row0 + ai * HALF + m * 16) * D + col0;
#pragma unroll
                    for (int bj = 0; bj < 2; ++bj) { const u32x4 w = xb[ai][m][bj];
                        f32x4 x0 = (f32x4){bflo(w.x), bfhi(w.x), bflo(w.y), bfhi(w.y)}, x1 = (f32x4){bflo(w.z), bfhi(w.z), bflo(w.w), bfhi(w.w)};
                        x0 += gv[bj][0] * acc[ai][bj][m][0]; x1 += gv[bj][1] * acc[ai][bj][m][1];
                        u32x4 o; o.x = pk2(x0[0], x0[1]); o.y = pk2(x0[2], x0[3]); o.z = pk2(x1[0], x1[1]); o.w = pk2(x1[2], x1[3]);
                        __builtin_nontemporal_store(o, (u32x4*)(xout + off + bj * HALF)); } }
        } else {
#pragma unroll
            for (int ai = 0; ai < 2; ++ai) {
                f32x4 xf[4][2][2];
#pragma unroll
                for (int m = 0; m < 4; ++m) { const size_t off = (size_t)(row0 + ai * HALF + m * 16) * D + col0;
#pragma unroll
                    for (int bj = 0; bj < 2; ++bj) { xf[m][bj][0] = *(const f32x4*)((const float*)xin + off + bj * HALF); xf[m][bj][1] = *(const f32x4*)((const float*)xin + off + bj * HALF + 4); } }
#pragma unroll
                for (int m = 0; m < 4; ++m) { const size_t off = (size_t)(row0 + ai * HALF + m * 16) * D + col0;
#pragma unroll
                    for (int bj = 0; bj < 2; ++bj) { f32x4 x0 = xf[m][bj][0], x1 = xf[m][bj][1];
                        x0 += gv[bj][0] * acc[ai][bj][m][0]; x1 += gv[bj][1] * acc[ai][bj][m][1];
                        u32x4 o; o.x = pk2(x0[0], x0[1]); o.y = pk2(x0[2], x0[3]); o.z = pk2(x1[0], x1[1]); o.w = pk2(x1[2], x1[3]);
                        __builtin_nontemporal_store(o, (u32x4*)(xout + off + bj * HALF)); } }
            }
        }
    }
};
}

DI void lds_barrier() { asm volatile("s_waitcnt lgkmcnt(0)" ::: "memory"); __builtin_amdgcn_s_barrier(); asm volatile("" ::: "memory"); }
struct LayerP {
    const float *sinks, *pool_scale, *conv_w, *conv_b, *a_log, *d_skip, *ssm_norm_w;
    const bf16* poolT;
    bf16* proj; const float* dt; float* cd; bf16* st_ret; bf16* st_ssd;
};


DI void pf_item(const LayerP& P, int phase, int it, int tid, unsigned& p0, unsigned& p1, unsigned& p2) {
    if (it < 0) return;
    const bf16* proj = P.proj;
    if (phase == 3) {
        if (it < 512) { const int b = it >> 6, nb = (it >> 1) & 31, hkv = it & 1; const size_t t0 = (size_t)b * SEQ + (size_t)nb * 128;
            const int key = tid >> 1; const size_t krow = (nb > 0 || key >= 128) ? t0 + key - 128 : t0;
            p0 = *(const unsigned*)(pcol(proj, ((tid & 1) ? C_SV : C_SK) + hkv * 64) + krow * TP);
            p1 = *(const unsigned*)(pcol(proj, C_SQ + hkv * 256 + (tid & 3) * 64) + (t0 + (tid >> 2)) * TP);
            p2 = *(const unsigned*)(pcol(proj, C_SG + hkv * 256 + (tid & 3) * 64) + (t0 + (tid >> 2)) * TP);
        } else if (it < 1024) { const int q = it - 512, b = q >> 6, c = (q >> 1) & 31, grp = q & 1; const size_t t0 = (size_t)b * SEQ + (size_t)c * 128;
            p0 = *(const unsigned*)(pcol(proj, C_MX + grp * 256 + (tid & 3) * 64) + (t0 + (tid >> 2)) * TP);
            p1 = *(const unsigned*)(pcol(proj, C_MX + 512 + grp * 128 + (tid & 1) * 64) + (t0 + ((tid & 255) >> 1)) * TP);
        } else if (it < 2048) { const int q = it - 1024, b = q >> 7, c = (q >> 2) & 31, h = q & 3; const size_t t0 = (size_t)b * SEQ + (size_t)c * 128;
            p0 = *(const unsigned*)(pcol(proj, C_RV + h * 128 + (tid & 1) * 64) + (t0 + ((tid & 255) >> 1)) * TP);
            p1 = *(const unsigned*)(pcol(proj, C_RK + h * 64) + (t0 + (tid & 127)) * TP);
        } else { const int q = it - 2048, tile = q >> 2, g = q & 3; const size_t t0 = (size_t)tile * 128;
            p0 = *(const unsigned*)(pcol(proj, ((tid & 256) ? C_PG : C_PX) + g * 128 + (tid & 1) * 64) + (t0 + ((tid & 255) >> 1)) * TP);
        }
    } else {
        if (it < 512) { const int b = it >> 6, c = (it >> 1) & 31, grp = it & 1; const size_t t0 = (size_t)b * SEQ + (size_t)c * 128;
            p0 = *(const unsigned*)(pcol(proj, C_MX + grp * 256 + (tid & 3) * 64) + (t0 + (tid >> 2)) * TP);
            p1 = *(const unsigned*)(pcol(proj, C_MX + ((tid & 256) ? 768 : 512) + grp * 128 + (tid & 1) * 64) + (t0 + ((tid & 255) >> 1)) * TP);
            p2 = *(const unsigned*)(pcol(proj, C_MZ + grp * 256 + (tid & 3) * 64) + (t0 + (tid >> 2)) * TP);
        } else { const int q = it - 512, b = q >> 7, c = (q >> 2) & 31, h = q & 3; const size_t t0 = (size_t)b * SEQ + (size_t)c * 128;
            p0 = (tid < 256) ? *(const unsigned*)(pcol(proj, ((tid & 128) ? C_RQ : C_RK) + h * 64) + (t0 + (tid & 127)) * TP)
                             : *(const unsigned*)(pcol(proj, C_RV + h * 128 + (tid & 1) * 64) + (t0 + ((tid & 255) >> 1)) * TP);
            p1 = *(const unsigned*)(pcol(proj, C_RG + h * 128 + (tid & 1) * 64) + (t0 + ((tid & 255) >> 1)) * TP);
            p2 = *(const unsigned*)(P.st_ret + ((size_t)((b * 32 + c) * 4 + h)) * 8192 + (tid & 127) * 64);
        }
    }
}
#define PF_DECL unsigned pf0_ = 0u, pf1_ = 0u, pf2_ = 0u
#define PF_ISSUE(phase) pf_item(P, (phase), nxt, tid, pf0_, pf1_, pf2_)
#define PF_DONE asm volatile("" :: "v"(pf0_), "v"(pf1_), "v"(pf2_))

DI void swa_unit(LAS unsigned char* lds, const LayerP& P, int b, int nb, int hkv, int tid, int nxt = -1) {
    asm volatile("" : "+v"(tid));
    const int lane = tid & 63, wave = tid >> 6, r32 = lane & 31, h2 = lane >> 5;
    LAS unsigned char* Ksm = lds;
    LAS unsigned char* Vsm = lds + 256 * 144;
    bf16* proj = P.proj;
    const size_t t0 = (size_t)b * SEQ + (size_t)nb * 128;
    LAS unsigned char* QO = lds + 256 * 144 + 256 * 192;
    {
      u32x4 kr[4], vr[4], qr[8];
      const bf16* qsrc = pcol(proj, C_SQ + hkv * 256) + t0 * TP;
#pragma unroll
      for (int i = 0; i < 4; ++i) { const int p = tid + 512 * i, key = p >> 3, ch = p & 7;
          kr[i] = zero4(); vr[i] = kr[i];
          if (nb > 0 || key >= 128) { const size_t ro = (t0 + key - 128) * TP + ch * 8; kr[i] = __builtin_nontemporal_load((const u32x4*)(pcol(proj, C_SK + hkv * 64) + ro)); vr[i] = __builtin_nontemporal_load((const u32x4*)(pcol(proj, C_SV + hkv * 64) + ro)); } }
#pragma unroll
      for (int i = 0; i < 8; ++i) { const int p = tid + 512 * i, row = p >> 5, c32 = p & 31; qr[i] = *(const u32x4*)(qsrc + (size_t)row * TP + c32 * 8); }
      __builtin_amdgcn_sched_barrier(0);
#pragma unroll
      for (int i = 0; i < 4; ++i) { const int p = tid + 512 * i, key = p >> 3, ch = p & 7;
          *(LAS u32x4*)(Ksm + key * 144 + ch * 16) = kr[i]; *(LAS u32x4*)(Vsm + key * 192 + ch * 16) = vr[i]; }
#pragma unroll
      for (int i = 0; i < 8; ++i) { const int p = tid + 512 * i, row = p >> 5, c32 = p & 31;
          *(LAS u32x4*)(QO + ((c32 >> 3) * 128 + row) * 144 + (c32 & 7) * 16) = qr[i]; } }
    lds_barrier();
    PF_DECL; PF_ISSUE(3);
    const int gi = wave >> 1, hq = hkv * 4 + gi;
    const float slope2 = __builtin_amdgcn_exp2f(-(float)(hq + 1)) * 1.44269504f, sink2 = P.sinks[hq] * 1.44269504f;
#pragma nounroll
    for (int sub = 0; sub < 2; ++sub) {
        const int r0 = (wave & 1) * 64 + sub * 32, r = r0 + r32, kt0 = r0 >> 5;
        LAS unsigned char* qo_row = QO + (gi * 128 + r) * 144;
        bf16x8 qf[4];
#pragma unroll
        for (int ks = 0; ks < 4; ++ks) qf[ks] = *(const LAS bf16x8*)(qo_row + (16 * ks + 8 * h2) * 2);
        f32x16 st[5];
        bf16x8 ka[2][4];
#pragma unroll
        for (int ks = 0; ks < 4; ++ks) ka[0][ks] = *(const LAS bf16x8*)(Ksm + (32 * kt0 + r32) * 144 + (16 * ks + 8 * h2) * 2);
#pragma unroll
        for (int i = 0; i < 5; ++i) {
            if (i < 4) {
#pragma unroll
                for (int ks = 0; ks < 4; ++ks) ka[(i + 1) & 1][ks] = *(const LAS bf16x8*)(Ksm + (32 * (kt0 + i + 1) + r32) * 144 + (16 * ks + 8 * h2) * 2); }
            __builtin_amdgcn_sched_barrier(0);
#pragma unroll
            for (int e = 0; e < 16; ++e) st[i][e] = 0.f;
#pragma unroll
            for (int ks = 0; ks < 4; ++ks) st[i] = MFMA32(ka[i & 1][ks], qf[ks], st[i]);
            __builtin_amdgcn_sched_barrier(0);
        }
        const int dbase = 128 + r32 - 4 * h2;
        const int lo = dbase - (nb > 0 ? 127 : min(127, r));
        const float sd = slope2 * (float)dbase, sinkr = sink2 + sd, ninf = -__builtin_inff();
#pragma unroll
        for (int i = 0; i < 5; ++i) {
#pragma unroll
            for (int e = 0; e < 16; ++e) { const int c = 32 * i + (e & 3) + 8 * (e >> 2);
                float sv = fmaf(slope2, (float)c, st[i][e]);
                if (i == 0) sv = (c >= lo) ? sv : ninf;
                if (i == 4) sv = (c <= dbase) ? sv : ninf;
                st[i][e] = sv; }
            __builtin_amdgcn_sched_barrier(0);
        }
        if (nb == 0) {
#pragma unroll
            for (int i = 1; i < 4; ++i)
#pragma unroll
                for (int e = 0; e < 16; ++e) { const int c = 32 * i + (e & 3) + 8 * (e >> 2); st[i][e] = (c >= lo) ? st[i][e] : ninf; }
        }
        float m = sinkr;
#pragma unroll
        for (int i = 0; i < 5; ++i)
#pragma unroll
            for (int e = 0; e < 16; ++e) m = fmaxf(m, st[i][e]);
        { float mt = m - sd; mt = fmaxf(mt, lane_xor(mt, 32, lane)); m = mt + sd; }
        float sum = 0.f;
#pragma unroll
        for (int i = 0; i < 5; ++i) {
#pragma unroll
            for (int e = 0; e < 16; ++e) { const float p = __builtin_amdgcn_exp2f(st[i][e] - m); st[i][e] = p; sum += p; }
            __builtin_amdgcn_sched_barrier(0);
        }
        sum += lane_xor(sum, 32, lane);
        const float inv = __builtin_amdgcn_rcpf(sum + __builtin_amdgcn_exp2f(sinkr - m));
        f32x16 o[2];
#pragma unroll
        for (int mt = 0; mt < 2; ++mt)
#pragma unroll
            for (int e = 0; e < 16; ++e) o[mt][e] = 0.f;
        bf16x8 va[2][2];
#pragma unroll
        for (int mt = 0; mt < 2; ++mt) { const int k0 = 32 * kt0 + 4 * h2; va[0][mt] = tr_frag(Vsm, 192, k0, k0 + 8, 32 * mt, lane); }
#pragma unroll
        for (int stp = 0; stp < 10; ++stp) { const int i = stp >> 1, s2 = stp & 1;
            if (stp < 9) { const int k1 = 32 * kt0 + 16 * (stp + 1) + 4 * h2;
#pragma unroll
                for (int mt = 0; mt < 2; ++mt) va[(stp + 1) & 1][mt] = tr_frag(Vsm, 192, k1, k1 + 8, 32 * mt, lane); }
            const bf16x8 bp = pack8(st[i][8 * s2], st[i][8 * s2 + 1], st[i][8 * s2 + 2], st[i][8 * s2 + 3], st[i][8 * s2 + 4], st[i][8 * s2 + 5], st[i][8 * s2 + 6], st[i][8 * s2 + 7]);
            __builtin_amdgcn_sched_barrier(0);
#pragma unroll
            for (int mt = 0; mt < 2; ++mt) o[mt] = MFMA32(va[stp & 1][mt], bp, o[mt]);
            __builtin_amdgcn_sched_barrier(0);
        }
#pragma unroll
        for (int mt = 0; mt < 2; ++mt)
#pragma unroll
            for (int g4 = 0; g4 < 4; ++g4) { u32x2 w; w.x = pk2(o[mt][4 * g4] * inv, o[mt][4 * g4 + 1] * inv); w.y = pk2(o[mt][4 * g4 + 2] * inv, o[mt][4 * g4 + 3] * inv);
                *(LAS u32x2*)(qo_row + (32 * mt + 8 * g4 + 4 * h2) * 2) = w; }
    }
    { bf16* gbase = pcol(proj, C_SG + hq * 64) + t0 * TP + (size_t)((wave & 1) * 64 + (lane >> 3)) * TP + (lane & 7) * 8;
      u32x4 gv[8];
#pragma unroll
      for (int it = 0; it < 8; ++it) gv[it] = *(const u32x4*)(gbase + (size_t)(it * 8) * TP);
#pragma unroll
      for (int it = 0; it < 8; ++it) { const int row = (wave & 1) * 64 + it * 8 + (lane >> 3), c8 = lane & 7;
          *(u32x4*)(gbase + (size_t)(it * 8) * TP) = gate8(*(const LAS u32x4*)(QO + (gi * 128 + row) * 144 + c8 * 16), gv[it]); } }
    PF_DONE;
    lds_barrier();
}

DI void pool_unit(LAS unsigned char* lds, const LayerP& P, int tile, int g, int tid, int nxt = -1) {
    asm volatile("" : "+v"(tid));
    const int lane = tid & 63, wave = tid >> 6, r32 = lane & 31, h2 = lane >> 5;
    LAS unsigned char* Usm = lds;
    LAS unsigned char* Ysm = lds + 46080;
    LAS unsigned char* Wsm = lds + 46080 + 34816;
    bf16* proj = P.proj;
    const size_t t0 = (size_t)tile * 128; const int seq0 = (int)(t0 & (SEQ - 1)), w = 2 << g;
    {
      u32x4 ur[5], wr4[4];
#pragma unroll
      for (int i = 0; i < 5; ++i) { const int p = tid + 512 * i, row = p >> 4, ch = p & 15, l = row - 15;
          ur[i] = zero4();
          if (row < 143 && (l >= 0 || seq0 > 0)) ur[i] = __builtin_nontemporal_load((const u32x4*)(pcol(proj, C_PX + g * 128) + (size_t)((long)t0 + l) * TP + ch * 8)); }
#pragma unroll
      for (int i = 0; i < 4; ++i) { const int p = tid + 512 * i, e = p >> 4, ch = p & 15; wr4[i] = *(const u32x4*)(P.poolT + (size_t)(g * 128 + e) * 128 + ch * 8); }
      __builtin_amdgcn_sched_barrier(0);
#pragma unroll
      for (int i = 0; i < 5; ++i) { const int p = tid + 512 * i, row = p >> 4, ch = p & 15;
          if (row < 144) *(LAS u32x4*)(Usm + row * 320 + ch * 16) = ur[i]; }
#pragma unroll
      for (int i = 0; i < 4; ++i) { const int p = tid + 512 * i, e = p >> 4, ch = p & 15; const u32x4 wv = wr4[i];
          *(LAS u32x2*)(Wsm + e * 264 + ch * 16) = (u32x2){wv.x, wv.y}; *(LAS u32x2*)(Wsm + e * 264 + ch * 16 + 8) = (u32x2){wv.z, wv.w}; } }
    lds_barrier();
    PF_DECL; PF_ISSUE(3);
    const int tt = wave >> 1, et0 = 2 * (wave & 1);
    bf16x8 mf[3];
    { const int cnt = min(seq0 + 32 * tt + r32 + 1, w); const float ic = 1.f / (float)cnt;
#pragma unroll
      for (int ks = 0; ks < 3; ++ks) { float mv[8];
#pragma unroll
          for (int i = 0; i < 8; ++i) { const int dd = 16 * ks + 8 * h2 + i - 15 - r32; mv[i] = ((dd > -w && dd <= 0) ? ic : 0.f) - (dd == 0 ? 1.f : 0.f); }
          mf[ks] = pack8(mv[0], mv[1], mv[2], mv[3], mv[4], mv[5], mv[6], mv[7]); } }
    f32x16 acc[2];
#pragma unroll
    for (int et = 0; et < 2; ++et)
#pragma unroll
        for (int e = 0; e < 16; ++e) acc[et][e] = 0.f;
    bf16x8 uf[2][3];
#pragma unroll
    for (int ks = 0; ks < 3; ++ks) { const int k0 = 32 * tt + 16 * ks + 8 * h2; uf[0][ks] = tr_frag(Usm, 320, k0, k0 + 4, 0, lane); }
#pragma unroll
    for (int ct = 0; ct < 4; ++ct) {
        bf16x8 wf[2][2];
#pragma unroll
        for (int s2 = 0; s2 < 2; ++s2)
#pragma unroll
            for (int et = 0; et < 2; ++et) { const LAS unsigned char* wp = Wsm + (32 * (et0 + et) + r32) * 264 + (32 * ct + 16 * s2 + 4 * h2) * 2;
                const u32x2 lo = *(const LAS u32x2*)wp, hi = *(const LAS u32x2*)(wp + 16);
                wf[s2][et] = __builtin_bit_cast(bf16x8, (u32x4){lo.x, lo.y, hi.x, hi.y}); }
        if (ct < 3) {
#pragma unroll
            for (int ks = 0; ks < 3; ++ks) { const int k0 = 32 * tt + 16 * ks + 8 * h2; uf[(ct + 1) & 1][ks] = tr_frag(Usm, 320, k0, k0 + 4, 32 * (ct + 1), lane); } }
        __builtin_amdgcn_sched_barrier(0);
        f32x16 Dm;
#pragma unroll
        for (int e = 0; e < 16; ++e) Dm[e] = 0.f;
#pragma unroll
        for (int ks = 0; ks < 3; ++ks) Dm = MFMA32(uf[ct & 1][ks], mf[ks], Dm);
#pragma unroll
        for (int s2 = 0; s2 < 2; ++s2) {
            const bf16x8 bp = pack8(Dm[8 * s2], Dm[8 * s2 + 1], Dm[8 * s2 + 2], Dm[8 * s2 + 3], Dm[8 * s2 + 4], Dm[8 * s2 + 5], Dm[8 * s2 + 6], Dm[8 * s2 + 7]);
#pragma unroll
            for (int et = 0; et < 2; ++et) acc[et] = MFMA32(wf[s2][et], bp, acc[et]);
        }
        __builtin_amdgcn_sched_barrier(0);
    }
#pragma unroll
    for (int et = 0; et < 2; ++et)
#pragma unroll
        for (int g4 = 0; g4 < 4; ++g4) { u32x2 o; o.x = pk2(acc[et][4 * g4], acc[et][4 * g4 + 1]); o.y = pk2(acc[et][4 * g4 + 2], acc[et][4 * g4 + 3]);
            *(LAS u32x2*)(Ysm + (32 * tt + r32) * 272 + (32 * (et0 + et) + 8 * g4 + 4 * h2) * 2) = o; }
    { bf16* gbase = pcol(proj, C_PG + g * 128) + t0 * TP;
      u32x4 gvv[4];
#pragma unroll
      for (int it = 0; it < 4; ++it) gvv[it] = *(const u32x4*)(gbase + (size_t)(32 * tt + it * 8 + (lane >> 3)) * TP + 64 * (wave & 1) + (lane & 7) * 8);
      const f32x4 s0 = *(const f32x4*)(P.pool_scale + g * 128 + 64 * (wave & 1) + (lane & 7) * 8), s1 = *(const f32x4*)(P.pool_scale + g * 128 + 64 * (wave & 1) + (lane & 7) * 8 + 4);
      __builtin_amdgcn_sched_barrier(0);
#pragma unroll
      for (int it = 0; it < 4; ++it) { const int row = 32 * tt + it * 8 + (lane >> 3), ch = 64 * (wave & 1) + (lane & 7) * 8;
          bf16* gp = gbase + (size_t)row * TP + ch; const u32x4 yv = *(const LAS u32x4*)(Ysm + row * 272 + ch * 2), gv = gvv[it];
          u32x4 o; o.x = pk2(bflo(yv.x) * s0[0] * bflo(gv.x), bfhi(yv.x) * s0[1] * bfhi(gv.x)); o.y = pk2(bflo(yv.y) * s0[2] * bflo(gv.y), bfhi(yv.y) * s0[3] * bfhi(gv.y));
          o.z = pk2(bflo(yv.z) * s1[0] * bflo(gv.z), bfhi(yv.z) * s1[1] * bfhi(gv.z)); o.w = pk2(bflo(yv.w) * s1[2] * bflo(gv.w), bfhi(yv.w) * s1[3] * bfhi(gv.w));
          *(u32x4*)gp = o; } }
    PF_DONE;
    lds_barrier();
}

DI float ret_lg(int h) { return log2f(1.f - exp2f(-5.f - (float)h)); }
DI void retU_unit(LAS unsigned char* lds, const LayerP& P, int b, int c, int h, int tid, int nxt = -1) {
    asm volatile("" : "+v"(tid));
    const int lane = tid & 63, wave = tid >> 6, r32 = lane & 31, h2 = lane >> 5;
    LAS unsigned char* Ksm = lds;
    LAS unsigned char* Vsm = lds + 128 * 192;
    const bf16* proj = P.proj; const size_t t0 = (size_t)b * SEQ + (size_t)c * 128; const float lg = ret_lg(h);
    u32x4 kr[2], vr[4];
#pragma unroll
    for (int i = 0; i < 2; ++i) { const int p = tid + 512 * i, s = p >> 3, ch = p & 7; kr[i] = __builtin_nontemporal_load((const u32x4*)(pcol(proj, C_RK + h * 64) + (t0 + s) * TP + ch * 8)); }
#pragma unroll
    for (int i = 0; i < 4; ++i) { const int p = tid + 512 * i, s = p >> 4, ch = p & 15; vr[i] = __builtin_nontemporal_load((const u32x4*)(pcol(proj, C_RV + h * 128) + (t0 + s) * TP + ch * 8)); }
    __builtin_amdgcn_sched_barrier(0);
#pragma unroll
    for (int i = 0; i < 2; ++i) { const int p = tid + 512 * i, s = p >> 3, ch = p & 7; float f[8];
        unpack8(kr[i], f); const float dk = __builtin_amdgcn_exp2f(lg * (float)(127 - s));
        u32x4 o; o.x = pk2(f[0] * dk, f[1] * dk); o.y = pk2(f[2] * dk, f[3] * dk); o.z = pk2(f[4] * dk, f[5] * dk); o.w = pk2(f[6] * dk, f[7] * dk);
        *(LAS u32x4*)(Ksm + s * 192 + ch * 16) = o; }
#pragma unroll
    for (int i = 0; i < 4; ++i) { const int p = tid + 512 * i, s = p >> 4, ch = p & 15;
        *(LAS u32x4*)(Vsm + s * 320 + ch * 16) = vr[i]; }
    lds_barrier();
    PF_DECL; PF_ISSUE(3);
    const int mt = wave >> 2, nt = wave & 3;
    f32x16 acc;
#pragma unroll
    for (int e = 0; e < 16; ++e) acc[e] = 0.f;
    bf16x8 fa[8], fbb[8];
#pragma unroll
    for (int ks = 0; ks < 8; ++ks) { const int k0 = 16 * ks + 8 * h2; fa[ks] = tr_frag(Ksm, 192, k0, k0 + 4, 32 * mt, lane); fbb[ks] = tr_frag(Vsm, 320, k0, k0 + 4, 32 * nt, lane); }
    __builtin_amdgcn_sched_barrier(0);
#pragma unroll
    for (int ks = 0; ks < 8; ++ks) acc = MFMA32(fa[ks], fbb[ks], acc);
    bf16* St = P.st_ret + ((size_t)((b * 32 + c) * 4 + h)) * 8192;
#pragma unroll
    for (int g4 = 0; g4 < 4; ++g4) { u32x2 o; o.x = pk2(acc[4 * g4], acc[4 * g4 + 1]); o.y = pk2(acc[4 * g4 + 2], acc[4 * g4 + 3]);
        *(u32x2*)(St + ((nt * 4 + 2 * mt + (g4 >> 1)) * 64 + (g4 & 1) * 32 + r32) * 8 + 4 * h2) = o; }
    PF_DONE;
    lds_barrier();
}

DI void retO_unit(LAS unsigned char* lds, const LayerP& P, int b, int c, int h, int tid, int nxt = -1) {
    asm volatile("" : "+v"(tid));
    const int lane = tid & 63, wave = tid >> 6, r32 = lane & 31, h2 = lane >> 5;
    LAS unsigned char* Ksm = lds;
    LAS unsigned char* Vsm = lds + 128 * 144;
    LAS unsigned char* Qsm = lds + 128 * 144 + 128 * 320;
    LAS unsigned char* Osm = Qsm + 128 * 144;
    LAS float* red = (LAS float*)(Osm + 128 * 272);
    bf16* proj = P.proj; const size_t t0 = (size_t)b * SEQ + (size_t)c * 128; const float lg = ret_lg(h);
    const int lt = wave >> 1, dvh = wave & 1, l = 32 * lt + r32;
    u32x4 kr[2], qr[2], vr[4]; bf16x8 sfr[2][4];
#pragma unroll
    for (int i = 0; i < 2; ++i) { const int p = tid + 512 * i, s = p >> 3, ch = p & 7;
        kr[i] = __builtin_nontemporal_load((const u32x4*)(pcol(proj, C_RK + h * 64) + (t0 + s) * TP + ch * 8));
        qr[i] = __builtin_nontemporal_load((const u32x4*)(pcol(proj, C_RQ + h * 64) + (t0 + s) * TP + ch * 8)); }
#pragma unroll
    for (int i = 0; i < 4; ++i) { const int p = tid + 512 * i, s = p >> 4, ch = p & 15;
        vr[i] = __builtin_nontemporal_load((const u32x4*)(pcol(proj, C_RV + h * 128) + (t0 + s) * TP + ch * 8)); }
    { const bf16* St = P.st_ret + ((size_t)((b * 32 + c) * 4 + h)) * 8192;
#pragma unroll
      for (int m2 = 0; m2 < 2; ++m2)
#pragma unroll
          for (int ks = 0; ks < 4; ++ks) sfr[m2][ks] = *(const bf16x8*)(St + (((2 * dvh + m2) * 4 + ks) * 64 + lane) * 8); }
    __builtin_amdgcn_sched_barrier(0);
#pragma unroll
    for (int i = 0; i < 2; ++i) { const int p = tid + 512 * i, s = p >> 3, ch = p & 7;
        *(LAS u32x4*)(Ksm + s * 144 + ch * 16) = kr[i]; *(LAS u32x4*)(Qsm + s * 144 + ch * 16) = qr[i]; }
#pragma unroll
    for (int i = 0; i < 4; ++i) { const int p = tid + 512 * i, s = p >> 4, ch = p & 15;
        *(LAS u32x4*)(Vsm + s * 320 + ch * 16) = vr[i]; }
    lds_barrier();
    PF_DECL; PF_ISSUE(5);
    bf16x8 qf[4];
#pragma unroll
    for (int ks = 0; ks < 4; ++ks) qf[ks] = *(const LAS bf16x8*)(Qsm + l * 144 + (16 * ks + 8 * h2) * 2);
    f32x16 acc[2], cr[2];
#pragma unroll
    for (int m2 = 0; m2 < 2; ++m2)
#pragma unroll
        for (int e = 0; e < 16; ++e) { acc[m2][e] = 0.f; cr[m2][e] = 0.f; }
    bf16x8 kf[4];
#pragma unroll
    for (int ks = 0; ks < 4; ++ks) kf[ks] = *(const LAS bf16x8*)(Ksm + r32 * 144 + (16 * ks + 8 * h2) * 2);
    for (int st = 0; st <= lt; ++st) {
        bf16x8 vf[2][2];
#pragma unroll
        for (int s2 = 0; s2 < 2; ++s2) { const int k0 = 32 * st + 16 * s2 + 4 * h2;
#pragma unroll
            for (int m2 = 0; m2 < 2; ++m2) vf[s2][m2] = tr_frag(Vsm, 320, k0, k0 + 8, 32 * (2 * dvh + m2), lane); }
        __builtin_amdgcn_sched_barrier(0);
        f32x16 G;
#pragma unroll
        for (int e = 0; e < 16; ++e) G[e] = 0.f;
#pragma unroll
        for (int ks = 0; ks < 4; ++ks) G = MFMA32(kf[ks], qf[ks], G);
        __builtin_amdgcn_sched_barrier(0);
        { const int sn = st < lt ? st + 1 : st;
#pragma unroll
          for (int ks = 0; ks < 4; ++ks) kf[ks] = *(const LAS bf16x8*)(Ksm + (32 * sn + r32) * 144 + (16 * ks + 8 * h2) * 2); }
        __builtin_amdgcn_sched_barrier(0);
#pragma unroll
        for (int e = 0; e < 16; ++e) { const int s = 32 * st + crow(e, h2); G[e] = (s <= l) ? G[e] * __builtin_amdgcn_exp2f(lg * (float)(l - s)) : 0.f; }
#pragma unroll
        for (int s2 = 0; s2 < 2; ++s2) {
            const bf16x8 bp = pack8(G[8 * s2], G[8 * s2 + 1], G[8 * s2 + 2], G[8 * s2 + 3], G[8 * s2 + 4], G[8 * s2 + 5], G[8 * s2 + 6], G[8 * s2 + 7]);
#pragma unroll
            for (int m2 = 0; m2 < 2; ++m2) acc[m2] = MFMA32(vf[s2][m2], bp, acc[m2]);
        }
    }
#pragma unroll
    for (int m2 = 0; m2 < 2; ++m2)
#pragma unroll
        for (int ks = 0; ks < 4; ++ks) cr[m2] = MFMA32(sfr[m2][ks], qf[ks], cr[m2]);
    const float qd = __builtin_amdgcn_exp2f(lg * (float)(l + 1));
    float ss = 0.f;
#pragma unroll
    for (int m2 = 0; m2 < 2; ++m2)
#pragma unroll
        for (int e = 0; e < 16; ++e) { const float v = acc[m2][e] + qd * cr[m2][e]; acc[m2][e] = v; ss += v * v; }
    ss += lane_xor(ss, 32, lane);
    if (h2 == 0) red[wave * 32 + r32] = ss;
    lds_barrier();
    const float rstd = rsqrtf((red[wave * 32 + r32] + red[(wave ^ 1) * 32 + r32]) * (1.f / 128.f) + EPS);
#pragma unroll
    for (int m2 = 0; m2 < 2; ++m2)
#pragma unroll
        for (int g4 = 0; g4 < 4; ++g4) { u32x2 o; o.x = pk2(acc[m2][4 * g4] * rstd, acc[m2][4 * g4 + 1] * rstd); o.y = pk2(acc[m2][4 * g4 + 2] * rstd, acc[m2][4 * g4 + 3] * rstd);
            *(LAS u32x2*)(Osm + l * 272 + (32 * (2 * dvh + m2) + 8 * g4 + 4 * h2) * 2) = o; }
    { bf16* gbase = pcol(proj, C_RG + h * 128) + t0 * TP;
      u32x4 gvv[4];
#pragma unroll
      for (int it = 0; it < 4; ++it) gvv[it] = *(const u32x4*)(gbase + (size_t)(32 * lt + it * 8 + (lane >> 3)) * TP + 64 * dvh + (lane & 7) * 8);
#pragma unroll
      for (int it = 0; it < 4; ++it) { const int row = 32 * lt + it * 8 + (lane >> 3), dv = 64 * dvh + (lane & 7) * 8;
          bf16* gp = gbase + (size_t)row * TP + dv;
          *(u32x4*)gp = gate8(*(const LAS u32x4*)(Osm + row * 272 + dv * 2), gvv[it]); } }
    PF_DONE;
    lds_barrier();
}

constexpr int SSD_TAB = 0, SSD_ACS = 2048, SSD_SSQ = 4096;
template <int PASS>
DI void ssd_stage(LAS unsigned char* lds, const LayerP& P, int b, int c, int grp, int tid, int xoff, int boff, int bstride, int coff) {
    const int lane = tid & 63, wave = tid >> 6;
    LAS float* dtl = (LAS float*)(lds + SSD_TAB); LAS float* acs = (LAS float*)(lds + SSD_ACS);
    const size_t t0 = (size_t)b * SEQ + (size_t)c * 128;
    const int chunk = lane, seg = wave;
    const int kind = chunk < 32 ? 0 : (chunk < 48 ? 1 : 2);
    const bool active = !(PASS == 1 && kind == 2);
    const int ch0 = kind == 0 ? grp * 256 + chunk * 8 : (kind == 1 ? 512 + grp * 128 + (chunk - 32) * 8 : 768 + grp * 128 + (chunk - 48) * 8);
    u32x4 raw[19];
    { const bf16* gp = pcol(P.proj, C_MX + ch0) + (t0 + 16 * seg) * TP;
      const bool hv = (seg > 0) || (c > 0);
      const u32x4 zz = zero4();
#pragma unroll
      for (int i = 0; i < 19; ++i) { raw[i] = zz; if (active && (i >= 3 || hv)) raw[i] = *(const u32x4*)(gp + ((long)i - 3) * TP); } }
    if (wave < 4) { const int hh = grp * 4 + wave; const float a = -__expf(P.a_log[hh]);
        const float d0 = P.dt[(t0 + 2 * lane) * 8 + hh], d1 = P.dt[(t0 + 2 * lane + 1) * 8 + hh];
        const float s0 = d0 * a, s1 = s0 + d1 * a; float tot = s1;
#pragma unroll
        for (int off = 1; off < 64; off <<= 1) { const float v = lane_up(tot, off, lane); if (lane >= off) tot += v; }
        const float ex = tot - s1;
        acs[wave * 128 + 2 * lane] = ex + s0; acs[wave * 128 + 2 * lane + 1] = ex + s1; dtl[wave * 128 + 2 * lane] = d0; dtl[wave * 128 + 2 * lane + 1] = d1; }
    lds_barrier();
    if (active) {
        float cw[4][8], cb[8];
#pragma unroll
        for (int j = 0; j < 4; ++j) { const f32x4 w0 = *(const f32x4*)(P.conv_w + j * 1024 + ch0), w1 = *(const f32x4*)(P.conv_w + j * 1024 + ch0 + 4);
            cw[j][0] = w0[0]; cw[j][1] = w0[1]; cw[j][2] = w0[2]; cw[j][3] = w0[3]; cw[j][4] = w1[0]; cw[j][5] = w1[1]; cw[j][6] = w1[2]; cw[j][7] = w1[3]; }
        { const f32x4 w0 = *(const f32x4*)(P.conv_b + ch0), w1 = *(const f32x4*)(P.conv_b + ch0 + 4);
            cb[0] = w0[0]; cb[1] = w0[1]; cb[2] = w0[2]; cb[3] = w0[3]; cb[4] = w1[0]; cb[5] = w1[1]; cb[6] = w1[2]; cb[7] = w1[3]; }
        float u3[8], u2[8], u1[8], cur[8];
        unpack8(raw[0], u3); unpack8(raw[1], u2); unpack8(raw[2], u1);
        const int r = chunk >> 3;
        const float aend = acs[(r & 3) * 128 + 127];
#pragma unroll
        for (int i = 0; i < 16; ++i) { const int l = 16 * seg + i;
            unpack8(raw[3 + i], cur);
            float o[8];
#pragma unroll
            for (int e = 0; e < 8; ++e) { const float v = cb[e] + cw[0][e] * u3[e] + cw[1][e] * u2[e] + cw[2][e] * u1[e] + cw[3][e] * cur[e]; o[e] = silu_f(v); u3[e] = u2[e]; u2[e] = u1[e]; u1[e] = cur[e]; }
            if (kind == 0) { float sc = dtl[r * 128 + l]; if (PASS == 1) sc *= __expf(aend - acs[r * 128 + l]);
#pragma unroll
                for (int e = 0; e < 8; ++e) o[e] *= sc; }
            u32x4 w; w.x = pk2(o[0], o[1]); w.y = pk2(o[2], o[3]); w.z = pk2(o[4], o[5]); w.w = pk2(o[6], o[7]);
            if (kind == 0) *(LAS u32x4*)(lds + xoff + l * 576 + chunk * 16) = w;
            else if (kind == 1) *(LAS u32x4*)(lds + boff + l * bstride + (chunk - 32) * 16) = w;
            else *(LAS u32x4*)(lds + coff + l * 272 + (chunk - 48) * 16) = w; }
    }
    lds_barrier();
}

DI void ssdU_unit(LAS unsigned char* lds, const LayerP& P, int b, int c, int grp, int tid, int nxt = -1) {
    asm volatile("" : "+v"(tid));
    const int lane = tid & 63, wave = tid >> 6, r32 = lane & 31, h2 = lane >> 5;
    constexpr int XOFF = 6144, BOFF = 6144 + 128 * 576;
    ssd_stage<1>(lds, P, b, c, grp, tid, XOFF, BOFF, 320, 0);
    PF_DECL; PF_ISSUE(3);
    const int r = wave >> 1, pt = wave & 1, hh = grp * 4 + r;
    f32x16 acc[4];
#pragma unroll
    for (int nt = 0; nt < 4; ++nt)
#pragma unroll
        for (int e = 0; e < 16; ++e) acc[nt][e] = 0.f;
    bf16x8 fx[2], fb[2][4];
    { const int k0 = 8 * h2; fx[0] = tr_frag(lds + XOFF, 576, k0, k0 + 4, r * 64 + 32 * pt, lane);
#pragma unroll
      for (int nt = 0; nt < 4; ++nt) fb[0][nt] = tr_frag(lds + BOFF, 320, k0, k0 + 4, 32 * nt, lane); }
#pragma unroll
    for (int ks = 0; ks < 8; ++ks) {
        if (ks < 7) { const int k1 = 16 * (ks + 1) + 8 * h2; fx[(ks + 1) & 1] = tr_frag(lds + XOFF, 576, k1, k1 + 4, r * 64 + 32 * pt, lane);
#pragma unroll
            for (int nt = 0; nt < 4; ++nt) fb[(ks + 1) & 1][nt] = tr_frag(lds + BOFF, 320, k1, k1 + 4, 32 * nt, lane); }
        __builtin_amdgcn_sched_barrier(0);
#pragma unroll
        for (int nt = 0; nt < 4; ++nt) acc[nt] = MFMA32(fb[ks & 1][nt], fx[ks & 1], acc[nt]);
        __builtin_amdgcn_sched_barrier(0);
    }
    bf16* Sb = P.st_ssd + ((size_t)((b * 32 + c) * 8 + hh)) * 8192;
#pragma unroll
    for (int nt = 0; nt < 4; ++nt)
#pragma unroll
        for (int g4 = 0; g4 < 4; ++g4) { u32x2 o; o.x = pk2(acc[nt][4 * g4], acc[nt][4 * g4 + 1]); o.y = pk2(acc[nt][4 * g4 + 2], acc[nt][4 * g4 + 3]);
            *(u32x2*)(Sb + ((pt * 8 + 2 * nt + (g4 >> 1)) * 64 + (g4 & 1) * 32 + r32) * 8 + 4 * h2) = o; }
    if (tid < 4) P.cd[(b * 32 + c) * 8 + grp * 4 + tid] = __expf(((LAS float*)(lds + SSD_ACS))[tid * 128 + 127]);
    PF_DONE;
    lds_barrier();
}

DI void ssdO_unit(LAS unsigned char* lds, const LayerP& P, int b, int c, int grp, int tid, int nxt = -1) {
    asm volatile("" : "+v"(tid));
    const int lane = tid & 63, wave = tid >> 6, r32 = lane & 31, h2 = lane >> 5;
    constexpr int BOFF = 6144, COFF = 6144 + 34816, XOFF = 6144 + 2 * 34816;
    ssd_stage<2>(lds, P, b, c, grp, tid, XOFF, BOFF, 272, COFF);
    PF_DECL; PF_ISSUE(5);
    LAS float* dtl = (LAS float*)(lds + SSD_TAB); LAS float* acs = (LAS float*)(lds + SSD_ACS); LAS float* ssq = (LAS float*)(lds + SSD_SSQ);
    bf16* proj = P.proj; const size_t t0 = (size_t)b * SEQ + (size_t)c * 128;
    const int r = wave >> 1, lh = wave & 1, hh = grp * 4 + r;
    const bf16* Sb = P.st_ssd + ((size_t)((b * 32 + c) * 8 + hh)) * 8192;
    const float dsk = P.d_skip[hh];
    bf16x8 sf[2][8];
#pragma unroll
    for (int pt = 0; pt < 2; ++pt)
#pragma unroll
        for (int ks = 0; ks < 8; ++ks) sf[pt][ks] = *(const bf16x8*)(Sb + ((pt * 8 + ks) * 64 + lane) * 8);
#pragma nounroll
    for (int li = 0; li < 2; ++li) {
        const int lt = 2 * lh + li, l = 32 * lt + r32;
        bf16x8 cf[8];
#pragma unroll
        for (int ks = 0; ks < 8; ++ks) cf[ks] = *(const LAS bf16x8*)(lds + COFF + l * 272 + (16 * ks + 8 * h2) * 2);
        f32x16 y[2], yo[2];
#pragma unroll
        for (int pt = 0; pt < 2; ++pt)
#pragma unroll
            for (int e = 0; e < 16; ++e) { y[pt][e] = 0.f; yo[pt][e] = 0.f; }
        const float al = acs[r * 128 + l];
        bf16* zrow = pcol(proj, C_MZ + hh * 64) + (t0 + l) * TP;
        u32x4 zr[2][2];
#pragma unroll
        for (int pt = 0; pt < 2; ++pt)
#pragma unroll
            for (int a2 = 0; a2 < 2; ++a2) zr[pt][a2] = *(const u32x4*)(zrow + 32 * pt + 16 * a2 + 8 * h2);
        __builtin_amdgcn_sched_barrier(0);
        for (int st = 0; st <= lt; ++st) {
            bf16x8 bfr[8];
#pragma unroll
            for (int ks = 0; ks < 8; ++ks) bfr[ks] = *(const LAS bf16x8*)(lds + BOFF + (32 * st + r32) * 272 + (16 * ks + 8 * h2) * 2);
            float dcy[16];
#pragma unroll
            for (int e = 0; e < 16; ++e) dcy[e] = acs[r * 128 + 32 * st + crow(e, h2)];
            __builtin_amdgcn_sched_barrier(0);
            f32x16 G;
#pragma unroll
            for (int e = 0; e < 16; ++e) G[e] = 0.f;
#pragma unroll
            for (int ks = 0; ks < 8; ++ks) G = MFMA32(bfr[ks], cf[ks], G);
            __builtin_amdgcn_sched_barrier(0);
            bf16x8 xf[2][2];
#pragma unroll
            for (int s2 = 0; s2 < 2; ++s2) { const int k0 = 32 * st + 16 * s2 + 4 * h2;
#pragma unroll
                for (int pt = 0; pt < 2; ++pt) xf[s2][pt] = tr_frag(lds + XOFF, 576, k0, k0 + 8, r * 64 + 32 * pt, lane); }
            __builtin_amdgcn_sched_barrier(0);
#pragma unroll
            for (int e = 0; e < 16; ++e) { const int s = 32 * st + crow(e, h2); G[e] = (s <= l) ? G[e] * __expf(al - dcy[e]) : 0.f; }
#pragma unroll
            for (int s2 = 0; s2 < 2; ++s2) {
                const bf16x8 bp = pack8(G[8 * s2], G[8 * s2 + 1], G[8 * s2 + 2], G[8 * s2 + 3], G[8 * s2 + 4], G[8 * s2 + 5], G[8 * s2 + 6], G[8 * s2 + 7]);
#pragma unroll
                for (int pt = 0; pt < 2; ++pt) y[pt] = MFMA32(xf[s2][pt], bp, y[pt]);
            }
        }
#pragma unroll
        for (int pt = 0; pt < 2; ++pt)
#pragma unroll
            for (int ks = 0; ks < 8; ++ks) yo[pt] = MFMA32(sf[pt][ks], cf[ks], yo[pt]);
        const float el = __expf(al), dti = __builtin_amdgcn_rcpf(dtl[r * 128 + l]);
        float ss = 0.f;
#pragma unroll
        for (int pt = 0; pt < 2; ++pt)
#pragma unroll
            for (int a2 = 0; a2 < 2; ++a2) {
                f32x4 v0, v1;
#pragma unroll
                for (int j = 0; j < 4; ++j) { v0[j] = y[pt][8 * a2 + j] + el * yo[pt][8 * a2 + j]; v1[j] = y[pt][8 * a2 + 4 + j] + el * yo[pt][8 * a2 + 4 + j]; }
                const bool hi = h2 != 0;
                const f32x4 mine = hi ? v1 : v0, give = hi ? v0 : v1;
                f32x4 got;
#pragma unroll
                for (int j = 0; j < 4; ++j) got[j] = lane_xor(give[j], 32, lane);
                const f32x4 lo4 = hi ? got : mine, hi4 = hi ? mine : got;
                float v8[8];
#pragma unroll
                for (int j = 0; j < 4; ++j) { v8[j] = lo4[j]; v8[4 + j] = hi4[j]; }
                const int p0 = 32 * pt + 16 * a2 + 8 * h2;
                float xs[8], zs[8]; unpack8(*(const LAS u32x4*)(lds + XOFF + l * 576 + (r * 64 + p0) * 2), xs); unpack8(zr[pt][a2], zs);
#pragma unroll
                for (int j = 0; j < 8; ++j) { v8[j] = (v8[j] + xs[j] * dti * dsk) * zs[j]; ss += v8[j] * v8[j]; }
                u32x4 o; o.x = pk2(v8[0], v8[1]); o.y = pk2(v8[2], v8[3]); o.z = pk2(v8[4], v8[5]); o.w = pk2(v8[6], v8[7]);
                *(u32x4*)(zrow + p0) = o;
            }
        ss += lane_xor(ss, 32, lane);
        if (h2 == 0) ssq[r * 128 + l] = ss;
    }
    f32x4 nw[2][2][2];
#pragma unroll
    for (int pt = 0; pt < 2; ++pt)
#pragma unroll
        for (int a2 = 0; a2 < 2; ++a2) { const int p0 = 32 * pt + 16 * a2 + 8 * h2; nw[pt][a2][0] = *(const f32x4*)(P.ssm_norm_w + hh * 64 + p0); nw[pt][a2][1] = *(const f32x4*)(P.ssm_norm_w + hh * 64 + p0 + 4); }
    lds_barrier();
#pragma nounroll
    for (int li = 0; li < 2; ++li) {
        const int l = 32 * (2 * lh + li) + r32;
        const float rstd = rsqrtf((ssq[l] + ssq[128 + l] + ssq[256 + l] + ssq[384 + l]) * (1.f / 256.f) + EPS);
        bf16* orow = pcol(proj, C_MZ + hh * 64) + (t0 + l) * TP;
        u32x4 yr[2][2];
#pragma unroll
        for (int pt = 0; pt < 2; ++pt)
#pragma unroll
            for (int a2 = 0; a2 < 2; ++a2) yr[pt][a2] = *(const u32x4*)(orow + 32 * pt + 16 * a2 + 8 * h2);
        __builtin_amdgcn_sched_barrier(0);
#pragma unroll
        for (int pt = 0; pt < 2; ++pt)
#pragma unroll
            for (int a2 = 0; a2 < 2; ++a2) { const int p0 = 32 * pt + 16 * a2 + 8 * h2; const f32x4 n0 = nw[pt][a2][0], n1 = nw[pt][a2][1];
                const u32x4 yv = yr[pt][a2];
                u32x4 o; o.x = pk2(bflo(yv.x) * rstd * n0[0], bfhi(yv.x) * rstd * n0[1]); o.y = pk2(bflo(yv.y) * rstd * n0[2], bfhi(yv.y) * rstd * n0[3]);
                o.z = pk2(bflo(yv.z) * rstd * n1[0], bfhi(yv.z) * rstd * n1[1]); o.w = pk2(bflo(yv.w) * rstd * n1[2], bfhi(yv.w) * rstd * n1[3]);
                *(u32x4*)(orow + p0) = o; }
    }
    PF_DONE;
    lds_barrier();
}

DI void scan_phase(const LayerP& P, int gid) {
    bf16* base; float dec_const = 0.f; const float* cdp = nullptr; size_t cstride;
    if (gid < 32768) { const int b = gid >> 12, h = (gid >> 10) & 3, e8 = gid & 1023; base = P.st_ret + ((size_t)(b * 32 * 4 + h)) * 8192 + e8 * 8; cstride = 4 * 8192; dec_const = exp2f(128.f * ret_lg(h)); }
    else if (gid < 98304) { const int g2 = gid - 32768, b = g2 >> 13, h = (g2 >> 10) & 7, e8 = g2 & 1023; base = P.st_ssd + ((size_t)(b * 32 * 8 + h)) * 8192 + e8 * 8; cstride = 8 * 8192; cdp = P.cd + b * 32 * 8 + h; }
    else return;
    float s[8]; float zf = 0.f; asm volatile("" : "+v"(zf));
#pragma unroll
    for (int e = 0; e < 8; ++e) s[e] = zf;
#pragma unroll
    for (int c0 = 0; c0 < 32; c0 += 16) {
        u32x4 v[16]; float dc[16];
#pragma unroll
        for (int i = 0; i < 16; ++i) { v[i] = *(const u32x4*)(base + (size_t)(c0 + i) * cstride); dc[i] = cdp ? cdp[(c0 + i) * 8] : dec_const; }
#pragma unroll
        for (int i = 0; i < 16; ++i) { float u[8]; unpack8(v[i], u);
            u32x4 o; o.x = pk2(s[0], s[1]); o.y = pk2(s[2], s[3]); o.z = pk2(s[4], s[5]); o.w = pk2(s[6], s[7]); *(u32x4*)(base + (size_t)(c0 + i) * cstride) = o;
#pragma unroll
            for (int e = 0; e < 8; ++e) s[e] = s[e] * dc[i] + u[e]; }
        __builtin_amdgcn_sched_barrier(0);
    }
}

DI int win_src(int r, float& sc) {
    sc = 1.f;
    if (r < 512) return S_RG + r;
    if (r < 1024) return S_SG + r - 512;
    if (r < 1536) return S_PG + r - 1024;
    if (r < 2048) return S_MZ + r - 1536;
    if (r < 2304) return S_RQ + r - 2048;
    if (r < 2560) { sc = 0.125f; return S_RK + r - 2304; }
    if (r < 3072) return S_RV + r - 2560;
    if (r < 3584) { sc = 0.125f * 1.44269504f; return S_SQ + r - 3072; }
    if (r < 3712) return S_SK + r - 3584;
    if (r < 3840) return S_SV + r - 3712;
    if (r < 4352) return S_PX + r - 3840;
    if (r < 5376) return S_MX + r - 4352;
    const int rho = r - 5376, pn = rho >> 8, bj = (rho >> 7) & 1, wc = (rho >> 5) & 3, n = (rho >> 4) & 1, fq = (rho >> 2) & 3, j = rho & 3;
    return S_MG + (2 * bj + n) * 1024 + 64 * pn + 32 * (wc >> 1) + 8 * fq + 4 * (wc & 1) + j;
}
DI void transpose_item(const float* W, int ldw, int K, bf16* WT, int r0, int k0, int col, float sc, LAS float* scr, int lane, int kd0 = -1) {
    if (kd0 < 0) kd0 = k0;
#pragma unroll 8
    for (int i = 0; i < 32; ++i) { const int kk = 2 * i + (lane >> 5); scr[kk * 33 + (lane & 31)] = W[(size_t)(k0 + kk) * ldw + col] * sc; }
    asm volatile("s_waitcnt lgkmcnt(0)" ::: "memory");
    const int c = lane & 7;
#pragma unroll
    for (int j = 0; j < 4; ++j) { const int n = (lane >> 3) + 8 * j; const LAS float* s = scr + (8 * c) * 33 + n;
        u32x4 o; o.x = pk2(s[0 * 33], s[1 * 33]); o.y = pk2(s[2 * 33], s[3 * 33]); o.z = pk2(s[4 * 33], s[5 * 33]); o.w = pk2(s[6 * 33], s[7 * 33]);
        *(u32x4*)(WT + (size_t)(r0 + n) * K + kd0 + 8 * c) = o; }
    asm volatile("s_waitcnt lgkmcnt(0)" ::: "memory");
}

DI void transpose_item8(const float* W, int ldw, int K, unsigned char* WT8, int r0, int k0, int col, float sc, LAS float* scr, int lane) {
#pragma unroll 8
    for (int i = 0; i < 32; ++i) { const int kk = 2 * i + (lane >> 5); scr[kk * 33 + (lane & 31)] = W[(size_t)(k0 + kk) * ldw + col] * sc; }
    asm volatile("s_waitcnt lgkmcnt(0)" ::: "memory");
    const int c = lane & 7;
#pragma unroll
    for (int j = 0; j < 4; ++j) { const int n = (lane >> 3) + 8 * j; const LAS float* s = scr + (8 * c) * 33 + n;
        u32x2 o; o.x = pk4_i8(s[0 * 33], s[1 * 33], s[2 * 33], s[3 * 33]); o.y = pk4_i8(s[4 * 33], s[5 * 33], s[6 * 33], s[7 * 33]);
        *(u32x2*)(WT8 + (size_t)(r0 + n) * K + k0 + 8 * c) = o; }
    asm volatile("s_waitcnt lgkmcnt(0)" ::: "memory");
}

struct Args {
    const float* in[18]; float* out; unsigned char* ws; int ph_lo, ph_hi;
};

DI void p0_prologue(LAS unsigned char* lds, const Args& a, int tid, int G, int part) {
    const int lane = tid & 63, wave = tid >> 6;
    unsigned char* ws = a.ws;
    if (part == 0)
    for (int it = blockIdx.x; it < 96; it += G) {
        const int l = it / 48, cg = it % 48;
        LAS float* sc = (LAS float*)lds;
        LAS float* red = (LAS float*)(lds + 32768);
        for (int i = tid; i < 8192; i += 512) sc[i] = silu_f(a.in[1][i]);
        __syncthreads();
        float acc[8];
#pragma unroll
        for (int b = 0; b < 8; ++b) acc[b] = 0.f;
        const float* wp = a.in[2] + (size_t)l * 1024 * 3072 + (size_t)(wave * 128) * 3072 + cg * 64 + lane;
#pragma unroll 4
        for (int k = 0; k < 128; ++k) { const float w = wp[(size_t)k * 3072];
#pragma unroll
            for (int b = 0; b < 8; ++b) acc[b] += sc[b * 1024 + wave * 128 + k] * w; }
#pragma unroll
        for (int b = 0; b < 8; ++b) red[(wave * 8 + b) * 64 + lane] = acc[b];
        __syncthreads();
        { const int b = tid >> 6, n = tid & 63; float s = 0.f;
#pragma unroll
            for (int w = 0; w < 8; ++w) s += red[(w * 8 + b) * 64 + n];
            ((float*)(ws + WS_MOD))[(size_t)(l * 8 + b) * 3072 + cg * 64 + n] = s + a.in[3][l * 3072 + cg * 64 + n]; }
        __syncthreads();
    }
    if (part == 0) {
        LAS float* red = (LAS float*)lds;
        for (int cb = blockIdx.x; cb < 256; cb += G) { const int l = cb >> 7, rho0 = (cb & 127) * 32, cc = tid & 31, ks = tid >> 5; float dummy;
            const float* wp = a.in[5] + (size_t)l * 1024 * DIN + (size_t)(ks * 64) * DIN + win_src(5376 + rho0 + cc, dummy);
            float mx = 0.f;
#pragma unroll 8
            for (int k = 0; k < 64; ++k) mx = fmaxf(mx, fabsf(__builtin_nontemporal_load(wp + (size_t)k * DIN)));
            __syncthreads(); red[ks * 32 + cc] = mx; __syncthreads();
            if (tid < 32) { float m2 = 0.f;
#pragma unroll
                for (int q = 0; q < 16; ++q) m2 = fmaxf(m2, red[q * 32 + tid]);
                ((float*)(ws + WS_SW))[l * 4096 + rho0 + tid] = m2 > 0.f ? m2 * (1.f / 127.f) : 1.f; }
        }
        return;
    }
    LAS float* scr = (LAS float*)(lds + wave * 8448);
    const int gw = blockIdx.x * 8 + wave, NGW = G * 8;
    constexpr int I_WIN = (WIN_ROWS / 32) * 16, I_UP = 32 * 8, I_OUT = 32 * 16, I_POOL = 4 * 2;
    constexpr int NITEMS = 2 * I_WIN + 8 * I_UP + 2 * I_OUT + 8 * I_POOL;
    for (int it = gw; it < NITEMS; it += NGW) {
        int r = it;
        if (r < 2 * I_WIN) { const int l = r / I_WIN, q = r % I_WIN, rg = q >> 4, kb = q & 15; float sc; const int col = win_src(rg * 32 + (lane & 31), sc);
            if (rg * 32 >= 5376) { const float isc = 1.f / ((const float*)(ws + WS_SW))[l * 4096 + rg * 32 - 5376 + (lane & 31)];
                transpose_item8(a.in[5] + (size_t)l * 1024 * DIN, DIN, 1024, ws + WS_WMG8 + (size_t)l * 4096 * 1024, rg * 32 - 5376, kb * 64, col, isc, scr, lane); continue; }
            transpose_item(a.in[5] + (size_t)l * 1024 * DIN, DIN, 1024, (bf16*)(ws + WS_WIN) + (size_t)l * WIN_L, rg * 32, kb * 64, col, sc, scr, lane); continue; }
        r -= 2 * I_WIN;
        if (r < 8 * I_UP) { const int li = r / I_UP, q = r % I_UP, rg = q >> 3, kb = q & 7;
            transpose_item(a.in[15] + (size_t)li * 512 * 1024, 1024, 2048, (bf16*)(ws + WS_WUP) + (size_t)(li >> 2) * 1024 * 2048, rg * 32, kb * 64, rg * 32 + (lane & 31), 1.f, scr, lane, (li & 3) * 512 + kb * 64); continue; }
        r -= 8 * I_UP;
        if (r < 2 * I_OUT) { const int l = r / I_OUT, q = r % I_OUT, rg = q >> 4, kb = q & 15;
            transpose_item(a.in[16] + (size_t)l * 1024 * 1024, 1024, 1024, (bf16*)(ws + WS_WOUT) + (size_t)l * 1024 * 1024, rg * 32, kb * 64, rg * 32 + (lane & 31), 1.f, scr, lane); continue; }
        r -= 2 * I_OUT;
        { const int lg = r / I_POOL, q = r % I_POOL, rg = q >> 1, kb = q & 1;
            transpose_item(a.in[7] + (size_t)lg * 128 * 128, 128, 128, (bf16*)(ws + WS_POOL) + (size_t)lg * 128 * 128, rg * 32, kb * 64, rg * 32 + (lane & 31), 1.f, scr, lane); }
    }
}

template <bool IN_BF16>
DI void p1_norm(LAS unsigned char* lds, const Args& a, int layer, const void* xin, int tid, int G) {
    const int lane = tid & 63, wave = tid >> 6;
    LAS float* wdt = (LAS float*)lds;
    const float* win = a.in[5] + (size_t)layer * 1024 * DIN;
    for (int i = tid; i < 8192; i += 512) { const int k = i >> 3, jj = i & 7; wdt[(((k >> 8) * 4 + (k & 3)) * 64 + ((k & 255) >> 2)) * 4 + (jj & 3) + (jj >> 2) * 4096] = win[(size_t)k * DIN + S_DT + jj]; }
    __syncthreads();
    const float* nw = a.in[4] + layer * 1024; const float* mod = (const float*)(a.ws + WS_MOD) + (size_t)layer * 8 * 3072;
    bf16* H = (bf16*)(a.ws + WS_H); float* DT = (float*)(a.ws + WS_DT); const float* dtb = a.in[11] + layer * 8;
    f32x4 w4r[4];
#pragma unroll
    for (int j = 0; j < 4; ++j) w4r[j] = *(const f32x4*)(nw + 256 * j + 4 * lane);
    const int row0_ = blockIdx.x * 8 + wave;
    f32x4 vf[4]; u32x2 vb[4];
#pragma unroll
    for (int j = 0; j < 4; ++j) { if (IN_BF16) vb[j] = __builtin_nontemporal_load((const u32x2*)((const bf16*)xin + (size_t)row0_ * D) + lane + 64 * j); else vf[j] = __builtin_nontemporal_load((const f32x4*)((const float*)xin + (size_t)row0_ * D) + lane + 64 * j); }
    for (int row = row0_; row < T; row += G * 8) {
        const int b = row >> 12;
        f32x4 v[4]; float ss = 0.f;
#pragma unroll
        for (int j = 0; j < 4; ++j) { if (IN_BF16) v[j] = (f32x4){bflo(vb[j].x), bfhi(vb[j].x), bflo(vb[j].y), bfhi(vb[j].y)}; else v[j] = vf[j]; }
        f32x4 sc4r[4], sh4r[4];
#pragma unroll
        for (int j = 0; j < 4; ++j) { const int col = 256 * j + 4 * lane; sc4r[j] = *(const f32x4*)(mod + b * 3072 + 1024 + col); sh4r[j] = *(const f32x4*)(mod + b * 3072 + col); }
        { const int nrow = row + G * 8 < T ? row + G * 8 : row;
#pragma unroll
          for (int j = 0; j < 4; ++j) { if (IN_BF16) vb[j] = __builtin_nontemporal_load((const u32x2*)((const bf16*)xin + (size_t)nrow * D) + lane + 64 * j); else vf[j] = __builtin_nontemporal_load((const f32x4*)((const float*)xin + (size_t)nrow * D) + lane + 64 * j); } }
        __builtin_amdgcn_sched_barrier(0);
#pragma unroll
        for (int j = 0; j < 4; ++j) ss += (v[j][0] * v[j][0] + v[j][1] * v[j][1]) + (v[j][2] * v[j][2] + v[j][3] * v[j][3]);
        const float rstd = rsqrtf(wave_sum(ss, lane) * (1.f / D) + EPS);
        float dacc[8]; f32x4 hq[4];
#pragma unroll
        for (int e = 0; e < 8; ++e) dacc[e] = 0.f;
#pragma unroll
        for (int j = 0; j < 4; ++j) { const int col = 256 * j + 4 * lane;
            const f32x4 w4 = w4r[j], sc4 = sc4r[j], sh4 = sh4r[j];
            const f32x4 hv = v[j] * rstd * w4 * (sc4 + 1.f) + sh4;
            u32x2 o; o.x = pk2(hv[0], hv[1]); o.y = pk2(hv[2], hv[3]);
            *(u32x2*)(H + (size_t)row * D + col) = o;
            hq[j] = hv;
#pragma unroll
            for (int e = 0; e < 4; ++e) { const f32x4 w0 = *(const LAS f32x4*)(wdt + ((j * 4 + e) * 64 + lane) * 4), w1 = *(const LAS f32x4*)(wdt + 4096 + ((j * 4 + e) * 64 + lane) * 4);
                dacc[0] += hv[e] * w0[0]; dacc[1] += hv[e] * w0[1]; dacc[2] += hv[e] * w0[2]; dacc[3] += hv[e] * w0[3];
                dacc[4] += hv[e] * w1[0]; dacc[5] += hv[e] * w1[1]; dacc[6] += hv[e] * w1[2]; dacc[7] += hv[e] * w1[3]; } }
        { float am = 0.f;
#pragma unroll
          for (int j = 0; j < 4; ++j) am = fmaxf(am, fmaxf(fmaxf(fabsf(hq[j][0]), fabsf(hq[j][1])), fmaxf(fabsf(hq[j][2]), fabsf(hq[j][3]))));
#pragma unroll
          for (int o = 1; o < 64; o <<= 1) am = fmaxf(am, lane_xor(am, o, lane));
          const float qs = am > 0.f ? 127.f / am : 0.f;
#pragma unroll
          for (int j = 0; j < 4; ++j) *(unsigned*)((unsigned char*)a.out + (size_t)T * D * 2 + (size_t)row * D + 256 * j + 4 * lane) = pk4_i8(hq[j][0] * qs, hq[j][1] * qs, hq[j][2] * qs, hq[j][3] * qs);
          if (lane == 0) ((float*)(a.ws + WS_SH))[row] = am > 0.f ? am * (1.f / 127.f) : 1.f; }
        float mine = 0.f;
#pragma unroll
        for (int e = 0; e < 8; ++e) { const float s = wave_sum(dacc[e], lane); if (lane == e) mine = s; }
        if (lane < 8) { const float z = mine + dtb[lane]; const float ez = __expf(z); DT[(size_t)row * 8 + lane] = z > 20.f ? z : (ez < 0.01f ? ez * (1.f - ez * (0.5f - ez * 0.33333334f)) : __logf(1.f + ez)); }
    }
    __syncthreads();
}

DI void p7_final(const Args& a, int tid, int G) {
    const int lane = tid & 63, wave = tid >> 6; const float* fw = a.in[17];
    const bf16* x2 = (const bf16*)(a.ws + WS_PROJ);
    f32x4 fwr[4];
#pragma unroll
    for (int j = 0; j < 4; ++j) fwr[j] = *(const f32x4*)(fw + 256 * j + 4 * lane);
    const int row0_ = blockIdx.x * 8 + wave;
    u32x2 vb[4];
#pragma unroll
    for (int j = 0; j < 4; ++j) vb[j] = __builtin_nontemporal_load((const u32x2*)(x2 + (size_t)row0_ * D) + lane + 64 * j);
    for (int row = row0_; row < T; row += G * 8) {
        f32x4 v[4]; float ss = 0.f;
#pragma unroll
        for (int j = 0; j < 4; ++j) v[j] = (f32x4){bflo(vb[j].x), bfhi(vb[j].x), bflo(vb[j].y), bfhi(vb[j].y)};
        { const int nrow = row + G * 8 < T ? row + G * 8 : row;
#pragma unroll
          for (int j = 0; j < 4; ++j) vb[j] = __builtin_nontemporal_load((const u32x2*)(x2 + (size_t)nrow * D) + lane + 64 * j); }
        __builtin_amdgcn_sched_barrier(0);
#pragma unroll
        for (int j = 0; j < 4; ++j) ss += (v[j][0] * v[j][0] + v[j][1] * v[j][1]) + (v[j][2] * v[j][2] + v[j][3] * v[j][3]);
        const float rstd = rsqrtf(wave_sum(ss, lane) * (1.f / D) + EPS);
        f32x4* xr = (f32x4*)(a.out + (size_t)row * D) + lane;
#pragma unroll
        for (int j = 0; j < 4; ++j) __builtin_nontemporal_store(v[j] * rstd * fwr[j], xr + 64 * j);
    }
}


#define XB_TMO      128
#define XB_XCNT(j)  (256  + 64 * (j))
#define XB_XSUB(j)  (1280 + 64 * (j))
#define XB_XGEN(j)  (2304 + 64 * (j))
#define XB_TOP      3328
#define XB_TOPGEN   3392
#define XCD_BAR_WORDS 3456
#define XB_SPIN_CAP (1u << 20)
DI unsigned xb_ld(unsigned* p)              { return __hip_atomic_load(p, __ATOMIC_RELAXED, __HIP_MEMORY_SCOPE_AGENT); }
DI unsigned xb_add(unsigned* p, unsigned v) { return __hip_atomic_fetch_add(p, v, __ATOMIC_RELAXED, __HIP_MEMORY_SCOPE_AGENT); }
DI unsigned xb_xcc_id() { return (unsigned)__builtin_amdgcn_s_getreg((3 << 11) | 20) & 0xFu; }
#define XB_SPIN(cond, bar) do { unsigned _sp = 0; while (cond) { __builtin_amdgcn_s_sleep(1); \
    if ((++_sp & 255u) == 0u) { if (xb_ld(&(bar)[XB_TMO])) break; if (_sp > XB_SPIN_CAP) { atomicAdd(&(bar)[XB_TMO], 1u); break; } } } } while (0)
struct XcdBarrier { unsigned* bar; unsigned x; volatile LAS unsigned* st; };
DI XcdBarrier xcd_barrier_post(unsigned* bar, volatile LAS unsigned* st, bool leader) {
    XcdBarrier b; b.bar = bar; b.x = xb_xcc_id(); b.st = st;
    if (leader) (void)xb_add(&bar[XB_XCNT(b.x)], 1u);
    return b;
}
DI void xcd_barrier_complete(unsigned* bar, unsigned x, unsigned& nloc, unsigned& nx) {
    const unsigned G = gridDim.x * gridDim.y * gridDim.z;
    unsigned sum, cnt, mine, sp = 0u;
    for (;;) {
        sum = 0u; cnt = 0u; mine = 0u;
#pragma unroll
        for (unsigned j = 0; j < 16; ++j) { const unsigned c = xb_ld(&bar[XB_XCNT(j)]); sum += c; cnt += (c > 0u) ? 1u : 0u; mine = (j == x) ? c : mine; }
        if (sum == G) break;
        __builtin_amdgcn_s_sleep(1);
        if ((++sp & 255u) == 0u) { if (xb_ld(&bar[XB_TMO])) break; if (sp > XB_SPIN_CAP) { atomicAdd(&bar[XB_TMO], 1u); break; } }
    }
    nloc = mine > 0u ? mine : 1u; nx = cnt > 0u ? cnt : 1u;
}
DI void xcd_barrier(const XcdBarrier& b, bool leader) {
    asm volatile("s_waitcnt vmcnt(0)" ::: "memory");
    __syncthreads();
    if (leader) {
        unsigned* bar = b.bar;
        __builtin_amdgcn_s_waitcnt(0);
        unsigned nloc = b.st[0], nx = b.st[1];
        if (nloc == 0u) { xcd_barrier_complete(bar, b.x, nloc, nx); b.st[0] = nloc; b.st[1] = nx; }
        const unsigned old = xb_add(&bar[XB_XSUB(b.x)], 1u);
        const unsigned gen = old / nloc;
        if (old + 1u == (gen + 1u) * nloc) {
            __builtin_amdgcn_fence(__ATOMIC_RELEASE, "agent");
            asm volatile("s_waitcnt vmcnt(0)" ::: "memory");
            const unsigned og = xb_add(&bar[XB_TOP], 1u);
            const unsigned tg = og / nx;
            if (og + 1u == (tg + 1u) * nx) xb_add(&bar[XB_TOPGEN], 1u);
            else XB_SPIN(xb_ld(&bar[XB_TOPGEN]) == tg, bar);
            __builtin_amdgcn_fence(__ATOMIC_ACQUIRE, "agent");
            xb_add(&bar[XB_XGEN(b.x)], 1u);
            asm volatile("s_waitcnt vmcnt(0)" ::: "memory");
        } else {
            XB_SPIN(xb_ld(&bar[XB_XGEN(b.x)]) == gen, bar);
            __builtin_amdgcn_fence(__ATOMIC_ACQUIRE, "agent");
            asm volatile("s_waitcnt vmcnt(0)" ::: "memory");
        }
    }
    __syncthreads();
}

#if defined(__HIP_DEVICE_COMPILE__)
#define LOAD_ARGS() ({ const __attribute__((address_space(4))) Args* kp_ = (const __attribute__((address_space(4))) Args*)__builtin_amdgcn_kernarg_segment_ptr(); asm volatile("" : "+s"(kp_)); *kp_; })
#else
#define LOAD_ARGS() (a_unused)
#endif
#define OPQ_TID() ({ int t_ = wave_idx * 64 + (int)__builtin_amdgcn_mbcnt_hi(~0u, __builtin_amdgcn_mbcnt_lo(~0u, 0u)); asm volatile("" : "+v"(t_)); t_; })
__global__ void __launch_bounds__(512, 2) mk_fwd(Args a_unused) {
    extern __shared__ __attribute__((aligned(16))) unsigned char lds_raw[];
    LAS unsigned char* lds = (LAS unsigned char*)lds_raw;
    cg::grid_group grid = cg::this_grid();
#define OPQ_S(x) ({ int s_ = (x); asm volatile("" : "+s"(s_)); s_; })
#ifndef LSEQ
#define LSEQ 0x87654321ull
#endif
    volatile LAS unsigned* xst = (volatile LAS unsigned*)(lds + LDS_BYTES - 512);
    if (threadIdx.x < 2) xst[threadIdx.x] = 0u;
    __syncthreads();
    const int wave_idx = __builtin_amdgcn_readfirstlane((int)(threadIdx.x >> 6));
    { const Args a = LOAD_ARGS(); (void)xcd_barrier_post((unsigned*)(a.ws + WS_CTL), xst, OPQ_TID() == 0); }
#define GRID_BARRIER() do { const Args ab_ = LOAD_ARGS(); XcdBarrier xb_; xb_.bar = (unsigned*)(ab_.ws + WS_CTL); xb_.x = xb_xcc_id(); xb_.st = (volatile LAS unsigned*)(lds + LDS_BYTES - 512); xcd_barrier(xb_, OPQ_TID() == 0); } while (0)
    { const Args a = LOAD_ARGS(); p0_prologue(lds, a, OPQ_TID(), OPQ_S(gridDim.x), 0); }
    grid.sync();
    { const Args a = LOAD_ARGS(); p0_prologue(lds, a, OPQ_TID(), OPQ_S(gridDim.x), 1); }
    { const Args a = LOAD_ARGS(); __syncthreads(); p1_norm<false>(lds, a, 0, a.in[0], OPQ_TID(), OPQ_S(gridDim.x)); }
    GRID_BARRIER();
    for (int layer = 0; layer < 2; ++layer) {
        for (unsigned long long sq = (layer == 0 ? (LSEQ >> 4) : LSEQ); sq != 0ull; sq >>= 4) {
            const int p = (int)(sq & 15ull);
            const Args a = LOAD_ARGS();
            const int G = OPQ_S(gridDim.x), bid = OPQ_S(blockIdx.x);
            unsigned char* ws = a.ws;
            bf16* proj = (bf16*)(ws + WS_PROJ); bf16* H = (bf16*)(ws + WS_H);
            bf16* Rg = proj + 8 * TS;
            const bf16* WinT = (const bf16*)(ws + WS_WIN) + (size_t)layer * WIN_L;
            if (p == 1) { if (layer == 0) p1_norm<false>(lds, a, layer, a.in[0], OPQ_TID(), G); else p1_norm<true>(lds, a, layer, a.out, OPQ_TID(), G); }
            else if (p == 2) { pg8::Gemm<1024, 1024, 1024, T / 256, 21, 31, 0, 512> g{H, WinT};
                pg8::EpiProj E{proj, TP}; pg8::gemm_phase(lds, g, G, bid, E, OPQ_TID()); }
            else if (p >= 3 && p <= 5) {
                LayerP P;
                P.sinks = a.in[6] + layer * 8; P.pool_scale = a.in[8] + layer * 512; P.conv_w = a.in[9] + layer * 4096; P.conv_b = a.in[10] + layer * 1024;
                P.a_log = a.in[12] + layer * 8; P.d_skip = a.in[13] + layer * 8; P.ssm_norm_w = a.in[14] + layer * 512;
                P.poolT = (const bf16*)(ws + WS_POOL) + (size_t)layer * 4 * 128 * 128;
                P.proj = proj; P.dt = (const float*)(ws + WS_DT); P.cd = (float*)(ws + WS_CD); P.st_ret = (bf16*)(ws + WS_EXT + ST_RET); P.st_ssd = (bf16*)(ws + WS_EXT + ST_SSD);
                const int tid = OPQ_TID();
                if (p == 3) {
                    const int nk = (3072 + G - 1) / G, rot = (bid * 5) % nk;
                    for (int k = 0; k < nk; ++k) { const int it = bid + G * ((k + rot) % nk); if (it >= 3072) continue;
                        int nxt = k + 1 < nk ? bid + G * ((k + 1 + rot) % nk) : -1; if (nxt >= 3072) nxt = -1;
                        if (it < 512) swa_unit(lds, P, it >> 6, (it >> 1) & 31, it & 1, tid, nxt);
                        else if (it < 1024) { const int q = it - 512; ssdU_unit(lds, P, q >> 6, (q >> 1) & 31, q & 1, tid, nxt); }
                        else if (it < 2048) { const int q = it - 1024; retU_unit(lds, P, q >> 7, (q >> 2) & 31, q & 3, tid, nxt); }
                        else { const int q = it - 2048; pool_unit(lds, P, q >> 2, q & 3, tid, nxt); }
                    }
                }
                else if (p == 4) scan_phase(P, bid * 512 + tid);
                else {
                    const int nk = (1536 + G - 1) / G, rot = (bid * 5) % nk;
                    for (int k = 0; k < nk; ++k) { const int it = bid + G * ((k + rot) % nk); if (it >= 1536) continue;
                        int nxt = k + 1 < nk ? bid + G * ((k + 1 + rot) % nk) : -1; if (nxt >= 1536) nxt = -1;
                        if (it < 512) ssdO_unit(lds, P, it >> 6, (it >> 1) & 31, it & 1, tid, nxt);
                        else { const int q = it - 512; retO_unit(lds, P, q >> 7, (q >> 2) & 31, q & 3, tid, nxt); }
                    }
                }
            }
            else if (p == 6) { pg8::Gemm<512, 512, 512, T / 256, 16, 31, 0, 512, true> g{(const bf16*)((unsigned char*)a.out + (size_t)T * D * 2), (const bf16*)(ws + WS_WMG8 + (size_t)layer * 4096 * 1024)};
                pg8::EpiGate E{Rg, (const float*)(ws + WS_SH), (const float*)(ws + WS_SW) + layer * 4096}; pg8::gemm_phase(lds, g, G, bid, E, OPQ_TID()); }
            else if (p == 7) { pg8::Gemm<TP, 2048, 2048, T / 256, 4, 31, 0, 2 * (long long)TS> g{proj, (const bf16*)(ws + WS_WUP) + (size_t)layer * 1024 * 2048};
                pg8::EpiMergeUp E{Rg, H}; pg8::gemm_phase(lds, g, G, bid, E, OPQ_TID()); }
            else if (p == 8) { pg8::Gemm<TP, 1024, 1024, T / 256, 4, 31, 0, 2 * (long long)TS> g{H, (const bf16*)(ws + WS_WOUT) + (size_t)layer * 1024 * 1024};
                const float* gate = (const float*)(ws + WS_MOD) + (size_t)layer * 8 * 3072 + 2048;
                if (layer == 0) { pg8::EpiOut<false> E{a.in[0], (bf16*)a.out, gate}; pg8::gemm_phase(lds, g, G, bid, E, OPQ_TID()); }
                else { pg8::EpiOut<true> E{a.out, proj, gate}; pg8::gemm_phase(lds, g, G, bid, E, OPQ_TID()); } }
            GRID_BARRIER();
        }
    }
    { const Args a = LOAD_ARGS(); p7_final(a, OPQ_TID(), OPQ_S(gridDim.x)); }
}
constexpr int N_PHASES = 1 + 2 * 8 + 1;

extern "C" void kernel_launch(void* const* d_in, const int* in_sizes, int n_in, void* d_out, int out_size, void* d_ws, size_t ws_size, hipStream_t stream) {
    static int grid = 0;
    if (grid == 0) {
        if (n_in != 18 || out_size != T * D || ws_size < WS_END) { fprintf(stderr, "kernel_launch: unexpected shapes (n_in %d out %d ws %zu); nothing launched\n", n_in, out_size, ws_size); grid = -1; return; }
        int dev = 0, cus = 0, per_cu = 0;
        if (hipGetDevice(&dev) != hipSuccess || hipDeviceGetAttribute(&cus, hipDeviceAttributeMultiprocessorCount, dev) != hipSuccess) { grid = -1; return; }
        if (hipFuncSetAttribute((const void*)mk_fwd, hipFuncAttributeMaxDynamicSharedMemorySize, LDS_BYTES) != hipSuccess) { fprintf(stderr, "kernel_launch: hipFuncSetAttribute failed\n"); grid = -1; return; }
        if (hipOccupancyMaxActiveBlocksPerMultiprocessor(&per_cu, (const void*)mk_fwd, 512, LDS_BYTES) != hipSuccess || per_cu < 1) { fprintf(stderr, "kernel_launch: occupancy query says %d\n", per_cu); per_cu = 1; }
        (void)hipGetLastError();
        grid = cus;
    }
    if (grid < 0) return;
    if (hipMemsetAsync((char*)d_ws + WS_CTL, 0, CTL_BYTES, stream) != hipSuccess) { fprintf(stderr, "kernel_launch: memset failed\n"); return; }
    Args a{};
    for (int i = 0; i < 18; ++i) a.in[i] = (const float*)d_in[i];
    a.out = (float*)d_out; a.ws = (unsigned char*)d_ws; a.ph_lo = 0; a.ph_hi = N_PHASES;
    void* args[] = {&a};
    hipError_t e = hipLaunchCooperativeKernel((void*)mk_fwd, dim3(grid), dim3(512), args, LDS_BYTES, stream);
    if (e != hipSuccess) fprintf(stderr, "cooperative launch failed: %s (grid %d)\n", hipGetErrorString(e), grid);
}
```

```cpp
#include <hip/hip_runtime.h>
#include <hip/hip_cooperative_groups.h>
#include <cstdio>
#include <cstdint>
namespace cg = cooperative_groups;

#define LAS __attribute__((address_space(3)))
#define DI __device__ __forceinline__
typedef unsigned short bf16;
typedef short bf16x8 __attribute__((ext_vector_type(8)));
typedef short s16x4 __attribute__((ext_vector_type(4)));
typedef short v4i16_t __attribute__((ext_vector_type(4)));
typedef float f32x2 __attribute__((ext_vector_type(2)));
typedef float f32x4 __attribute__((ext_vector_type(4)));
typedef float f32x16 __attribute__((ext_vector_type(16)));
typedef unsigned u32x2 __attribute__((ext_vector_type(2)));
typedef unsigned u32x4 __attribute__((ext_vector_type(4)));
typedef __bf16 bf2_t __attribute__((ext_vector_type(2)));
typedef int v4i_t __attribute__((ext_vector_type(4)));
typedef int v8i_t __attribute__((ext_vector_type(8)));

constexpr int BATCH = 8, SEQ = 4096, T = BATCH * SEQ, D = 1024, DIN = 9480, LDP = 5376;
constexpr float EPS = 1e-6f;
constexpr int TP = 256;
constexpr size_t TS = (size_t)T * 256;
constexpr int C_RG = 0, C_SG = 512, C_PG = 1024, C_MZ = 1536, C_RQ = 2048, C_RK = 2304, C_RV = 2560, C_SQ = 3072, C_SK = 3584, C_SV = 3712, C_PX = 3840, C_MX = 4352;
constexpr int S_RQ = 0, S_RK = 256, S_RV = 512, S_RG = 1024, S_SQ = 1536, S_SK = 2048, S_SV = 2176, S_SG = 2304, S_PX = 2816, S_PG = 3328, S_MX = 3840, S_MZ = 4864, S_DT = 5376, S_MG = 5384;
constexpr int WIN_ROWS = 9472;

constexpr size_t MiB = 1u << 20;
constexpr size_t WS_CTL = 0, CTL_BYTES = 64 * 1024;
constexpr size_t WS_MOD = 1 * MiB;
constexpr size_t WS_DT = 2 * MiB;
constexpr size_t WS_CD = 3 * MiB;
constexpr size_t WS_WIN = 4 * MiB;
constexpr size_t WIN_L = (size_t)WIN_ROWS * 1024;
constexpr size_t WS_WUP = 41 * MiB;
constexpr size_t WS_WOUT = 49 * MiB;
constexpr size_t WS_POOL = 53 * MiB;
constexpr size_t WS_H = 54 * MiB;
constexpr size_t WS_PROJ = 118 * MiB;
constexpr size_t WS_EXT = 454 * MiB;
constexpr size_t WS_WMG8 = 502 * MiB;
constexpr size_t WS_SW = 510 * MiB;
constexpr size_t WS_SH = 510 * MiB + 65536;
constexpr size_t WS_END = 511 * MiB;
constexpr size_t ST_RET = 0, ST_SSD = 16 * MiB;

constexpr int LDS_BYTES = 163840;

DI unsigned pk2(float lo, float hi) { f32x2 v = {lo, hi}; bf2_t b = __builtin_convertvector(v, bf2_t); return __builtin_bit_cast(unsigned, b); }
DI float bflo(unsigned u) { return __uint_as_float(u << 16); }
DI float bfhi(unsigned u) { return __uint_as_float(u & 0xffff0000u); }
DI float bf2f(bf16 v) { return __uint_as_float(((unsigned)v) << 16); }
DI unsigned pk4_i8(float a, float b, float c, float d) {
    const int ia = (int)rintf(fminf(fmaxf(a, -127.f), 127.f)), ib = (int)rintf(fminf(fmaxf(b, -127.f), 127.f)), ic = (int)rintf(fminf(fmaxf(c, -127.f), 127.f)), id = (int)rintf(fminf(fmaxf(d, -127.f), 127.f));
    return (unsigned)(ia & 255) | ((unsigned)(ib & 255) << 8) | ((unsigned)(ic & 255) << 16) | ((unsigned)id << 24);
}
DI float silu_f(float x) { return x * __builtin_amdgcn_rcpf(1.f + __expf(-x)); }
DI float sigm_f(float x) { return __builtin_amdgcn_rcpf(1.f + __expf(-x)); }
DI float lane_xor(float v, int o, int lane) { return __int_as_float(__builtin_amdgcn_ds_bpermute((lane ^ o) << 2, __float_as_int(v))); }
DI float lane_up(float v, int o, int lane) { const int src = lane >= o ? lane - o : lane; return __int_as_float(__builtin_amdgcn_ds_bpermute(src << 2, __float_as_int(v))); }
DI float wave_sum(float v, int lane) {
#pragma unroll
    for (int o = 1; o < 64; o <<= 1) v += lane_xor(v, o, lane);
    return v;
}
DI bf16* pcol(bf16* proj, int c) { return proj + (size_t)(c >> 8) * TS + (c & 255); }
DI const bf16* pcol(const bf16* proj, int c) { return proj + (size_t)(c >> 8) * TS + (c & 255); }
DI int crow(int r, int h) { return (r & 3) + 8 * (r >> 2) + 4 * h; }
#define MFMA32(a, b, c) __builtin_amdgcn_mfma_f32_32x32x16_bf16((a), (b), (c), 0, 0, 0)
DI bf16x8 pack8(float a0, float a1, float a2, float a3, float a4, float a5, float a6, float a7) {
    u32x4 p; p.x = pk2(a0, a1); p.y = pk2(a2, a3); p.z = pk2(a4, a5); p.w = pk2(a6, a7); return __builtin_bit_cast(bf16x8, p);
}
DI u32x4 zero4() { unsigned z = 0u; asm volatile("" : "+v"(z)); return (u32x4){z, z, z, z}; }
DI s16x4 trr(const LAS unsigned char* p) { return __builtin_bit_cast(s16x4, __builtin_amdgcn_ds_read_tr16_b64_v4i16((LAS v4i16_t*)p)); }
DI bf16x8 tr_frag(const LAS unsigned char* img, int stride, int klo, int khi, int col0, int lane) {
    const int i16 = lane & 15, q = i16 >> 2, p = i16 & 3, blk = (lane >> 4) & 1;
    const LAS unsigned char* a = img + q * stride + (col0 + 16 * blk + 4 * p) * 2;
    const s16x4 lo = trr(a + klo * stride), hi = trr(a + khi * stride);
    return (bf16x8){lo[0], lo[1], lo[2], lo[3], hi[0], hi[1], hi[2], hi[3]};
}
DI u32x4 gate8(u32x4 ov, u32x4 gv) {
    u32x4 r;
    r.x = pk2(bflo(ov.x) * bflo(gv.x), bfhi(ov.x) * bfhi(gv.x)); r.y = pk2(bflo(ov.y) * bflo(gv.y), bfhi(ov.y) * bfhi(gv.y));
    r.z = pk2(bflo(ov.z) * bflo(gv.z), bfhi(ov.z) * bfhi(gv.z)); r.w = pk2(bflo(ov.w) * bflo(gv.w), bfhi(ov.w) * bfhi(gv.w));
    return r;
}
DI void unpack8(u32x4 w, float* f) { f[0] = bflo(w.x); f[1] = bfhi(w.x); f[2] = bflo(w.y); f[3] = bfhi(w.y); f[4] = bflo(w.z); f[5] = bfhi(w.z); f[6] = bflo(w.w); f[7] = bfhi(w.w); }

namespace pg8 {
constexpr int BM = 256, BK = 64, HALF = 128, HTB = HALF * BK * 2, STAGE_BYTES = 8 * HTB, NXCD = 8, WGM = 8;
__host__ __device__ __forceinline__ int lds_byte(int r, int c) { const int st = (r >> 4) * 2 + (c >> 5), rr = r & 15, cc = c & 31, ob = rr * 64 + cc * 2; return st * 1024 + (ob ^ (((ob >> 9) & 1) << 5)); }
__host__ __device__ __forceinline__ void stage_rc(int b, int& R, int& C) { const int st = b / 1024, sb = b % 1024, swz = sb ^ (((sb >> 9) & 1) << 5); R = (st >> 1) * 16 + swz / 64; C = (st & 1) * 32 + (swz % 64) / 2; }
__host__ __device__ __forceinline__ int perm32(int rho) { const int n = rho >> 4, i = rho & 15; return 8 * (i >> 2) + 4 * n + (i & 3); }

struct Unit { int pm, pn; };
template <int LDA_, int LDB_, int K_, int NM_, int NN_, int ASH_, long long AGS_, long long AKTS_, bool FP8_ = false> struct Gemm { const bf16* A; const bf16* Bt; static constexpr bool fp8 = FP8_; static constexpr int lda = LDA_, ldb = LDB_, K = K_, nM = NM_, nN = NN_, a_shift = ASH_; static constexpr long long a_gstride = AGS_, a_kts = AKTS_; };

template <int nM, int nN> struct StaticOrder {
    static constexpr int nwg = nM * nN; int G, c, L0, L1;
    __device__ void init(int G_, int c_, int L0_, int L1_) { G = G_; c = c_; L0 = L0_; L1 = L1_ < 0 ? nwg : L1_; }
    __device__ bool next(int i, Unit& u) const {
        const long L = (long)i * G + c + L0; if (L >= L1) return false;
        int wgid = (int)L; { const int q = nwg / NXCD, r = nwg % NXCD, xcd = wgid % NXCD, off = wgid / NXCD; wgid = (xcd < r ? xcd * (q + 1) : r * (q + 1) + (xcd - r) * q) + off; }
        const int nig = WGM * nN, gid = wgid / nig, fm = gid * WGM, gsz = (nM - fm) < WGM ? (nM - fm) : WGM;
        u.pm = fm + ((wgid % nig) % gsz); u.pn = (wgid % nig) / gsz; return true;
    }
};

template <class GemmT, class Epi>
__device__ __forceinline__ void gemm_phase(LAS unsigned char* lds, const GemmT g, int G_, int c_, const Epi& E, const int tid, int L0_ = 0, int L1_ = -1) {
    StaticOrder<GemmT::nM, GemmT::nN> S; S.init(G_, c_, L0_, L1_);
    const int wid = __builtin_amdgcn_readfirstlane(tid >> 6), lane = tid & 63, wr = wid >> 2, wc = wid & 3, fr = lane & 15, fq = lane >> 4;
    constexpr int nt = GemmT::K / BK;
    unsigned voffA[2], voffB[2];
#pragma unroll
    for (int i = 0; i < 2; ++i) { int R, C; stage_rc(tid * 16 + i * 8192, R, C); const int Rb = Epi::PERM ? ((R & ~31) + perm32(R & 31)) : R;
        voffA[i] = (unsigned)(R * g.lda + C) * 2u; voffB[i] = (unsigned)(Rb * g.ldb + C) * 2u; }
    const size_t kstep = (size_t)(BK * 2);
    const size_t hstepA = (size_t)HALF * g.lda * 2, hstepB = (size_t)HALF * g.ldb * 2;
    const unsigned ldsw = (unsigned)wid * 1024u;
    const int aoff = lds_byte(wr * 64 + fr, fq * 8), boff = lds_byte(wc * 32 + fr, fq * 8);
#define PG8_SA(b, h) (((b) * 2 + (h)) * HTB)
#define PG8_SB(b, h) ((4 + (b) * 2 + (h)) * HTB)
#define PG8_STAGE(bufoff, gbase, voff) do { _Pragma("unroll") for (int _i = 0; _i < 2; ++_i) \
        __builtin_amdgcn_global_load_lds((const unsigned*)((const char*)(gbase) + (voff)[_i]), (LAS unsigned*)(lds + (bufoff) + ldsw + _i * 8192), 16, 0, 0); } while (0)
#define PG8_LDA(dst, b, h) do { _Pragma("unroll") for (int m = 0; m < 4; ++m) _Pragma("unroll") for (int k = 0; k < 2; ++k) dst[m][k] = *(const LAS bf16x8*)(lds + PG8_SA(b, h) + aoff + m * 2048 + k * 1024); } while (0)
#define PG8_LDB(dst, b, h) do { _Pragma("unroll") for (int n = 0; n < 2; ++n) _Pragma("unroll") for (int k = 0; k < 2; ++k) dst[n][k] = *(const LAS bf16x8*)(lds + PG8_SB(b, h) + boff + n * 2048 + k * 1024); } while (0)
#define PG8_CAT8(x0, x1) __builtin_shufflevector(__builtin_bit_cast(v4i_t, (x0)), __builtin_bit_cast(v4i_t, (x1)), 0, 1, 2, 3, 4, 5, 6, 7)
#define PG8_MMA(ai, bj, At, Bt) do { __builtin_amdgcn_s_setprio(1); _Pragma("unroll") for (int m = 0; m < 4; ++m) _Pragma("unroll") for (int n = 0; n < 2; ++n) { \
        if constexpr (GemmT::fp8) { _Pragma("unroll") for (int k = 0; k < 2; ++k) acc[ai][bj][m][n] = __builtin_bit_cast(f32x4, __builtin_amdgcn_mfma_i32_16x16x64_i8(__builtin_bit_cast(v4i_t, Bt[n][k]), __builtin_bit_cast(v4i_t, At[m][k]), __builtin_bit_cast(v4i_t, acc[ai][bj][m][n]), 0, 0, 0)); } \
        else { _Pragma("unroll") for (int k = 0; k < 2; ++k) acc[ai][bj][m][n] = __builtin_amdgcn_mfma_f32_16x16x32_bf16(Bt[n][k], At[m][k], acc[ai][bj][m][n], 0, 0, 0); } } \
        __builtin_amdgcn_s_setprio(0); } while (0)
#define PG8_WAIT_V(n) asm volatile("s_waitcnt vmcnt(" #n ")" ::: "memory")
#define PG8_WAIT_L(n) asm volatile("s_waitcnt lgkmcnt(" #n ")" ::: "memory")
#define PG8_BAR __builtin_amdgcn_s_barrier()
#define PG8_SCHED __builtin_amdgcn_sched_barrier(0)
#define PG8_APTR(u) ((const char*)g.A + 2 * ((size_t)(u).pm * 256 * g.lda + (size_t)((u).pn >> g.a_shift) * g.a_gstride))
#define PG8_BPTR(u) ((const char*)g.Bt + 2 * ((size_t)(u).pn * 256 * g.ldb))
    Unit cur, nxt; int ui = 0;
    if (!S.next(0, cur)) return;
    f32x4 acc[2][2][4][2];
#pragma unroll
    for (int a = 0; a < 2; ++a)
#pragma unroll
        for (int b = 0; b < 2; ++b)
#pragma unroll
            for (int m = 0; m < 4; ++m)
#pragma unroll
                for (int n = 0; n < 2; ++n) acc[a][b][m][n] = (f32x4){0.f, 0.f, 0.f, 0.f};
    bf16x8 At[4][2], B0[2][2], B1[2][2];
    unsigned pf0 = 0u, pf1 = 0u;
    const char* cA = PG8_APTR(cur); const char* cB = PG8_BPTR(cur);
    PG8_STAGE(PG8_SB(0, 0), cB, voffB); PG8_STAGE(PG8_SB(0, 1), cB + hstepB, voffB); PG8_STAGE(PG8_SA(0, 0), cA, voffA); PG8_STAGE(PG8_SA(0, 1), cA + hstepA, voffA);
    if (wr == 1) PG8_BAR;
    PG8_WAIT_V(2); PG8_BAR;
    PG8_STAGE(PG8_SB(1, 0), cB + kstep, voffB); PG8_STAGE(PG8_SA(1, 0), cA + kstep, voffA); PG8_STAGE(PG8_SB(1, 1), cB + hstepB + kstep, voffB);
    PG8_WAIT_V(6); PG8_BAR;
    for (;;) {
        const bool has_next = S.next(ui + 1, nxt);
        const char* nA = has_next ? PG8_APTR(nxt) : cA; const char* nB = has_next ? PG8_BPTR(nxt) : cB;
        constexpr int tseg = Epi::HOOK ? 8 : nt;
#pragma nounroll
        for (int t0 = 0; t0 < nt; t0 += tseg) {
        if constexpr (Epi::HOOK) { if (t0 != 0) { E.hook(acc, cur, (t0 >> 3) - 1, wr, wc, lane); asm volatile("" :: "v"(pf0), "v"(pf1)); } }
#pragma nounroll
        for (int t = t0; t < t0 + tseg; t += 2) {
            const bool last = (t == nt - 2);
            const char* a1 = cA + (size_t)(t >> 2) * GemmT::a_kts + (size_t)((t & 3) + 1) * kstep;
            const char* a2 = last ? nA : cA + (size_t)((t + 2) >> 2) * GemmT::a_kts + (size_t)((t + 2) & 3) * kstep; const char* b2 = last ? nB : cB + (size_t)(t + 2) * kstep;
            const char* a3 = a2 + kstep; const char* b3 = b2 + kstep;
            PG8_LDB(B0, 0, 0); PG8_LDB(B1, 0, 1); PG8_SCHED; PG8_LDA(At, 0, 0); PG8_STAGE(PG8_SA(1, 1), a1 + hstepA, voffA);
            PG8_WAIT_V(8); PG8_WAIT_L(0); PG8_BAR; PG8_MMA(0, 0, At, B0); PG8_MMA(0, 1, At, B1); PG8_BAR; PG8_SCHED;
            PG8_LDA(At, 0, 1); PG8_STAGE(PG8_SB(0, 0), b2, voffB); PG8_STAGE(PG8_SB(0, 1), b2 + hstepB, voffB); PG8_STAGE(PG8_SA(0, 0), a2, voffA);
            PG8_WAIT_V(8); PG8_WAIT_L(0); PG8_BAR; PG8_MMA(1, 0, At, B0); PG8_MMA(1, 1, At, B1); PG8_BAR; PG8_SCHED;
            PG8_LDB(B0, 1, 0); PG8_LDB(B1, 1, 1); PG8_SCHED; PG8_LDA(At, 1, 0); PG8_STAGE(PG8_SA(0, 1), a2 + hstepA, voffA);
            PG8_WAIT_V(8); PG8_WAIT_L(0); PG8_BAR; PG8_MMA(0, 0, At, B0); PG8_MMA(0, 1, At, B1); PG8_BAR; PG8_SCHED;
            PG8_LDA(At, 1, 1); PG8_STAGE(PG8_SB(1, 0), b3, voffB); PG8_STAGE(PG8_SB(1, 1), b3 + hstepB, voffB); PG8_STAGE(PG8_SA(1, 0), a3, voffA);
            PG8_WAIT_V(8); PG8_WAIT_L(0); PG8_BAR; PG8_MMA(1, 0, At, B0); PG8_MMA(1, 1, At, B1); PG8_BAR; PG8_SCHED;
        }
        }
        if (wr == 0) PG8_BAR;
        { int le = lane; asm volatile("" : "+v"(le)); E(acc, cur, wr, wc, le & 15, le >> 4); if constexpr (Epi::HOOK) asm volatile("" :: "v"(pf0), "v"(pf1)); }
        if (!has_next) break;
#pragma unroll
        for (int a = 0; a < 2; ++a)
#pragma unroll
            for (int b = 0; b < 2; ++b)
#pragma unroll
                for (int m = 0; m < 4; ++m)
#pragma unroll
                    for (int n = 0; n < 2; ++n) acc[a][b][m][n] = (f32x4){0.f, 0.f, 0.f, 0.f};
        cur = nxt; cA = nA; cB = nB; ++ui;
        if (wr == 1) PG8_BAR;
    }
    PG8_WAIT_V(0);
    PG8_BAR;
#undef PG8_SA
#undef PG8_SB
#undef PG8_STAGE
#undef PG8_LDA
#undef PG8_LDB
#undef PG8_MMA
#undef PG8_CAT8
#undef PG8_WAIT_V
#undef PG8_WAIT_L
#undef PG8_BAR
#undef PG8_SCHED
#undef PG8_APTR
#undef PG8_BPTR
}

struct EpiProj {
    static constexpr bool PERM = true, HOOK = false;
    DI void hook(f32x4 (&)[2][2][4][2], const Unit&, int, int, int, int) const {}
    DI void prefetch(const Unit&, int, int, int, int, unsigned&, unsigned&) const {}
    bf16* O; int ldc; int pn0;
    DI void operator()(const f32x4 (&acc)[2][2][4][2], const Unit& u, int wr, int wc, int fr, int fq) const {
        const int row0 = u.pm * BM + wr * 64 + fr, col0 = wc * 32 + 8 * fq, pnn = u.pn + pn0;
        bf16* Ot = O + (size_t)pnn * TS;
#pragma unroll
        for (int ai = 0; ai < 2; ++ai)
#pragma unroll
            for (int m = 0; m < 4; ++m) { bf16* rowp = Ot + (size_t)(row0 + ai * HALF + m * 16) * ldc + col0;
#pragma unroll
                for (int bj = 0; bj < 2; ++bj) { f32x4 v0 = acc[ai][bj][m][0], v1 = acc[ai][bj][m][1];
                    if (pnn < 8) {
#pragma unroll
                        for (int j = 0; j < 4; ++j) { v0[j] = silu_f(v0[j]); v1[j] = silu_f(v1[j]); } }
                    u32x4 w; w.x = pk2(v0[0], v0[1]); w.y = pk2(v0[2], v0[3]); w.z = pk2(v1[0], v1[1]); w.w = pk2(v1[2], v1[3]);
                    __builtin_nontemporal_store(w, (u32x4*)(rowp + bj * HALF)); } }
    }
};
struct EpiProjI8 {
    static constexpr bool PERM = true, HOOK = false;
    DI void hook(f32x4 (&)[2][2][4][2], const Unit&, int, int, int, int) const {}
    DI void prefetch(const Unit&, int, int, int, int, unsigned&, unsigned&) const {}
    bf16* O; const float* sH; const float* sW;
    DI void operator()(const f32x4 (&acc)[2][2][4][2], const Unit& u, int wr, int wc, int fr, int fq) const {
        const int row0 = u.pm * BM + wr * 64 + fr, col0 = wc * 32 + 8 * fq;
        bf16* Ot = O + (size_t)u.pn * TS;
        f32x4 cs[2][2]; float rsv[2][4];
#pragma unroll
        for (int bj = 0; bj < 2; ++bj)
#pragma unroll
            for (int n = 0; n < 2; ++n) cs[bj][n] = *(const f32x4*)(sW + u.pn * BM + bj * HALF + col0 + 4 * n);
#pragma unroll
        for (int ai = 0; ai < 2; ++ai)
#pragma unroll
            for (int m = 0; m < 4; ++m) rsv[ai][m] = sH[row0 + ai * HALF + m * 16];
#pragma unroll
        for (int ai = 0; ai < 2; ++ai)
#pragma unroll
            for (int m = 0; m < 4; ++m) { bf16* rowp = Ot + (size_t)(row0 + ai * HALF + m * 16) * TP + col0; const float rs = rsv[ai][m];
#pragma unroll
                for (int bj = 0; bj < 2; ++bj) { f32x4 v0, v1;
#pragma unroll
                    for (int j = 0; j < 4; ++j) { v0[j] = silu_f((float)__float_as_int(acc[ai][bj][m][0][j]) * rs * cs[bj][0][j]); v1[j] = silu_f((float)__float_as_int(acc[ai][bj][m][1][j]) * rs * cs[bj][1][j]); }
                    u32x4 w; w.x = pk2(v0[0], v0[1]); w.y = pk2(v0[2], v0[3]); w.z = pk2(v1[0], v1[1]); w.w = pk2(v1[2], v1[3]);
                    __builtin_nontemporal_store(w, (u32x4*)(rowp + bj * HALF)); } }
    }
};
DI size_t r_off(int k, int pm, int dq, int ai, int bj, int mp, int n, int wr, int wc, int lane) {
    return (((((((((((size_t)k * 128 + pm) * 4 + dq) * 2 + ai) * 2 + bj) * 2 + mp) * 2 + n) * 2 + wr) * 4 + wc) * 64 + lane) * 8);
}
struct EpiGate {
    static constexpr bool PERM = false, HOOK = false;
    bf16* R; const float* sH; const float* sW;
    DI void operator()(const f32x4 (&acc)[2][2][4][2], const Unit& u, int wr, int wcp, int fr, int fq) const {
        const int lane = fq * 16 + fr, dq = u.pn >> 2, bj = (u.pn >> 1) & 1, wc = 2 * (u.pn & 1) + (wcp >> 1), n = wcp & 1;
        f32x4 cs[4];
#pragma unroll
        for (int i = 0; i < 4; ++i) cs[i] = *(const f32x4*)(sW + u.pn * BM + (i >> 1) * HALF + wcp * 32 + (i & 1) * 16 + 4 * fq);
        float rsv[2][4];
#pragma unroll
        for (int ai = 0; ai < 2; ++ai)
#pragma unroll
            for (int m = 0; m < 4; ++m) rsv[ai][m] = sH[u.pm * BM + ai * HALF + wr * 64 + m * 16 + fr];
#pragma unroll
        for (int ai = 0; ai < 2; ++ai)
#pragma unroll
            for (int mp = 0; mp < 2; ++mp) {
                u32x2 wv[2][4];
#pragma unroll
                for (int mh = 0; mh < 2; ++mh) { const int m = 2 * mp + mh;
                    const float rs = rsv[ai][m];
                    float e[4][4];
#pragma unroll
                    for (int i = 0; i < 4; ++i)
#pragma unroll
                        for (int j = 0; j < 4; ++j) { const float gq = (float)__float_as_int(acc[ai][i >> 1][m][i & 1][j]) * rs * cs[i][j]; e[i][j] = 1.f + __expf(-fminf(fmaxf(gq, -30.f), 30.f)); }
#pragma unroll
                    for (int k = 0; k < 4; ++k) { float r[4];
#pragma unroll
                        for (int j = 0; j < 4; ++j) r[j] = k < 3 ? e[k + 1][j] * __builtin_amdgcn_rcpf(e[k][j]) : __builtin_amdgcn_rcpf(e[3][j]);
                        wv[mh][k].x = pk2(r[0], r[1]); wv[mh][k].y = pk2(r[2], r[3]); } }
#pragma unroll
                for (int k = 0; k < 4; ++k) { const u32x4 w = (u32x4){wv[0][k].x, wv[0][k].y, wv[1][k].x, wv[1][k].y};
                    __builtin_nontemporal_store(w, (u32x4*)(R + r_off(k, u.pm, dq, ai, bj, mp, n, wr, wc, lane))); }
            }
    }
    DI void hook(f32x4 (&)[2][2][4][2], const Unit&, int, int, int, int) const {}
    DI void prefetch(const Unit&, int, int, int, int, unsigned&, unsigned&) const {}
};
struct EpiMergeUp {
    static constexpr bool PERM = true, HOOK = true;
    const bf16* R; bf16* O;
    DI void scale(f32x4 (&acc)[2][2][4][2], const Unit& u, int k, int wr, int wc, int lane) const {
        asm volatile("" : "+v"(lane));
        const bf16* base = R + r_off(k, u.pm, u.pn, 0, 0, 0, 0, wr, wc, lane);
#pragma unroll
        for (int ai = 0; ai < 2; ++ai) {
            u32x4 v[2][4];
#pragma unroll
            for (int bj = 0; bj < 2; ++bj)
#pragma unroll
                for (int q = 0; q < 4; ++q) v[bj][q] = __builtin_nontemporal_load((const u32x4*)(base + (size_t)((ai * 2 + bj) * 4 + q) * 4096));
            __builtin_amdgcn_sched_barrier(0);
#pragma unroll
            for (int bj = 0; bj < 2; ++bj)
#pragma unroll
                for (int q = 0; q < 4; ++q) { const u32x4 w = v[bj][q]; const int mp = q >> 1, n = q & 1;
                    acc[ai][bj][2 * mp][n] *= (f32x4){bflo(w.x), bfhi(w.x), bflo(w.y), bfhi(w.y)}; acc[ai][bj][2 * mp + 1][n] *= (f32x4){bflo(w.z), bfhi(w.z), bflo(w.w), bfhi(w.w)}; }
            __builtin_amdgcn_sched_barrier(0);
        }
    }
    DI void hook(f32x4 (&acc)[2][2][4][2], const Unit& u, int k, int wr, int wc, int lane) const { scale(acc, u, k, wr, wc, lane); }
    DI void prefetch(const Unit& u, int k, int wr, int wc, int lane, unsigned& p0, unsigned& p1) const {
        asm volatile("" : "+v"(lane));
        const char* b = (const char*)(R + r_off(k, u.pm, u.pn, 0, 0, 0, 0, wr, wc, 0)) + (lane >> 3) * 8192 + (lane & 7) * 128;
        p0 = *(const unsigned*)b; p1 = *(const unsigned*)(b + 8 * 8192);
    }
    DI void operator()(f32x4 (&acc)[2][2][4][2], const Unit& u, int wr, int wc, int fr, int fq) const {
        scale(acc, u, 3, wr, wc, fq * 16 + fr);
        const int row0 = u.pm * BM + wr * 64 + fr, col0 = wc * 32 + 8 * fq;
        bf16* Ot = O + (size_t)u.pn * TS;
#pragma unroll
        for (int ai = 0; ai < 2; ++ai)
#pragma unroll
            for (int m = 0; m < 4; ++m) { bf16* rowp = Ot + (size_t)(row0 + ai * HALF + m * 16) * TP + col0;
#pragma unroll
                for (int bj = 0; bj < 2; ++bj) { const f32x4 v0 = acc[ai][bj][m][0], v1 = acc[ai][bj][m][1];
                    u32x4 w; w.x = pk2(v0[0], v0[1]); w.y = pk2(v0[2], v0[3]); w.z = pk2(v1[0], v1[1]); w.w = pk2(v1[2], v1[3]);
                    *(u32x4*)(rowp + bj * HALF) = w; } }
    }
};
template <bool IN_BF16> struct EpiOut {
    static constexpr bool PERM = true, HOOK = false;
    DI void hook(f32x4 (&)[2][2][4][2], const Unit&, int, int, int, int) const {}
    DI void prefetch(const Unit&, int, int, int, int, unsigned&, unsigned&) const {}
    const void* xin; bf16* xout; const float* gate;
    DI void operator()(const f32x4 (&acc)[2][2][4][2], const Unit& u, int wr, int wc, int fr, int fq) const {
        const int row0 = u.pm * BM + wr * 64 + fr, col0 = u.pn * BM + wc * 32 + 8 * fq;
        const float* gp = gate + (size_t)(u.pm >> 4) * 3072 + col0;
        f32x4 gv[2][2];
#pragma unroll
        for (int bj = 0; bj < 2; ++bj)
#pragma unroll
            for (int n = 0; n < 2; ++n) gv[bj][n] = *(const f32x4*)(gp + bj * HALF + n * 4);
        if constexpr (IN_BF16) {
            u32x4 xb[2][4][2];
#pragma unroll
            for (int ai = 0; ai < 2; ++ai)
#pragma unroll
                for (int m = 0; m < 4; ++m)
#pragma unroll
                    for (int bj = 0; bj < 2; ++bj) xb[ai][m][bj] = *(const u32x4*)((const bf16*)xin + (size_t)(row0 + ai * HALF + m * 16) * D + col0 + bj * HALF);
#pragma unroll
            for (int ai = 0; ai < 2; ++ai)
#pragma unroll
                for (int m = 0; m < 4; ++m) { const size_t off = (size_t)(row0 + ai * HALF + m * 16) * D + col0;
#pragma unroll
                    for (int bj = 0; bj < 2; ++bj) { const u32x4 w = xb[ai][m][bj];
                        f32x4 x0 = (f32x4){bflo(w.x), bfhi(w.x), bflo(w.y), bfhi(w.y)}, x1 = (f32x4){bflo(w.z), bfhi(w.z), bflo(w.w), bfhi(w.w)};
                        x0 += gv[bj][0] * acc[ai][bj][m][0]; x1 += gv[bj][1] * acc[ai][bj][m][1];
                        u32x4 o; o.x = pk2(x0[0], x0[1]); o.y = pk2(x0[2], x0[3]); o.z = pk2(x1[0], x1[1]); o.w = pk2(x1[2], x1[3]);
                        *(u32x4*)(xout + off + bj * HALF) = o; } }
        } else {
#pragma unroll
            for (int ai = 0; ai < 2; ++ai) {
                f32x4 xf[4][2][2];
#pragma unroll
                for (int m = 0; m < 4; ++m) { const size_t off = (size_t)(row0 + ai * HALF + m * 16) * D + col0;
#pragma unroll
                    for (int bj = 0; bj < 2; ++bj) { xf[m][bj][0] = *(const f32x4*)((const float*)xin + off + bj * HALF); xf[m][bj][1] = *(const f32x4*)((const float*)xin + off + bj * HALF + 4); } }
#pragma unroll
                for (int m = 0; m < 4; ++m) { const size_t off = (size_t)(row0 + ai * HALF + m * 16) * D + col0;
#pragma unroll
                    for (int bj = 0; bj < 2; ++bj) { f32x4 x0 = xf[m][bj][0], x1 = xf[m][bj][1];
                        x0 += gv[bj][0] * acc[ai][bj][m][0]; x1 += gv[bj][1] * acc[ai][bj][m][1];
                        u32x4 o; o.x = pk2(x0[0], x0[1]); o.y = pk2(x0[2], x0[3]); o.z = pk2(x1[0], x1[1]); o.w = pk2(x1[2], x1[3]);
                        *(u32x4*)(xout + off + bj * HALF) = o; } }
            }
        }
    }
};
}

DI void lds_barrier() { asm volatile("s_waitcnt lgkmcnt(0)" ::: "memory"); __builtin_amdgcn_s_barrier(); asm volatile("" ::: "memory"); }
struct LayerP {
    const float *sinks, *pool_scale, *conv_w, *conv_b, *a_log, *d_skip, *ssm_norm_w;
    const bf16* poolT;
    bf16* proj; const float* dt; float* cd; bf16* st_ret; bf16* st_ssd;
};


DI void pf_item(const LayerP& P, int phase, int it, int tid, unsigned& p0, unsigned& p1, unsigned& p2) {
    if (it < 0) return;
    const bf16* proj = P.proj;
    if (phase == 3) {
        if (it < 512) { const int b = it >> 6, nb = (it >> 1) & 31, hkv = it & 1; const size_t t0 = (size_t)b * SEQ + (size_t)nb * 128;
            const int key = tid >> 1; const size_t krow = (nb > 0 || key >= 128) ? t0 + key - 128 : t0;
            p0 = *(const unsigned*)(pcol(proj, ((tid & 1) ? C_SV : C_SK) + hkv * 64) + krow * TP);
            p1 = *(const unsigned*)(pcol(proj, C_SQ + hkv * 256 + (tid & 3) * 64) + (t0 + (tid >> 2)) * TP);
            p2 = *(const unsigned*)(pcol(proj, C_SG + hkv * 256 + (tid & 3) * 64) + (t0 + (tid >> 2)) * TP);
        } else if (it < 1024) { const int q = it - 512, b = q >> 6, c = (q >> 1) & 31, grp = q & 1; const size_t t0 = (size_t)b * SEQ + (size_t)c * 128;
            p0 = *(const unsigned*)(pcol(proj, C_MX + grp * 256 + (tid & 3) * 64) + (t0 + (tid >> 2)) * TP);
            p1 = *(const unsigned*)(pcol(proj, C_MX + 512 + grp * 128 + (tid & 1) * 64) + (t0 + ((tid & 255) >> 1)) * TP);
        } else if (it < 2048) { const int q = it - 1024, b = q >> 7, c = (q >> 2) & 31, h = q & 3; const size_t t0 = (size_t)b * SEQ + (size_t)c * 128;
            p0 = *(const unsigned*)(pcol(proj, C_RV + h * 128 + (tid & 1) * 64) + (t0 + ((tid & 255) >> 1)) * TP);
            p1 = *(const unsigned*)(pcol(proj, C_RK + h * 64) + (t0 + (tid & 127)) * TP);
        } else { const int q = it - 2048, tile = q >> 2, g = q & 3; const size_t t0 = (size_t)tile * 128;
            p0 = *(const unsigned*)(pcol(proj, ((tid & 256) ? C_PG : C_PX) + g * 128 + (tid & 1) * 64) + (t0 + ((tid & 255) >> 1)) * TP);
        }
    } else {
        if (it < 512) { const int b = it >> 6, c = (it >> 1) & 31, grp = it & 1; const size_t t0 = (size_t)b * SEQ + (size_t)c * 128;
            p0 = *(const unsigned*)(pcol(proj, C_MX + grp * 256 + (tid & 3) * 64) + (t0 + (tid >> 2)) * TP);
            p1 = *(const unsigned*)(pcol(proj, C_MX + ((tid & 256) ? 768 : 512) + grp * 128 + (tid & 1) * 64) + (t0 + ((tid & 255) >> 1)) * TP);
            p2 = *(const unsigned*)(pcol(proj, C_MZ + grp * 256 + (tid & 3) * 64) + (t0 + (tid >> 2)) * TP);
        } else { const int q = it - 512, b = q >> 7, c = (q >> 2) & 31, h = q & 3; const size_t t0 = (size_t)b * SEQ + (size_t)c * 128;
            p0 = (tid < 256) ? *(const unsigned*)(pcol(proj, ((tid & 128) ? C_RQ : C_RK) + h * 64) + (t0 + (tid & 127)) * TP)
                             : *(const unsigned*)(pcol(proj, C_RV + h * 128 + (tid & 1) * 64) + (t0 + ((tid & 255) >> 1)) * TP);
            p1 = *(const unsigned*)(pcol(proj, C_RG + h * 128 + (tid & 1) * 64) + (t0 + ((tid & 255) >> 1)) * TP);
            p2 = *(const unsigned*)(P.st_ret + ((size_t)((b * 32 + c) * 4 + h)) * 8192 + (tid & 127) * 64);
        }
    }
}
#define PF_DECL unsigned pf0_ = 0u, pf1_ = 0u, pf2_ = 0u
#define PF_ISSUE(phase) pf_item(P, (phase), nxt, tid, pf0_, pf1_, pf2_)
#define PF_DONE asm volatile("" :: "v"(pf0_), "v"(pf1_), "v"(pf2_))

DI void swa_unit(LAS unsigned char* lds, const LayerP& P, int b, int nb, int hkv, int tid, int nxt = -1) {
    asm volatile("" : "+v"(tid));
    const int lane = tid & 63, wave = tid >> 6, r32 = lane & 31, h2 = lane >> 5;
    LAS unsigned char* Ksm = lds;
    LAS unsigned char* Vsm = lds + 256 * 144;
    bf16* proj = P.proj;
    const size_t t0 = (size_t)b * SEQ + (size_t)nb * 128;
    LAS unsigned char* QO = lds + 256 * 144 + 256 * 192;
    {
      u32x4 kr[4], vr[4], qr[8];
      const bf16* qsrc = pcol(proj, C_SQ + hkv * 256) + t0 * TP;
#pragma unroll
      for (int i = 0; i < 4; ++i) { const int p = tid + 512 * i, key = p >> 3, ch = p & 7;
          kr[i] = zero4(); vr[i] = kr[i];
          if (nb > 0 || key >= 128) { const size_t ro = (t0 + key - 128) * TP + ch * 8; kr[i] = __builtin_nontemporal_load((const u32x4*)(pcol(proj, C_SK + hkv * 64) + ro)); vr[i] = __builtin_nontemporal_load((const u32x4*)(pcol(proj, C_SV + hkv * 64) + ro)); } }
#pragma unroll
      for (int i = 0; i < 8; ++i) { const int p = tid + 512 * i, row = p >> 5, c32 = p & 31; qr[i] = *(const u32x4*)(qsrc + (size_t)row * TP + c32 * 8); }
      __builtin_amdgcn_sched_barrier(0);
#pragma unroll
      for (int i = 0; i < 4; ++i) { const int p = tid + 512 * i, key = p >> 3, ch = p & 7;
          *(LAS u32x4*)(Ksm + key * 144 + ch * 16) = kr[i]; *(LAS u32x4*)(Vsm + key * 192 + ch * 16) = vr[i]; }
#pragma unroll
      for (int i = 0; i < 8; ++i) { const int p = tid + 512 * i, row = p >> 5, c32 = p & 31;
          *(LAS u32x4*)(QO + ((c32 >> 3) * 128 + row) * 144 + (c32 & 7) * 16) = qr[i]; } }
    lds_barrier();
    PF_DECL;
    const int gi = wave >> 1, hq = hkv * 4 + gi;
    const float slope2 = __builtin_amdgcn_exp2f(-(float)(hq + 1)) * 1.44269504f, sink2 = P.sinks[hq] * 1.44269504f;
#pragma nounroll
    for (int sub = 0; sub < 2; ++sub) {
        const int r0 = (wave & 1) * 64 + sub * 32, r = r0 + r32, kt0 = r0 >> 5;
        LAS unsigned char* qo_row = QO + (gi * 128 + r) * 144;
        bf16x8 qf[4];
#pragma unroll
        for (int ks = 0; ks < 4; ++ks) qf[ks] = *(const LAS bf16x8*)(qo_row + (16 * ks + 8 * h2) * 2);
        f32x16 st[5];
        const int dbase = 128 + r32 - 4 * h2;
        const int lo = dbase - (nb > 0 ? 127 : min(127, r));
        const float sd = slope2 * (float)dbase, sinkr = sink2 + sd, ninf = -__builtin_inff();
#define SWA_BIAS(i_) { _Pragma("unroll") for (int e = 0; e < 16; ++e) { const int c = 32 * (i_) + (e & 3) + 8 * (e >> 2); float sv = fmaf(slope2, (float)c, st[i_][e]); \
            if ((i_) == 0) sv = (c >= lo) ? sv : ninf;         \
            if ((i_) == 4) sv = (c <= dbase) ? sv : ninf; st[i_][e] = sv; } }
        bf16x8 ka[2][4];
#pragma unroll
        for (int ks = 0; ks < 4; ++ks) ka[0][ks] = *(const LAS bf16x8*)(Ksm + (32 * kt0 + r32) * 144 + (16 * ks + 8 * h2) * 2);
#pragma unroll
        for (int i = 0; i < 5; ++i) {
            if (i < 4) {
#pragma unroll
                for (int ks = 0; ks < 4; ++ks) ka[(i + 1) & 1][ks] = *(const LAS bf16x8*)(Ksm + (32 * (kt0 + i + 1) + r32) * 144 + (16 * ks + 8 * h2) * 2); }
            __builtin_amdgcn_sched_barrier(0);
#pragma unroll
            for (int e = 0; e < 16; ++e) st[i][e] = 0.f;
#pragma unroll
            for (int ks = 0; ks < 4; ++ks) st[i] = MFMA32(ka[i & 1][ks], qf[ks], st[i]);
            __builtin_amdgcn_sched_barrier(0);
            if (i == 1) SWA_BIAS(0) else if (i == 2) SWA_BIAS(1) else if (i == 3) SWA_BIAS(2) else if (i == 4) SWA_BIAS(3)
            __builtin_amdgcn_sched_barrier(0);
        }
        SWA_BIAS(4)
        if (nb == 0) {
#pragma unroll
            for (int i = 1; i < 4; ++i)
#pragma unroll
                for (int e = 0; e < 16; ++e) { const int c = 32 * i + (e & 3) + 8 * (e >> 2); st[i][e] = (c >= lo) ? st[i][e] : ninf; }
        }
        float m = sinkr;
#pragma unroll
        for (int i = 0; i < 5; ++i)
#pragma unroll
            for (int e = 0; e < 16; ++e) m = fmaxf(m, st[i][e]);
        { float mt = m - sd; mt = fmaxf(mt, lane_xor(mt, 32, lane)); m = mt + sd; }
        float sum = 0.f;
        f32x16 o[2];
#pragma unroll
        for (int mt = 0; mt < 2; ++mt)
#pragma unroll
            for (int e = 0; e < 16; ++e) o[mt][e] = 0.f;
        bf16x8 va[2][2];
#pragma unroll
        for (int mt = 0; mt < 2; ++mt) { const int k0 = 32 * kt0 + 4 * h2; va[0][mt] = tr_frag(Vsm, 192, k0, k0 + 8, 32 * mt, lane); }
#pragma unroll
        for (int stp = 0; stp < 10; ++stp) { const int i = stp >> 1, s2 = stp & 1;
            if (stp < 9) { const int k1 = 32 * kt0 + 16 * (stp + 1) + 4 * h2;
#pragma unroll
                for (int mt = 0; mt < 2; ++mt) va[(stp + 1) & 1][mt] = tr_frag(Vsm, 192, k1, k1 + 8, 32 * mt, lane); }
            float pv[8];
#pragma unroll
            for (int e = 0; e < 8; ++e) { pv[e] = __builtin_amdgcn_exp2f(st[i][8 * s2 + e] - m); sum += pv[e]; }
            const bf16x8 bp = pack8(pv[0], pv[1], pv[2], pv[3], pv[4], pv[5], pv[6], pv[7]);
            __builtin_amdgcn_sched_barrier(0);
#pragma unroll
            for (int mt = 0; mt < 2; ++mt) o[mt] = MFMA32(va[stp & 1][mt], bp, o[mt]);
            __builtin_amdgcn_sched_barrier(0);
        }
        sum += lane_xor(sum, 32, lane);
        const float inv = __builtin_amdgcn_rcpf(sum + __builtin_amdgcn_exp2f(sinkr - m));
#pragma unroll
        for (int mt = 0; mt < 2; ++mt)
#pragma unroll
            for (int g4 = 0; g4 < 4; ++g4) { u32x2 w; w.x = pk2(o[mt][4 * g4] * inv, o[mt][4 * g4 + 1] * inv); w.y = pk2(o[mt][4 * g4 + 2] * inv, o[mt][4 * g4 + 3] * inv);
                *(LAS u32x2*)(qo_row + (32 * mt + 8 * g4 + 4 * h2) * 2) = w; }
    }
    PF_ISSUE(3);
    { bf16* gbase = pcol(proj, C_SG + hq * 64) + t0 * TP + (size_t)((wave & 1) * 64 + (lane >> 3)) * TP + (lane & 7) * 8;
      u32x4 gv[8];
#pragma unroll
      for (int it = 0; it < 8; ++it) gv[it] = *(const u32x4*)(gbase + (size_t)(it * 8) * TP);
#pragma unroll
      for (int it = 0; it < 8; ++it) { const int row = (wave & 1) * 64 + it * 8 + (lane >> 3), c8 = lane & 7;
          *(u32x4*)(gbase + (size_t)(it * 8) * TP) = gate8(*(const LAS u32x4*)(QO + (gi * 128 + row) * 144 + c8 * 16), gv[it]); } }
    PF_DONE;
    lds_barrier();
}

DI void pool_unit(LAS unsigned char* lds, const LayerP& P, int tile, int g, int tid, int nxt = -1) {
    asm volatile("" : "+v"(tid));
    const int lane = tid & 63, wave = tid >> 6, r32 = lane & 31, h2 = lane >> 5;
    LAS unsigned char* Usm = lds;
    LAS unsigned char* Ysm = lds + 46080;
    LAS unsigned char* Wsm = lds + 46080 + 34816;
    bf16* proj = P.proj;
    const size_t t0 = (size_t)tile * 128; const int seq0 = (int)(t0 & (SEQ - 1)), w = 2 << g;
    {
      u32x4 ur[5], wr4[4];
#pragma unroll
      for (int i = 0; i < 5; ++i) { const int p = tid + 512 * i, row = p >> 4, ch = p & 15, l = row - 15;
          ur[i] = zero4();
          if (row < 143 && (l >= 0 || seq0 > 0)) ur[i] = __builtin_nontemporal_load((const u32x4*)(pcol(proj, C_PX + g * 128) + (size_t)((long)t0 + l) * TP + ch * 8)); }
#pragma unroll
      for (int i = 0; i < 4; ++i) { const int p = tid + 512 * i, e = p >> 4, ch = p & 15; wr4[i] = *(const u32x4*)(P.poolT + (size_t)(g * 128 + e) * 128 + ch * 8); }
      __builtin_amdgcn_sched_barrier(0);
#pragma unroll
      for (int i = 0; i < 5; ++i) { const int p = tid + 512 * i, row = p >> 4, ch = p & 15;
          if (row < 144) *(LAS u32x4*)(Usm + row * 320 + ch * 16) = ur[i]; }
#pragma unroll
      for (int i = 0; i < 4; ++i) { const int p = tid + 512 * i, e = p >> 4, ch = p & 15; const u32x4 wv = wr4[i];
          *(LAS u32x2*)(Wsm + e * 264 + ch * 16) = (u32x2){wv.x, wv.y}; *(LAS u32x2*)(Wsm + e * 264 + ch * 16 + 8) = (u32x2){wv.z, wv.w}; } }
    lds_barrier();
    PF_DECL;
    const int tt = wave >> 1, et0 = 2 * (wave & 1);
    bf16x8 mf[3];
    { const int cnt = min(seq0 + 32 * tt + r32 + 1, w); const float ic = 1.f / (float)cnt;
#pragma unroll
      for (int ks = 0; ks < 3; ++ks) { float mv[8];
#pragma unroll
          for (int i = 0; i < 8; ++i) { const int dd = 16 * ks + 8 * h2 + i - 15 - r32; mv[i] = ((dd > -w && dd <= 0) ? ic : 0.f) - (dd == 0 ? 1.f : 0.f); }
          mf[ks] = pack8(mv[0], mv[1], mv[2], mv[3], mv[4], mv[5], mv[6], mv[7]); } }
    f32x16 acc[2];
#pragma unroll
    for (int et = 0; et < 2; ++et)
#pragma unroll
        for (int e = 0; e < 16; ++e) acc[et][e] = 0.f;
    bf16x8 uf[2][3];
#pragma unroll
    for (int ks = 0; ks < 3; ++ks) { const int k0 = 32 * tt + 16 * ks + 8 * h2; uf[0][ks] = tr_frag(Usm, 320, k0, k0 + 4, 0, lane); }
#pragma unroll
    for (int ct = 0; ct < 4; ++ct) {
        bf16x8 wf[2][2];
#pragma unroll
        for (int s2 = 0; s2 < 2; ++s2)
#pragma unroll
            for (int et = 0; et < 2; ++et) { const LAS unsigned char* wp = Wsm + (32 * (et0 + et) + r32) * 264 + (32 * ct + 16 * s2 + 4 * h2) * 2;
                const u32x2 lo = *(const LAS u32x2*)wp, hi = *(const LAS u32x2*)(wp + 16);
                wf[s2][et] = __builtin_bit_cast(bf16x8, (u32x4){lo.x, lo.y, hi.x, hi.y}); }
        if (ct < 3) {
#pragma unroll
            for (int ks = 0; ks < 3; ++ks) { const int k0 = 32 * tt + 16 * ks + 8 * h2; uf[(ct + 1) & 1][ks] = tr_frag(Usm, 320, k0, k0 + 4, 32 * (ct + 1), lane); } }
        __builtin_amdgcn_sched_barrier(0);
        f32x16 Dm;
#pragma unroll
        for (int e = 0; e < 16; ++e) Dm[e] = 0.f;
#pragma unroll
        for (int ks = 0; ks < 3; ++ks) Dm = MFMA32(uf[ct & 1][ks], mf[ks], Dm);
#pragma unroll
        for (int s2 = 0; s2 < 2; ++s2) {
            const bf16x8 bp = pack8(Dm[8 * s2], Dm[8 * s2 + 1], Dm[8 * s2 + 2], Dm[8 * s2 + 3], Dm[8 * s2 + 4], Dm[8 * s2 + 5], Dm[8 * s2 + 6], Dm[8 * s2 + 7]);
#pragma unroll
            for (int et = 0; et < 2; ++et) acc[et] = MFMA32(wf[s2][et], bp, acc[et]);
        }
        __builtin_amdgcn_sched_barrier(0);
    }
    PF_ISSUE(3);
#pragma unroll
    for (int et = 0; et < 2; ++et)
#pragma unroll
        for (int g4 = 0; g4 < 4; ++g4) { u32x2 o; o.x = pk2(acc[et][4 * g4], acc[et][4 * g4 + 1]); o.y = pk2(acc[et][4 * g4 + 2], acc[et][4 * g4 + 3]);
            *(LAS u32x2*)(Ysm + (32 * tt + r32) * 272 + (32 * (et0 + et) + 8 * g4 + 4 * h2) * 2) = o; }
    { bf16* gbase = pcol(proj, C_PG + g * 128) + t0 * TP;
      u32x4 gvv[4];
#pragma unroll
      for (int it = 0; it < 4; ++it) gvv[it] = *(const u32x4*)(gbase + (size_t)(32 * tt + it * 8 + (lane >> 3)) * TP + 64 * (wave & 1) + (lane & 7) * 8);
      const f32x4 s0 = *(const f32x4*)(P.pool_scale + g * 128 + 64 * (wave & 1) + (lane & 7) * 8), s1 = *(const f32x4*)(P.pool_scale + g * 128 + 64 * (wave & 1) + (lane & 7) * 8 + 4);
      __builtin_amdgcn_sched_barrier(0);
#pragma unroll
      for (int it = 0; it < 4; ++it) { const int row = 32 * tt + it * 8 + (lane >> 3), ch = 64 * (wave & 1) + (lane & 7) * 8;
          bf16* gp = gbase + (size_t)row * TP + ch; const u32x4 yv = *(const LAS u32x4*)(Ysm + row * 272 + ch * 2), gv = gvv[it];
          u32x4 o; o.x = pk2(bflo(yv.x) * s0[0] * bflo(gv.x), bfhi(yv.x) * s0[1] * bfhi(gv.x)); o.y = pk2(bflo(yv.y) * s0[2] * bflo(gv.y), bfhi(yv.y) * s0[3] * bfhi(gv.y));
          o.z = pk2(bflo(yv.z) * s1[0] * bflo(gv.z), bfhi(yv.z) * s1[1] * bfhi(gv.z)); o.w = pk2(bflo(yv.w) * s1[2] * bflo(gv.w), bfhi(yv.w) * s1[3] * bfhi(gv.w));
          *(u32x4*)gp = o; } }
    PF_DONE;
    lds_barrier();
}

DI float ret_lg(int h) { return log2f(1.f - exp2f(-5.f - (float)h)); }
DI void retU_unit(LAS unsigned char* lds, const LayerP& P, int b, int c, int h, int tid, int nxt = -1) {
    asm volatile("" : "+v"(tid));
    const int lane = tid & 63, wave = tid >> 6, r32 = lane & 31, h2 = lane >> 5;
    LAS unsigned char* Ksm = lds;
    LAS unsigned char* Vsm = lds + 128 * 192;
    const bf16* proj = P.proj; const size_t t0 = (size_t)b * SEQ + (size_t)c * 128; const float lg = ret_lg(h);
    u32x4 kr[2], vr[4];
#pragma unroll
    for (int i = 0; i < 2; ++i) { const int p = tid + 512 * i, s = p >> 3, ch = p & 7; kr[i] = __builtin_nontemporal_load((const u32x4*)(pcol(proj, C_RK + h * 64) + (t0 + s) * TP + ch * 8)); }
#pragma unroll
    for (int i = 0; i < 4; ++i) { const int p = tid + 512 * i, s = p >> 4, ch = p & 15; vr[i] = __builtin_nontemporal_load((const u32x4*)(pcol(proj, C_RV + h * 128) + (t0 + s) * TP + ch * 8)); }
    __builtin_amdgcn_sched_barrier(0);
#pragma unroll
    for (int i = 0; i < 2; ++i) { const int p = tid + 512 * i, s = p >> 3, ch = p & 7; float f[8];
        unpack8(kr[i], f); const float dk = __builtin_amdgcn_exp2f(lg * (float)(127 - s));
        u32x4 o; o.x = pk2(f[0] * dk, f[1] * dk); o.y = pk2(f[2] * dk, f[3] * dk); o.z = pk2(f[4] * dk, f[5] * dk); o.w = pk2(f[6] * dk, f[7] * dk);
        *(LAS u32x4*)(Ksm + s * 192 + ch * 16) = o; }
#pragma unroll
    for (int i = 0; i < 4; ++i) { const int p = tid + 512 * i, s = p >> 4, ch = p & 15;
        *(LAS u32x4*)(Vsm + s * 320 + ch * 16) = vr[i]; }
    lds_barrier();
    PF_DECL; PF_ISSUE(3);
    const int mt = wave >> 2, nt = wave & 3;
    f32x16 acc;
#pragma unroll
    for (int e = 0; e < 16; ++e) acc[e] = 0.f;
    bf16x8 fa[8], fbb[8];
#pragma unroll
    for (int ks = 0; ks < 8; ++ks) { const int k0 = 16 * ks + 8 * h2; fa[ks] = tr_frag(Ksm, 192, k0, k0 + 4, 32 * mt, lane); fbb[ks] = tr_frag(Vsm, 320, k0, k0 + 4, 32 * nt, lane); }
    __builtin_amdgcn_sched_barrier(0);
#pragma unroll
    for (int ks = 0; ks < 8; ++ks) acc = MFMA32(fa[ks], fbb[ks], acc);
    bf16* St = P.st_ret + ((size_t)((b * 32 + c) * 4 + h)) * 8192;
#pragma unroll
    for (int g4 = 0; g4 < 4; ++g4) { u32x2 o; o.x = pk2(acc[4 * g4], acc[4 * g4 + 1]); o.y = pk2(acc[4 * g4 + 2], acc[4 * g4 + 3]);
        *(u32x2*)(St + ((nt * 4 + 2 * mt + (g4 >> 1)) * 64 + (g4 & 1) * 32 + r32) * 8 + 4 * h2) = o; }
    PF_DONE;
    lds_barrier();
}

DI void retO_unit(LAS unsigned char* lds, const LayerP& P, int b, int c, int h, int tid, int nxt = -1) {
    asm volatile("" : "+v"(tid));
    const int lane = tid & 63, wave = tid >> 6, r32 = lane & 31, h2 = lane >> 5;
    LAS unsigned char* Ksm = lds;
    LAS unsigned char* Vsm = lds + 128 * 144;
    LAS unsigned char* Qsm = lds + 128 * 144 + 128 * 320;
    LAS unsigned char* Osm = Qsm + 128 * 144;
    LAS float* red = (LAS float*)(Osm + 128 * 272);
    bf16* proj = P.proj; const size_t t0 = (size_t)b * SEQ + (size_t)c * 128; const float lg = ret_lg(h);
    const int lt = wave < 4 ? (wave >> 1) : 3 - ((wave - 4) >> 1), dvh = wave & 1, l = 32 * lt + r32;
    u32x4 kr[2], qr[2], vr[4]; bf16x8 sfr[2][4];
#pragma unroll
    for (int i = 0; i < 2; ++i) { const int p = tid + 512 * i, s = p >> 3, ch = p & 7;
        kr[i] = __builtin_nontemporal_load((const u32x4*)(pcol(proj, C_RK + h * 64) + (t0 + s) * TP + ch * 8));
        qr[i] = __builtin_nontemporal_load((const u32x4*)(pcol(proj, C_RQ + h * 64) + (t0 + s) * TP + ch * 8)); }
#pragma unroll
    for (int i = 0; i < 4; ++i) { const int p = tid + 512 * i, s = p >> 4, ch = p & 15;
        vr[i] = __builtin_nontemporal_load((const u32x4*)(pcol(proj, C_RV + h * 128) + (t0 + s) * TP + ch * 8)); }
    { const bf16* St = P.st_ret + ((size_t)((b * 32 + c) * 4 + h)) * 8192;
#pragma unroll
      for (int m2 = 0; m2 < 2; ++m2)
#pragma unroll
          for (int ks = 0; ks < 4; ++ks) sfr[m2][ks] = *(const bf16x8*)(St + (((2 * dvh + m2) * 4 + ks) * 64 + lane) * 8); }
    __builtin_amdgcn_sched_barrier(0);
#pragma unroll
    for (int i = 0; i < 2; ++i) { const int p = tid + 512 * i, s = p >> 3, ch = p & 7;
        *(LAS u32x4*)(Ksm + s * 144 + ch * 16) = kr[i]; *(LAS u32x4*)(Qsm + s * 144 + ch * 16) = qr[i]; }
#pragma unroll
    for (int i = 0; i < 4; ++i) { const int p = tid + 512 * i, s = p >> 4, ch = p & 15;
        *(LAS u32x4*)(Vsm + s * 320 + ch * 16) = vr[i]; }
    lds_barrier();
    PF_DECL;
    bf16x8 qf[4];
#pragma unroll
    for (int ks = 0; ks < 4; ++ks) qf[ks] = *(const LAS bf16x8*)(Qsm + l * 144 + (16 * ks + 8 * h2) * 2);
    f32x16 acc[2], cr[2];
#pragma unroll
    for (int m2 = 0; m2 < 2; ++m2)
#pragma unroll
        for (int e = 0; e < 16; ++e) { acc[m2][e] = 0.f; cr[m2][e] = 0.f; }
    bf16x8 kf[4];
#pragma unroll
    for (int ks = 0; ks < 4; ++ks) kf[ks] = *(const LAS bf16x8*)(Ksm + r32 * 144 + (16 * ks + 8 * h2) * 2);
    for (int st = 0; st <= lt; ++st) {
        bf16x8 vf[2][2];
#pragma unroll
        for (int s2 = 0; s2 < 2; ++s2) { const int k0 = 32 * st + 16 * s2 + 4 * h2;
#pragma unroll
            for (int m2 = 0; m2 < 2; ++m2) vf[s2][m2] = tr_frag(Vsm, 320, k0, k0 + 8, 32 * (2 * dvh + m2), lane); }
        __builtin_amdgcn_sched_barrier(0);
        f32x16 G;
#pragma unroll
        for (int e = 0; e < 16; ++e) G[e] = 0.f;
#pragma unroll
        for (int ks = 0; ks < 4; ++ks) G = MFMA32(kf[ks], qf[ks], G);
        __builtin_amdgcn_sched_barrier(0);
        { const int sn = st < lt ? st + 1 : st;
#pragma unroll
          for (int ks = 0; ks < 4; ++ks) kf[ks] = *(const LAS bf16x8*)(Ksm + (32 * sn + r32) * 144 + (16 * ks + 8 * h2) * 2); }
        __builtin_amdgcn_sched_barrier(0);
#pragma unroll
        for (int e = 0; e < 16; ++e) { const int s = 32 * st + crow(e, h2); G[e] = (s <= l) ? G[e] * __builtin_amdgcn_exp2f(lg * (float)(l - s)) : 0.f; }
#pragma unroll
        for (int s2 = 0; s2 < 2; ++s2) {
            const bf16x8 bp = pack8(G[8 * s2], G[8 * s2 + 1], G[8 * s2 + 2], G[8 * s2 + 3], G[8 * s2 + 4], G[8 * s2 + 5], G[8 * s2 + 6], G[8 * s2 + 7]);
#pragma unroll
            for (int m2 = 0; m2 < 2; ++m2) acc[m2] = MFMA32(vf[s2][m2], bp, acc[m2]);
        }
    }
#pragma unroll
    for (int m2 = 0; m2 < 2; ++m2)
#pragma unroll
        for (int ks = 0; ks < 4; ++ks) cr[m2] = MFMA32(sfr[m2][ks], qf[ks], cr[m2]);
    PF_ISSUE(5);
    const float qd = __builtin_amdgcn_exp2f(lg * (float)(l + 1));
    float ss = 0.f;
#pragma unroll
    for (int m2 = 0; m2 < 2; ++m2)
#pragma unroll
        for (int e = 0; e < 16; ++e) { const float v = acc[m2][e] + qd * cr[m2][e]; acc[m2][e] = v; ss += v * v; }
    ss += lane_xor(ss, 32, lane);
    if (h2 == 0) red[wave * 32 + r32] = ss;
    lds_barrier();
    const float rstd = rsqrtf((red[wave * 32 + r32] + red[(wave ^ 1) * 32 + r32]) * (1.f / 128.f) + EPS);
#pragma unroll
    for (int m2 = 0; m2 < 2; ++m2)
#pragma unroll
        for (int g4 = 0; g4 < 4; ++g4) { u32x2 o; o.x = pk2(acc[m2][4 * g4] * rstd, acc[m2][4 * g4 + 1] * rstd); o.y = pk2(acc[m2][4 * g4 + 2] * rstd, acc[m2][4 * g4 + 3] * rstd);
            *(LAS u32x2*)(Osm + l * 272 + (32 * (2 * dvh + m2) + 8 * g4 + 4 * h2) * 2) = o; }
    { bf16* gbase = pcol(proj, C_RG + h * 128) + t0 * TP;
      u32x4 gvv[4];
#pragma unroll
      for (int it = 0; it < 4; ++it) gvv[it] = *(const u32x4*)(gbase + (size_t)(32 * lt + it * 8 + (lane >> 3)) * TP + 64 * dvh + (lane & 7) * 8);
#pragma unroll
      for (int it = 0; it < 4; ++it) { const int row = 32 * lt + it * 8 + (lane >> 3), dv = 64 * dvh + (lane & 7) * 8;
          bf16* gp = gbase + (size_t)row * TP + dv;
          *(u32x4*)gp = gate8(*(const LAS u32x4*)(Osm + row * 272 + dv * 2), gvv[it]); } }
    PF_DONE;
    lds_barrier();
}

constexpr int SSD_TAB = 0, SSD_ACS = 2048, SSD_SSQ = 4096;
template <int PASS>
DI void ssd_stage(LAS unsigned char* lds, const LayerP& P, int b, int c, int grp, int tid, int xoff, int boff, int bstride, int coff) {
    const int lane = tid & 63, wave = tid >> 6;
    LAS float* dtl = (LAS float*)(lds + SSD_TAB); LAS float* acs = (LAS float*)(lds + SSD_ACS);
    const size_t t0 = (size_t)b * SEQ + (size_t)c * 128;
    const int chunk = lane, seg = wave;
    const int kind = chunk < 32 ? 0 : (chunk < 48 ? 1 : 2);
    const bool active = !(PASS == 1 && kind == 2);
    const int ch0 = kind == 0 ? grp * 256 + chunk * 8 : (kind == 1 ? 512 + grp * 128 + (chunk - 32) * 8 : 768 + grp * 128 + (chunk - 48) * 8);
    float alog_ = 0.f, d0_ = 0.f, d1_ = 0.f;
    if (wave < 4) { const int hh = grp * 4 + wave; alog_ = P.a_log[hh]; d0_ = P.dt[(t0 + 2 * lane) * 8 + hh]; d1_ = P.dt[(t0 + 2 * lane + 1) * 8 + hh]; }
    __builtin_amdgcn_sched_barrier(0);
    u32x4 raw[19];
    { const bf16* gp = pcol(P.proj, C_MX + ch0) + (t0 + 16 * seg) * TP;
      const bool hv = (seg > 0) || (c > 0);
      const u32x4 zz = zero4();
#pragma unroll
      for (int i = 0; i < 19; ++i) { raw[i] = zz; if (active && (i >= 3 || hv)) raw[i] = *(const u32x4*)(gp + ((long)i - 3) * TP); } }
    __builtin_amdgcn_sched_barrier(0);
    if (wave < 4) { const float a = -__expf(alog_);
        const float d0 = d0_, d1 = d1_;
        const float s0 = d0 * a, s1 = s0 + d1 * a; float tot = s1;
#pragma unroll
        for (int off = 1; off < 64; off <<= 1) { const float v = lane_up(tot, off, lane); if (lane >= off) tot += v; }
        const float ex = tot - s1;
        acs[wave * 128 + 2 * lane] = ex + s0; acs[wave * 128 + 2 * lane + 1] = ex + s1; dtl[wave * 128 + 2 * lane] = d0; dtl[wave * 128 + 2 * lane + 1] = d1; }
    lds_barrier();
    if (active) {
        float cw[4][8], cb[8];
#pragma unroll
        for (int j = 0; j < 4; ++j) { const f32x4 w0 = *(const f32x4*)(P.conv_w + j * 1024 + ch0), w1 = *(const f32x4*)(P.conv_w + j * 1024 + ch0 + 4);
            cw[j][0] = w0[0]; cw[j][1] = w0[1]; cw[j][2] = w0[2]; cw[j][3] = w0[3]; cw[j][4] = w1[0]; cw[j][5] = w1[1]; cw[j][6] = w1[2]; cw[j][7] = w1[3]; }
        { const f32x4 w0 = *(const f32x4*)(P.conv_b + ch0), w1 = *(const f32x4*)(P.conv_b + ch0 + 4);
            cb[0] = w0[0]; cb[1] = w0[1]; cb[2] = w0[2]; cb[3] = w0[3]; cb[4] = w1[0]; cb[5] = w1[1]; cb[6] = w1[2]; cb[7] = w1[3]; }
        float u3[8], u2[8], u1[8], cur[8];
        unpack8(raw[0], u3); unpack8(raw[1], u2); unpack8(raw[2], u1);
        const int r = chunk >> 3;
        const float aend = acs[(r & 3) * 128 + 127];
#pragma unroll
        for (int i = 0; i < 16; ++i) { const int l = 16 * seg + i;
            unpack8(raw[3 + i], cur);
            float o[8];
#pragma unroll
            for (int e = 0; e < 8; ++e) { const float v = cb[e] + cw[0][e] * u3[e] + cw[1][e] * u2[e] + cw[2][e] * u1[e] + cw[3][e] * cur[e]; o[e] = silu_f(v); u3[e] = u2[e]; u2[e] = u1[e]; u1[e] = cur[e]; }
            if (kind == 0) { float sc = dtl[r * 128 + l]; if (PASS == 1) sc *= __expf(aend - acs[r * 128 + l]);
#pragma unroll
                for (int e = 0; e < 8; ++e) o[e] *= sc; }
            u32x4 w; w.x = pk2(o[0], o[1]); w.y = pk2(o[2], o[3]); w.z = pk2(o[4], o[5]); w.w = pk2(o[6], o[7]);
            if (kind == 0) *(LAS u32x4*)(lds + xoff + l * 576 + chunk * 16) = w;
            else if (kind == 1) *(LAS u32x4*)(lds + boff + l * bstride + (chunk - 32) * 16) = w;
            else *(LAS u32x4*)(lds + coff + l * 272 + (chunk - 48) * 16) = w; }
    }
    lds_barrier();
}

DI void ssdU_unit(LAS unsigned char* lds, const LayerP& P, int b, int c, int grp, int tid, int nxt = -1) {
    asm volatile("" : "+v"(tid));
    const int lane = tid & 63, wave = tid >> 6, r32 = lane & 31, h2 = lane >> 5;
    constexpr int XOFF = 6144, BOFF = 6144 + 128 * 576;
    ssd_stage<1>(lds, P, b, c, grp, tid, XOFF, BOFF, 320, 0);
    PF_DECL; PF_ISSUE(3);
    const int r = wave >> 1, pt = wave & 1, hh = grp * 4 + r;
    f32x16 acc[4];
#pragma unroll
    for (int nt = 0; nt < 4; ++nt)
#pragma unroll
        for (int e = 0; e < 16; ++e) acc[nt][e] = 0.f;
    bf16x8 fx[2], fb[2][4];
    { const int k0 = 8 * h2; fx[0] = tr_frag(lds + XOFF, 576, k0, k0 + 4, r * 64 + 32 * pt, lane);
#pragma unroll
      for (int nt = 0; nt < 4; ++nt) fb[0][nt] = tr_frag(lds + BOFF, 320, k0, k0 + 4, 32 * nt, lane); }
#pragma unroll
    for (int ks = 0; ks < 8; ++ks) {
        if (ks < 7) { const int k1 = 16 * (ks + 1) + 8 * h2; fx[(ks + 1) & 1] = tr_frag(lds + XOFF, 576, k1, k1 + 4, r * 64 + 32 * pt, lane);
#pragma unroll
            for (int nt = 0; nt < 4; ++nt) fb[(ks + 1) & 1][nt] = tr_frag(lds + BOFF, 320, k1, k1 + 4, 32 * nt, lane); }
        __builtin_amdgcn_sched_barrier(0);
#pragma unroll
        for (int nt = 0; nt < 4; ++nt) acc[nt] = MFMA32(fb[ks & 1][nt], fx[ks & 1], acc[nt]);
        __builtin_amdgcn_sched_barrier(0);
    }
    bf16* Sb = P.st_ssd + ((size_t)((b * 32 + c) * 8 + hh)) * 8192;
#pragma unroll
    for (int nt = 0; nt < 4; ++nt)
#pragma unroll
        for (int g4 = 0; g4 < 4; ++g4) { u32x2 o; o.x = pk2(acc[nt][4 * g4], acc[nt][4 * g4 + 1]); o.y = pk2(acc[nt][4 * g4 + 2], acc[nt][4 * g4 + 3]);
            *(u32x2*)(Sb + ((pt * 8 + 2 * nt + (g4 >> 1)) * 64 + (g4 & 1) * 32 + r32) * 8 + 4 * h2) = o; }
    if (tid < 4) P.cd[(b * 32 + c) * 8 + grp * 4 + tid] = __expf(((LAS float*)(lds + SSD_ACS))[tid * 128 + 127]);
    PF_DONE;
    lds_barrier();
}

DI void ssdO_unit(LAS unsigned char* lds, const LayerP& P, int b, int c, int grp, int tid, int nxt = -1) {
    asm volatile("" : "+v"(tid));
    const int lane = tid & 63, wave = tid >> 6, r32 = lane & 31, h2 = lane >> 5;
    constexpr int BOFF = 6144, COFF = 6144 + 34816, XOFF = 6144 + 2 * 34816;
    ssd_stage<2>(lds, P, b, c, grp, tid, XOFF, BOFF, 272, COFF);
    PF_DECL;
    LAS float* dtl = (LAS float*)(lds + SSD_TAB); LAS float* acs = (LAS float*)(lds + SSD_ACS); LAS float* ssq = (LAS float*)(lds + SSD_SSQ);
    bf16* proj = P.proj; const size_t t0 = (size_t)b * SEQ + (size_t)c * 128;
    const int r = wave >> 1, lh = wave & 1, hh = grp * 4 + r;
    const bf16* Sb = P.st_ssd + ((size_t)((b * 32 + c) * 8 + hh)) * 8192;
    const float dsk = P.d_skip[hh];
    bf16x8 sf0[8];
#pragma unroll
    for (int ks = 0; ks < 8; ++ks) sf0[ks] = *(const bf16x8*)(Sb + (ks * 64 + lane) * 8);
    u32x4 og[2][4];
#pragma unroll
    for (int li = 0; li < 2; ++li) {
        const int lt = li == 0 ? lh : 3 - lh, l = 32 * lt + r32;
        bf16x8 cf[8];
#pragma unroll
        for (int ks = 0; ks < 8; ++ks) cf[ks] = *(const LAS bf16x8*)(lds + COFF + l * 272 + (16 * ks + 8 * h2) * 2);
        f32x16 y[2];
#pragma unroll
        for (int pt = 0; pt < 2; ++pt)
#pragma unroll
            for (int e = 0; e < 16; ++e) y[pt][e] = 0.f;
        const float al = acs[r * 128 + l];
        for (int st = 0; st <= lt; ++st) {
            bf16x8 bfr[8];
#pragma unroll
            for (int ks = 0; ks < 8; ++ks) bfr[ks] = *(const LAS bf16x8*)(lds + BOFF + (32 * st + r32) * 272 + (16 * ks + 8 * h2) * 2);
            __builtin_amdgcn_sched_barrier(0);
            f32x16 G;
#pragma unroll
            for (int e = 0; e < 16; ++e) G[e] = 0.f;
#pragma unroll
            for (int ks = 0; ks < 8; ++ks) G = MFMA32(bfr[ks], cf[ks], G);
            __builtin_amdgcn_sched_barrier(0);
            bf16x8 xf[2][2];
#pragma unroll
            for (int s2 = 0; s2 < 2; ++s2) { const int k0 = 32 * st + 16 * s2 + 4 * h2;
#pragma unroll
                for (int pt = 0; pt < 2; ++pt) xf[s2][pt] = tr_frag(lds + XOFF, 576, k0, k0 + 8, r * 64 + 32 * pt, lane); }
            float dcy[16];
#pragma unroll
            for (int e = 0; e < 16; ++e) dcy[e] = acs[r * 128 + 32 * st + crow(e, h2)];
            __builtin_amdgcn_sched_barrier(0);
#pragma unroll
            for (int e = 0; e < 16; ++e) { const int s = 32 * st + crow(e, h2); G[e] = (s <= l) ? G[e] * __expf(al - dcy[e]) : 0.f; }
#pragma unroll
            for (int s2 = 0; s2 < 2; ++s2) {
                const bf16x8 bp = pack8(G[8 * s2], G[8 * s2 + 1], G[8 * s2 + 2], G[8 * s2 + 3], G[8 * s2 + 4], G[8 * s2 + 5], G[8 * s2 + 6], G[8 * s2 + 7]);
#pragma unroll
                for (int pt = 0; pt < 2; ++pt) y[pt] = MFMA32(xf[s2][pt], bp, y[pt]);
            }
        }
        bf16* zrow = pcol(proj, C_MZ + hh * 64) + (t0 + l) * TP;
        u32x4 zr[2][2];
#pragma unroll
        for (int pt = 0; pt < 2; ++pt)
#pragma unroll
            for (int a2 = 0; a2 < 2; ++a2) zr[pt][a2] = *(const u32x4*)(zrow + 32 * pt + 16 * a2 + 8 * h2);
        bf16x8 sf1[8];
#pragma unroll
        for (int ks = 0; ks < 8; ++ks) sf1[ks] = *(const bf16x8*)(Sb + ((8 + ks) * 64 + lane) * 8);
        __builtin_amdgcn_sched_barrier(0);
        f32x16 yo[2];
#pragma unroll
        for (int pt = 0; pt < 2; ++pt)
#pragma unroll
            for (int e = 0; e < 16; ++e) yo[pt][e] = 0.f;
#pragma unroll
        for (int ks = 0; ks < 8; ++ks) yo[0] = MFMA32(sf0[ks], cf[ks], yo[0]);
#pragma unroll
        for (int ks = 0; ks < 8; ++ks) yo[1] = MFMA32(sf1[ks], cf[ks], yo[1]);
        const float el = __expf(al), dti = __builtin_amdgcn_rcpf(dtl[r * 128 + l]);
        float ss = 0.f;
#pragma unroll
        for (int pt = 0; pt < 2; ++pt)
#pragma unroll
            for (int a2 = 0; a2 < 2; ++a2) {
                f32x4 v0, v1;
#pragma unroll
                for (int j = 0; j < 4; ++j) { v0[j] = y[pt][8 * a2 + j] + el * yo[pt][8 * a2 + j]; v1[j] = y[pt][8 * a2 + 4 + j] + el * yo[pt][8 * a2 + 4 + j]; }
                const bool hi = h2 != 0;
                const f32x4 mine = hi ? v1 : v0, give = hi ? v0 : v1;
                f32x4 got;
#pragma unroll
                for (int j = 0; j < 4; ++j) got[j] = lane_xor(give[j], 32, lane);
                const f32x4 lo4 = hi ? got : mine, hi4 = hi ? mine : got;
                float v8[8];
#pragma unroll
                for (int j = 0; j < 4; ++j) { v8[j] = lo4[j]; v8[4 + j] = hi4[j]; }
                const int p0 = 32 * pt + 16 * a2 + 8 * h2;
                float xs[8], zs[8]; unpack8(*(const LAS u32x4*)(lds + XOFF + l * 576 + (r * 64 + p0) * 2), xs); unpack8(zr[pt][a2], zs);
#pragma unroll
                for (int j = 0; j < 8; ++j) { v8[j] = (v8[j] + xs[j] * dti * dsk) * zs[j]; ss += v8[j] * v8[j]; }
                u32x4 o; o.x = pk2(v8[0], v8[1]); o.y = pk2(v8[2], v8[3]); o.z = pk2(v8[4], v8[5]); o.w = pk2(v8[6], v8[7]);
                og[li][pt * 2 + a2] = o;
            }
        ss += lane_xor(ss, 32, lane);
        if (h2 == 0) ssq[r * 128 + l] = ss;
        __builtin_amdgcn_sched_barrier(0);
    }
    PF_ISSUE(5);
    f32x4 nw[2][2][2];
#pragma unroll
    for (int pt = 0; pt < 2; ++pt)
#pragma unroll
        for (int a2 = 0; a2 < 2; ++a2) { const int p0 = 32 * pt + 16 * a2 + 8 * h2; nw[pt][a2][0] = *(const f32x4*)(P.ssm_norm_w + hh * 64 + p0); nw[pt][a2][1] = *(const f32x4*)(P.ssm_norm_w + hh * 64 + p0 + 4); }
    lds_barrier();
#pragma unroll
    for (int li = 0; li < 2; ++li) {
        const int l = 32 * (li == 0 ? lh : 3 - lh) + r32;
        const float rstd = rsqrtf((ssq[l] + ssq[128 + l] + ssq[256 + l] + ssq[384 + l]) * (1.f / 256.f) + EPS);
        bf16* orow = pcol(proj, C_MZ + hh * 64) + (t0 + l) * TP;
#pragma unroll
        for (int pt = 0; pt < 2; ++pt)
#pragma unroll
            for (int a2 = 0; a2 < 2; ++a2) { const int p0 = 32 * pt + 16 * a2 + 8 * h2; const f32x4 n0 = nw[pt][a2][0], n1 = nw[pt][a2][1];
                const u32x4 yv = og[li][pt * 2 + a2];
                u32x4 o; o.x = pk2(bflo(yv.x) * rstd * n0[0], bfhi(yv.x) * rstd * n0[1]); o.y = pk2(bflo(yv.y) * rstd * n0[2], bfhi(yv.y) * rstd * n0[3]);
                o.z = pk2(bflo(yv.z) * rstd * n1[0], bfhi(yv.z) * rstd * n1[1]); o.w = pk2(bflo(yv.w) * rstd * n1[2], bfhi(yv.w) * rstd * n1[3]);
                *(u32x4*)(orow + p0) = o; }
    }
    PF_DONE;
    lds_barrier();
}

DI void scan_phase(const LayerP& P, int gid) {
    bf16* base; float dec_const = 0.f; const float* cdp = nullptr; size_t cstride;
    if (gid < 32768) { const int b = gid >> 12, h = (gid >> 10) & 3, e8 = gid & 1023; base = P.st_ret + ((size_t)(b * 32 * 4 + h)) * 8192 + e8 * 8; cstride = 4 * 8192; dec_const = exp2f(128.f * ret_lg(h)); }
    else if (gid < 98304) { const int g2 = gid - 32768, b = g2 >> 13, h = (g2 >> 10) & 7, e8 = g2 & 1023; base = P.st_ssd + ((size_t)(b * 32 * 8 + h)) * 8192 + e8 * 8; cstride = 8 * 8192; cdp = P.cd + b * 32 * 8 + h; }
    else return;
    float s[8]; float zf = 0.f; asm volatile("" : "+v"(zf));
#pragma unroll
    for (int e = 0; e < 8; ++e) s[e] = zf;
#pragma unroll
    for (int c0 = 0; c0 < 32; c0 += 16) {
        u32x4 v[16]; float dc[16];
#pragma unroll
        for (int i = 0; i < 16; ++i) { v[i] = *(const u32x4*)(base + (size_t)(c0 + i) * cstride); dc[i] = cdp ? cdp[(c0 + i) * 8] : dec_const; }
#pragma unroll
        for (int i = 0; i < 16; ++i) { float u[8]; unpack8(v[i], u);
            u32x4 o; o.x = pk2(s[0], s[1]); o.y = pk2(s[2], s[3]); o.z = pk2(s[4], s[5]); o.w = pk2(s[6], s[7]); *(u32x4*)(base + (size_t)(c0 + i) * cstride) = o;
#pragma unroll
            for (int e = 0; e < 8; ++e) s[e] = s[e] * dc[i] + u[e]; }
        __builtin_amdgcn_sched_barrier(0);
    }
}

DI int win_src(int r, float& sc) {
    sc = 1.f;
    if (r < 512) return S_RG + r;
    if (r < 1024) return S_SG + r - 512;
    if (r < 1536) return S_PG + r - 1024;
    if (r < 2048) return S_MZ + r - 1536;
    if (r < 2304) return S_RQ + r - 2048;
    if (r < 2560) { sc = 0.125f; return S_RK + r - 2304; }
    if (r < 3072) return S_RV + r - 2560;
    if (r < 3584) { sc = 0.125f * 1.44269504f; return S_SQ + r - 3072; }
    if (r < 3712) return S_SK + r - 3584;
    if (r < 3840) return S_SV + r - 3712;
    if (r < 4352) return S_PX + r - 3840;
    if (r < 5376) return S_MX + r - 4352;
    const int rho = r - 5376, pn = rho >> 8, bj = (rho >> 7) & 1, wc = (rho >> 5) & 3, n = (rho >> 4) & 1, fq = (rho >> 2) & 3, j = rho & 3;
    return S_MG + (2 * bj + n) * 1024 + 64 * pn + 32 * (wc >> 1) + 8 * fq + 4 * (wc & 1) + j;
}
DI void transpose_item(const float* W, int ldw, int K, bf16* WT, int r0, int k0, int col, float sc, LAS float* scr, int lane, int kd0 = -1) {
    if (kd0 < 0) kd0 = k0;
#pragma unroll 8
    for (int i = 0; i < 32; ++i) { const int kk = 2 * i + (lane >> 5); scr[kk * 33 + (lane & 31)] = W[(size_t)(k0 + kk) * ldw + col] * sc; }
    asm volatile("s_waitcnt lgkmcnt(0)" ::: "memory");
    const int c = lane & 7;
#pragma unroll
    for (int j = 0; j < 4; ++j) { const int n = (lane >> 3) + 8 * j; const LAS float* s = scr + (8 * c) * 33 + n;
        u32x4 o; o.x = pk2(s[0 * 33], s[1 * 33]); o.y = pk2(s[2 * 33], s[3 * 33]); o.z = pk2(s[4 * 33], s[5 * 33]); o.w = pk2(s[6 * 33], s[7 * 33]);
        *(u32x4*)(WT + (size_t)(r0 + n) * K + kd0 + 8 * c) = o; }
    asm volatile("s_waitcnt lgkmcnt(0)" ::: "memory");
}

DI void transpose_item8(const float* W, int ldw, int K, unsigned char* WT8, int r0, int k0, int col, float sc, LAS float* scr, int lane) {
#pragma unroll 8
    for (int i = 0; i < 32; ++i) { const int kk = 2 * i + (lane >> 5); scr[kk * 33 + (lane & 31)] = W[(size_t)(k0 + kk) * ldw + col] * sc; }
    asm volatile("s_waitcnt lgkmcnt(0)" ::: "memory");
    const int c = lane & 7;
#pragma unroll
    for (int j = 0; j < 4; ++j) { const int n = (lane >> 3) + 8 * j; const LAS float* s = scr + (8 * c) * 33 + n;
        u32x2 o; o.x = pk4_i8(s[0 * 33], s[1 * 33], s[2 * 33], s[3 * 33]); o.y = pk4_i8(s[4 * 33], s[5 * 33], s[6 * 33], s[7 * 33]);
        *(u32x2*)(WT8 + (size_t)(r0 + n) * K + k0 + 8 * c) = o; }
    asm volatile("s_waitcnt lgkmcnt(0)" ::: "memory");
}

struct Args {
    const float* in[18]; float* out; unsigned char* ws; int ph_lo, ph_hi;
};

constexpr int T_I_WIN = (WIN_ROWS / 32) * 16, T_I_UP = 32 * 8, T_I_OUT = 32 * 16, T_I_POOL = 4 * 2;
constexpr int T_NITEMS = 2 * T_I_WIN + 8 * T_I_UP + 2 * T_I_OUT + 8 * T_I_POOL;
struct TIt { const float* src; bf16* dst; unsigned char* dst8; float sc; int ldw, K, r0, kd0, is8; };
DI TIt t_decode(const Args& a, int it, int lane) {
    TIt t; unsigned char* ws = a.ws; int r = it; t.is8 = 0; t.dst8 = nullptr; t.dst = nullptr;
    if (r < 2 * T_I_WIN) { const int l = r / T_I_WIN, q = r % T_I_WIN, rg = q >> 4, kb = q & 15; float sc; const int col = win_src(rg * 32 + (lane & 31), sc);
        t.src = a.in[5] + (size_t)l * 1024 * DIN + (size_t)(kb * 64) * DIN + col; t.ldw = DIN; t.K = 1024; t.kd0 = kb * 64; t.sc = sc; t.r0 = rg * 32;
        if (rg * 32 < 2048) { t.is8 = 1; t.sc = 1.f / ((const float*)(ws + WS_SW))[l * 6144 + 4096 + rg * 32 + (lane & 31)];
            t.dst8 = (unsigned char*)((bf16*)(ws + WS_WIN) + (size_t)l * WIN_L + (size_t)5376 * 1024); }
        else if (rg * 32 >= 5376) { t.is8 = 1; t.sc = 1.f / ((const float*)(ws + WS_SW))[l * 6144 + rg * 32 - 5376 + (lane & 31)];
            t.dst8 = ws + WS_WMG8 + (size_t)l * 4096 * 1024; t.r0 = rg * 32 - 5376; }
        else t.dst = (bf16*)(ws + WS_WIN) + (size_t)l * WIN_L;
        return t; }
    r -= 2 * T_I_WIN;
    if (r < 8 * T_I_UP) { const int li = r / T_I_UP, q = r % T_I_UP, rg = q >> 3, kb = q & 7;
        t.src = a.in[15] + (size_t)li * 512 * 1024 + (size_t)(kb * 64) * 1024 + rg * 32 + (lane & 31); t.ldw = 1024; t.K = 2048; t.kd0 = (li & 3) * 512 + kb * 64; t.sc = 1.f; t.r0 = rg * 32;
        t.dst = (bf16*)(ws + WS_WUP) + (size_t)(li >> 2) * 1024 * 2048; return t; }
    r -= 8 * T_I_UP;
    if (r < 2 * T_I_OUT) { const int l = r / T_I_OUT, q = r % T_I_OUT, rg = q >> 4, kb = q & 15;
        t.src = a.in[16] + (size_t)l * 1024 * 1024 + (size_t)(kb * 64) * 1024 + rg * 32 + (lane & 31); t.ldw = 1024; t.K = 1024; t.kd0 = kb * 64; t.sc = 1.f; t.r0 = rg * 32;
        t.dst = (bf16*)(ws + WS_WOUT) + (size_t)l * 1024 * 1024; return t; }
    r -= 2 * T_I_OUT;
    { const int lg = r / T_I_POOL, q = r % T_I_POOL, rg = q >> 1, kb = q & 1;
        t.src = a.in[7] + (size_t)lg * 128 * 128 + (size_t)(kb * 64) * 128 + rg * 32 + (lane & 31); t.ldw = 128; t.K = 128; t.kd0 = kb * 64; t.sc = 1.f; t.r0 = rg * 32;
        t.dst = (bf16*)(ws + WS_POOL) + (size_t)lg * 128 * 128; return t; }
}
DI void t_load(const TIt& t, float (&v)[32], int lane) {
    const float* p = t.src + (size_t)(lane >> 5) * t.ldw;
#pragma unroll
    for (int i = 0; i < 32; ++i) v[i] = p[(size_t)(2 * i) * t.ldw];
}
DI void t_process(const TIt& t, const float (&v)[32], LAS float* scr, int lane) {
#pragma unroll
    for (int i = 0; i < 32; ++i) { const int kk = 2 * i + (lane >> 5); scr[kk * 33 + (lane & 31)] = v[i] * t.sc; }
    asm volatile("s_waitcnt lgkmcnt(0)" ::: "memory");
    const int c = lane & 7;
    if (t.is8) {
#pragma unroll
        for (int j = 0; j < 4; ++j) { const int n = (lane >> 3) + 8 * j; const LAS float* s = scr + (8 * c) * 33 + n;
            u32x2 o; o.x = pk4_i8(s[0 * 33], s[1 * 33], s[2 * 33], s[3 * 33]); o.y = pk4_i8(s[4 * 33], s[5 * 33], s[6 * 33], s[7 * 33]);
            *(u32x2*)(t.dst8 + (size_t)(t.r0 + n) * t.K + t.kd0 + 8 * c) = o; }
    } else {
#pragma unroll
        for (int j = 0; j < 4; ++j) { const int n = (lane >> 3) + 8 * j; const LAS float* s = scr + (8 * c) * 33 + n;
            u32x4 o; o.x = pk2(s[0 * 33], s[1 * 33]); o.y = pk2(s[2 * 33], s[3 * 33]); o.z = pk2(s[4 * 33], s[5 * 33]); o.w = pk2(s[6 * 33], s[7 * 33]);
            *(u32x4*)(t.dst + (size_t)(t.r0 + n) * t.K + t.kd0 + 8 * c) = o; }
    }
    asm volatile("s_waitcnt lgkmcnt(0)" ::: "memory");
}
DI void p0_prologue(LAS unsigned char* lds, const Args& a, int tid, int G, int part) {
    const int lane = tid & 63, wave = tid >> 6;
    unsigned char* ws = a.ws;
    if (part == 0)
    for (int it = blockIdx.x; it < 192; it += G) {
        const int l = it / 96, cg = it % 96, cc = tid & 31, ks = tid >> 5;
        LAS float* sc = (LAS float*)lds;
        LAS float* red = (LAS float*)(lds + 32768);
        for (int i = tid; i < 8192; i += 512) sc[i] = silu_f(a.in[1][i]);
        __syncthreads();
        float acc[8];
#pragma unroll
        for (int b = 0; b < 8; ++b) acc[b] = 0.f;
        const float* wp = a.in[2] + (size_t)l * 1024 * 3072 + (size_t)(ks * 64) * 3072 + cg * 32 + cc;
#pragma unroll
        for (int k0 = 0; k0 < 64; k0 += 32) { float w[32];
#pragma unroll
            for (int j = 0; j < 32; ++j) w[j] = wp[(size_t)(k0 + j) * 3072];
            __builtin_amdgcn_sched_barrier(0);
#pragma unroll
            for (int j = 0; j < 32; ++j)
#pragma unroll
                for (int b = 0; b < 8; ++b) acc[b] += sc[b * 1024 + ks * 64 + k0 + j] * w[j];
            __builtin_amdgcn_sched_barrier(0); }
#pragma unroll
        for (int b = 0; b < 8; ++b) red[(ks * 8 + b) * 32 + cc] = acc[b];
        __syncthreads();
        if (tid < 256) { const int b = tid >> 5, n = tid & 31; float s = 0.f;
#pragma unroll
            for (int q = 0; q < 16; ++q) s += red[(q * 8 + b) * 32 + n];
            ((float*)(ws + WS_MOD))[(size_t)(l * 8 + b) * 3072 + cg * 32 + n] = s + a.in[3][l * 3072 + cg * 32 + n]; }
        __syncthreads();
    }
    if (part == 0) {
        LAS float* red = (LAS float*)lds;
        for (int cb = blockIdx.x; cb < 384; cb += G) { const int l = cb / 192, gq = cb % 192, rho0 = gq * 32, cc = tid & 31, ks = tid >> 5; float dummy;
            const float* wp = a.in[5] + (size_t)l * 1024 * DIN + (size_t)(ks * 64) * DIN + win_src(gq < 128 ? 5376 + rho0 + cc : rho0 - 4096 + cc, dummy);
            float mx = 0.f;
#pragma unroll
            for (int k0 = 0; k0 < 64; k0 += 32) { float w[32];
#pragma unroll
                for (int j = 0; j < 32; ++j) w[j] = __builtin_nontemporal_load(wp + (size_t)(k0 + j) * DIN);
                __builtin_amdgcn_sched_barrier(0);
#pragma unroll
                for (int j = 0; j < 32; ++j) mx = fmaxf(mx, fabsf(w[j]));
                __builtin_amdgcn_sched_barrier(0); }
            __syncthreads(); red[ks * 32 + cc] = mx; __syncthreads();
            if (tid < 32) { float m2 = 0.f;
#pragma unroll
                for (int q = 0; q < 16; ++q) m2 = fmaxf(m2, red[q * 32 + tid]);
                ((float*)(ws + WS_SW))[l * 6144 + rho0 + tid] = m2 > 0.f ? m2 * (1.f / 127.f) : 1.f; }
        }
        return;
    }
    LAS float* scr = (LAS float*)(lds + wave * 8448);
    const int gw = blockIdx.x * 8 + wave, NGW = G * 8;
    if (gw < T_NITEMS) {
        int it = gw; TIt ta = t_decode(a, it, lane), tb = ta; float va[32], vb[32];
        t_load(ta, va, lane);
        for (;;) {
            int itn = it + NGW; bool has = itn < T_NITEMS;
            if (has) { tb = t_decode(a, itn, lane); t_load(tb, vb, lane); }
            __builtin_amdgcn_sched_barrier(0);
            t_process(ta, va, scr, lane);
            if (!has) break;
            it = itn; itn = it + NGW; has = itn < T_NITEMS;
            if (has) { ta = t_decode(a, itn, lane); t_load(ta, va, lane); }
            __builtin_amdgcn_sched_barrier(0);
            t_process(tb, vb, scr, lane);
            if (!has) break;
            it = itn;
        }
    }
}

template <bool IN_BF16>
DI void p1_norm(LAS unsigned char* lds, const Args& a, int layer, const void* xin, int tid, int G) {
    const int lane = tid & 63, wave = tid >> 6;
    LAS float* wdt = (LAS float*)lds;
    const float* win = a.in[5] + (size_t)layer * 1024 * DIN;
    for (int i = tid; i < 8192; i += 512) { const int k = i >> 3, jj = i & 7; wdt[(((k >> 8) * 4 + (k & 3)) * 64 + ((k & 255) >> 2)) * 4 + (jj & 3) + (jj >> 2) * 4096] = win[(size_t)k * DIN + S_DT + jj]; }
    __syncthreads();
    const float* nw = a.in[4] + layer * 1024; const float* mod = (const float*)(a.ws + WS_MOD) + (size_t)layer * 8 * 3072;
    bf16* H = (bf16*)(a.ws + WS_H); float* DT = (float*)(a.ws + WS_DT); const float* dtb = a.in[11] + layer * 8;
    f32x4 w4r[4];
#pragma unroll
    for (int j = 0; j < 4; ++j) w4r[j] = *(const f32x4*)(nw + 256 * j + 4 * lane);
    const int row0_ = blockIdx.x * 8 + wave;
    f32x4 vf[4]; u32x2 vb[4];
#pragma unroll
    for (int j = 0; j < 4; ++j) { if (IN_BF16) vb[j] = __builtin_nontemporal_load((const u32x2*)((const bf16*)xin + (size_t)row0_ * D) + lane + 64 * j); else vf[j] = __builtin_nontemporal_load((const f32x4*)((const float*)xin + (size_t)row0_ * D) + lane + 64 * j); }
    for (int row = row0_; row < T; row += G * 8) {
        const int b = row >> 12;
        f32x4 v[4]; float ss = 0.f;
#pragma unroll
        for (int j = 0; j < 4; ++j) { if (IN_BF16) v[j] = (f32x4){bflo(vb[j].x), bfhi(vb[j].x), bflo(vb[j].y), bfhi(vb[j].y)}; else v[j] = vf[j]; }
        f32x4 sc4r[4], sh4r[4];
#pragma unroll
        for (int j = 0; j < 4; ++j) { const int col = 256 * j + 4 * lane; sc4r[j] = *(const f32x4*)(mod + b * 3072 + 1024 + col); sh4r[j] = *(const f32x4*)(mod + b * 3072 + col); }
        { const int nrow = row + G * 8 < T ? row + G * 8 : row;
#pragma unroll
          for (int j = 0; j < 4; ++j) { if (IN_BF16) vb[j] = __builtin_nontemporal_load((const u32x2*)((const bf16*)xin + (size_t)nrow * D) + lane + 64 * j); else vf[j] = __builtin_nontemporal_load((const f32x4*)((const float*)xin + (size_t)nrow * D) + lane + 64 * j); } }
        __builtin_amdgcn_sched_barrier(0);
#pragma unroll
        for (int j = 0; j < 4; ++j) ss += (v[j][0] * v[j][0] + v[j][1] * v[j][1]) + (v[j][2] * v[j][2] + v[j][3] * v[j][3]);
        const float rstd = rsqrtf(wave_sum(ss, lane) * (1.f / D) + EPS);
        float dacc[8]; f32x4 hq[4];
#pragma unroll
        for (int e = 0; e < 8; ++e) dacc[e] = 0.f;
#pragma unroll
        for (int j = 0; j < 4; ++j) { const int col = 256 * j + 4 * lane;
            const f32x4 w4 = w4r[j], sc4 = sc4r[j], sh4 = sh4r[j];
            const f32x4 hv = v[j] * rstd * w4 * (sc4 + 1.f) + sh4;
            u32x2 o; o.x = pk2(hv[0], hv[1]); o.y = pk2(hv[2], hv[3]);
            *(u32x2*)(H + (size_t)j * TS + (size_t)row * TP + 4 * lane) = o;
            hq[j] = hv;
#pragma unroll
            for (int e = 0; e < 4; ++e) { const f32x4 w0 = *(const LAS f32x4*)(wdt + ((j * 4 + e) * 64 + lane) * 4), w1 = *(const LAS f32x4*)(wdt + 4096 + ((j * 4 + e) * 64 + lane) * 4);
                dacc[0] += hv[e] * w0[0]; dacc[1] += hv[e] * w0[1]; dacc[2] += hv[e] * w0[2]; dacc[3] += hv[e] * w0[3];
                dacc[4] += hv[e] * w1[0]; dacc[5] += hv[e] * w1[1]; dacc[6] += hv[e] * w1[2]; dacc[7] += hv[e] * w1[3]; } }
        { float am = 0.f;
#pragma unroll
          for (int j = 0; j < 4; ++j) am = fmaxf(am, fmaxf(fmaxf(fabsf(hq[j][0]), fabsf(hq[j][1])), fmaxf(fabsf(hq[j][2]), fabsf(hq[j][3]))));
#pragma unroll
          for (int o = 1; o < 64; o <<= 1) am = fmaxf(am, lane_xor(am, o, lane));
          const float qs = am > 0.f ? 127.f / am : 0.f;
#pragma unroll
          for (int j = 0; j < 4; ++j) *(unsigned*)((unsigned char*)a.out + (size_t)T * D * 2 + (size_t)row * D + 256 * j + 4 * lane) = pk4_i8(hq[j][0] * qs, hq[j][1] * qs, hq[j][2] * qs, hq[j][3] * qs);
          if (lane == 0) ((float*)(a.ws + WS_SH))[row] = am > 0.f ? am * (1.f / 127.f) : 1.f; }
        float mine = 0.f;
#pragma unroll
        for (int e = 0; e < 8; ++e) { const float s = wave_sum(dacc[e], lane); if (lane == e) mine = s; }
        if (lane < 8) { const float z = mine + dtb[lane]; const float ez = __expf(z); DT[(size_t)row * 8 + lane] = z > 20.f ? z : (ez < 0.01f ? ez * (1.f - ez * (0.5f - ez * 0.33333334f)) : __logf(1.f + ez)); }
    }
    __syncthreads();
}

DI void p7_final(const Args& a, int tid, int G) {
    const int lane = tid & 63, wave = tid >> 6; const float* fw = a.in[17];
    const bf16* x2 = (const bf16*)(a.ws + WS_PROJ);
    f32x4 fwr[4];
#pragma unroll
    for (int j = 0; j < 4; ++j) fwr[j] = *(const f32x4*)(fw + 256 * j + 4 * lane);
    const int row0_ = blockIdx.x * 8 + wave;
    u32x2 vb[4];
#pragma unroll
    for (int j = 0; j < 4; ++j) vb[j] = __builtin_nontemporal_load((const u32x2*)(x2 + (size_t)row0_ * D) + lane + 64 * j);
    for (int row = row0_; row < T; row += G * 8) {
        f32x4 v[4]; float ss = 0.f;
#pragma unroll
        for (int j = 0; j < 4; ++j) v[j] = (f32x4){bflo(vb[j].x), bfhi(vb[j].x), bflo(vb[j].y), bfhi(vb[j].y)};
        { const int nrow = row + G * 8 < T ? row + G * 8 : row;
#pragma unroll
          for (int j = 0; j < 4; ++j) vb[j] = __builtin_nontemporal_load((const u32x2*)(x2 + (size_t)nrow * D) + lane + 64 * j); }
        __builtin_amdgcn_sched_barrier(0);
#pragma unroll
        for (int j = 0; j < 4; ++j) ss += (v[j][0] * v[j][0] + v[j][1] * v[j][1]) + (v[j][2] * v[j][2] + v[j][3] * v[j][3]);
        const float rstd = rsqrtf(wave_sum(ss, lane) * (1.f / D) + EPS);
        f32x4* xr = (f32x4*)(a.out + (size_t)row * D) + lane;
#pragma unroll
        for (int j = 0; j < 4; ++j) __builtin_nontemporal_store(v[j] * rstd * fwr[j], xr + 64 * j);
    }
}


#define XB_TMO      128
#define XB_XCNT(j)  (256  + 64 * (j))
#define XB_XSUB(j)  (1280 + 64 * (j))
#define XB_XGEN(j)  (2304 + 64 * (j))
#define XB_TOP      3328
#define XB_TOPGEN   3392
#define XCD_BAR_WORDS 3456
#define XB_SPIN_CAP (1u << 20)
DI unsigned xb_ld(unsigned* p)              { return __hip_atomic_load(p, __ATOMIC_RELAXED, __HIP_MEMORY_SCOPE_AGENT); }
DI unsigned xb_add(unsigned* p, unsigned v) { return __hip_atomic_fetch_add(p, v, __ATOMIC_RELAXED, __HIP_MEMORY_SCOPE_AGENT); }
DI unsigned xb_xcc_id() { return (unsigned)__builtin_amdgcn_s_getreg((3 << 11) | 20) & 0xFu; }
#define XB_SPIN(cond, bar) do { unsigned _sp = 0; while (cond) { __builtin_amdgcn_s_sleep(1); \
    if ((++_sp & 255u) == 0u) { if (xb_ld(&(bar)[XB_TMO])) break; if (_sp > XB_SPIN_CAP) { atomicAdd(&(bar)[XB_TMO], 1u); break; } } } } while (0)
struct XcdBarrier { unsigned* bar; unsigned x; volatile LAS unsigned* st; };
DI XcdBarrier xcd_barrier_post(unsigned* bar, volatile LAS unsigned* st, bool leader) {
    XcdBarrier b; b.bar = bar; b.x = xb_xcc_id(); b.st = st;
    if (leader) (void)xb_add(&bar[XB_XCNT(b.x)], 1u);
    return b;
}
DI void xcd_barrier_complete(unsigned* bar, unsigned x, unsigned& nloc, unsigned& nx) {
    const unsigned G = gridDim.x * gridDim.y * gridDim.z;
    unsigned sum, cnt, mine, sp = 0u;
    for (;;) {
        sum = 0u; cnt = 0u; mine = 0u;
#pragma unroll
        for (unsigned j = 0; j < 16; ++j) { const unsigned c = xb_ld(&bar[XB_XCNT(j)]); sum += c; cnt += (c > 0u) ? 1u : 0u; mine = (j == x) ? c : mine; }
        if (sum == G) break;
        __builtin_amdgcn_s_sleep(1);
        if ((++sp & 255u) == 0u) { if (xb_ld(&bar[XB_TMO])) break; if (sp > XB_SPIN_CAP) { atomicAdd(&bar[XB_TMO], 1u); break; } }
    }
    nloc = mine > 0u ? mine : 1u; nx = cnt > 0u ? cnt : 1u;
}
DI void xcd_barrier(const XcdBarrier& b, bool leader) {
    asm volatile("s_waitcnt vmcnt(0)" ::: "memory");
    __syncthreads();
    if (leader) {
        unsigned* bar = b.bar;
        __builtin_amdgcn_s_waitcnt(0);
        unsigned nloc = b.st[0], nx = b.st[1];
        if (nloc == 0u) { xcd_barrier_complete(bar, b.x, nloc, nx); b.st[0] = nloc; b.st[1] = nx; }
        const unsigned old = xb_add(&bar[XB_XSUB(b.x)], 1u);
        const unsigned gen = old / nloc;
        if (old + 1u == (gen + 1u) * nloc) {
            __builtin_amdgcn_fence(__ATOMIC_RELEASE, "agent");
            asm volatile("s_waitcnt vmcnt(0)" ::: "memory");
            const unsigned og = xb_add(&bar[XB_TOP], 1u);
            const unsigned tg = og / nx;
            if (og + 1u == (tg + 1u) * nx) xb_add(&bar[XB_TOPGEN], 1u);
            else XB_SPIN(xb_ld(&bar[XB_TOPGEN]) == tg, bar);
            __builtin_amdgcn_fence(__ATOMIC_ACQUIRE, "agent");
            xb_add(&bar[XB_XGEN(b.x)], 1u);
            asm volatile("s_waitcnt vmcnt(0)" ::: "memory");
        } else {
            XB_SPIN(xb_ld(&bar[XB_XGEN(b.x)]) == gen, bar);
            __builtin_amdgcn_fence(__ATOMIC_ACQUIRE, "agent");
            asm volatile("s_waitcnt vmcnt(0)" ::: "memory");
        }
    }
    __syncthreads();
}

#if defined(__HIP_DEVICE_COMPILE__)
#define LOAD_ARGS() ({ const __attribute__((address_space(4))) Args* kp_ = (const __attribute__((address_space(4))) Args*)__builtin_amdgcn_kernarg_segment_ptr(); asm volatile("" : "+s"(kp_)); *kp_; })
#else
#define LOAD_ARGS() (a_unused)
#endif
#define OPQ_TID() ({ int t_ = wave_idx * 64 + (int)__builtin_amdgcn_mbcnt_hi(~0u, __builtin_amdgcn_mbcnt_lo(~0u, 0u)); asm volatile("" : "+v"(t_)); t_; })
__global__ void __launch_bounds__(512, 2) mk_fwd(Args a_unused) {
    extern __shared__ __attribute__((aligned(16))) unsigned char lds_raw[];
    LAS unsigned char* lds = (LAS unsigned char*)lds_raw;
    cg::grid_group grid = cg::this_grid();
#define OPQ_S(x) ({ int s_ = (x); asm volatile("" : "+s"(s_)); s_; })
#ifndef LSEQ
#define LSEQ 0x87654321ull
#endif
    volatile LAS unsigned* xst = (volatile LAS unsigned*)(lds + LDS_BYTES - 512);
    if (threadIdx.x < 2) xst[threadIdx.x] = 0u;
    __syncthreads();
    const int wave_idx = __builtin_amdgcn_readfirstlane((int)(threadIdx.x >> 6));
    { const Args a = LOAD_ARGS(); (void)xcd_barrier_post((unsigned*)(a.ws + WS_CTL), xst, OPQ_TID() == 0); }
#define GRID_BARRIER() do { const Args ab_ = LOAD_ARGS(); XcdBarrier xb_; xb_.bar = (unsigned*)(ab_.ws + WS_CTL); xb_.x = xb_xcc_id(); xb_.st = (volatile LAS unsigned*)(lds + LDS_BYTES - 512); xcd_barrier(xb_, OPQ_TID() == 0); } while (0)
    { const Args a = LOAD_ARGS(); p0_prologue(lds, a, OPQ_TID(), OPQ_S(gridDim.x), 0); }
    { const Args a = LOAD_ARGS(); if (a.ph_lo == 0x7fffffff) grid.sync(); }
    GRID_BARRIER();
    { const Args a = LOAD_ARGS(); p0_prologue(lds, a, OPQ_TID(), OPQ_S(gridDim.x), 1); }
    { const Args a = LOAD_ARGS(); __syncthreads(); p1_norm<false>(lds, a, 0, a.in[0], OPQ_TID(), OPQ_S(gridDim.x)); }
    GRID_BARRIER();
    for (int layer = 0; layer < 2; ++layer) {
        for (unsigned long long sq = (layer == 0 ? (LSEQ >> 4) : LSEQ); sq != 0ull; sq >>= 4) {
            const int p = (int)(sq & 15ull);
            const Args a = LOAD_ARGS();
            const int G = OPQ_S(gridDim.x), bid = OPQ_S(blockIdx.x);
            unsigned char* ws = a.ws;
            bf16* proj = (bf16*)(ws + WS_PROJ); bf16* H = (bf16*)(ws + WS_H);
            bf16* Rg = proj + 8 * TS;
            const bf16* WinT = (const bf16*)(ws + WS_WIN) + (size_t)layer * WIN_L;
            if (p == 1) { if (layer == 0) p1_norm<false>(lds, a, layer, a.in[0], OPQ_TID(), G); else p1_norm<true>(lds, a, layer, a.out, OPQ_TID(), G); }
            else if (p == 2) {
                { pg8::Gemm<TP, 1024, 1024, T / 256, 13, 31, 0, 2 * (long long)TS> g{H, WinT + (size_t)2048 * 1024};
                  pg8::EpiProj E{proj, TP, 8}; pg8::gemm_phase(lds, g, G, bid, E, OPQ_TID()); }
                __syncthreads();
                { pg8::Gemm<512, 512, 512, T / 256, 8, 31, 0, 512, true> g{(const bf16*)((unsigned char*)a.out + (size_t)T * D * 2), (const bf16*)((const bf16*)(ws + WS_WIN) + (size_t)layer * WIN_L + (size_t)5376 * 1024)};
                  pg8::EpiProjI8 E{proj, (const float*)(ws + WS_SH), (const float*)(ws + WS_SW) + layer * 6144 + 4096};
                  const int half = G >> 1, nfirst = 5 * (G - half);
                  const bool split = (G == 256), hi = bid >= half;
                  pg8::gemm_phase(lds, g, split ? (hi ? G - half : half) : G, split ? (hi ? bid - half : bid) : bid, E, OPQ_TID(), (split && !hi) ? nfirst : 0, (split && hi) ? nfirst : -1); }
            }
            else if (p >= 3 && p <= 5) {
                LayerP P;
                P.sinks = a.in[6] + layer * 8; P.pool_scale = a.in[8] + layer * 512; P.conv_w = a.in[9] + layer * 4096; P.conv_b = a.in[10] + layer * 1024;
                P.a_log = a.in[12] + layer * 8; P.d_skip = a.in[13] + layer * 8; P.ssm_norm_w = a.in[14] + layer * 512;
                P.poolT = (const bf16*)(ws + WS_POOL) + (size_t)layer * 4 * 128 * 128;
                P.proj = proj; P.dt = (const float*)(ws + WS_DT); P.cd = (float*)(ws + WS_CD); P.st_ret = (bf16*)(ws + WS_EXT + ST_RET); P.st_ssd = (bf16*)(ws + WS_EXT + ST_SSD);
                const int tid = OPQ_TID();
                if (p == 3) {
                    const int nk = (3072 + G - 1) / G, rot = (bid * 5) % nk;
                    for (int k = 0; k < nk; ++k) { const int it = bid + G * ((k + rot) % nk); if (it >= 3072) continue;
                        int nxt = k + 1 < nk ? bid + G * ((k + 1 + rot) % nk) : -1; if (nxt >= 3072) nxt = -1;
                        if (it < 512) swa_unit(lds, P, it >> 6, (it >> 1) & 31, it & 1, tid, nxt);
                        else if (it < 1024) { const int q = it - 512; ssdU_unit(lds, P, q >> 6, (q >> 1) & 31, q & 1, tid, nxt); }
                        else if (it < 2048) { const int q = it - 1024; retU_unit(lds, P, q >> 7, (q >> 2) & 31, q & 3, tid, nxt); }
                        else { const int q = it - 2048; pool_unit(lds, P, q >> 2, q & 3, tid, nxt); }
                    }
                }
                else if (p == 4) scan_phase(P, bid * 512 + tid);
                else {
                    const int nk = (1536 + G - 1) / G, rot = (bid * 5) % nk;
                    for (int k = 0; k < nk; ++k) { const int it = bid + G * ((k + rot) % nk); if (it >= 1536) continue;
                        int nxt = k + 1 < nk ? bid + G * ((k + 1 + rot) % nk) : -1; if (nxt >= 1536) nxt = -1;
                        if (it < 512) ssdO_unit(lds, P, it >> 6, (it >> 1) & 31, it & 1, tid, nxt);
                        else { const int q = it - 512; retO_unit(lds, P, q >> 7, (q >> 2) & 31, q & 3, tid, nxt); }
                    }
                }
            }
            else if (p == 6) { pg8::Gemm<512, 512, 512, T / 256, 16, 31, 0, 512, true> g{(const bf16*)((unsigned char*)a.out + (size_t)T * D * 2), (const bf16*)(ws + WS_WMG8 + (size_t)layer * 4096 * 1024)};
                pg8::EpiGate E{Rg, (const float*)(ws + WS_SH), (const float*)(ws + WS_SW) + layer * 6144}; pg8::gemm_phase(lds, g, G, bid, E, OPQ_TID()); }
            else if (p == 7) { pg8::Gemm<TP, 2048, 2048, T / 256, 4, 31, 0, 2 * (long long)TS> g{proj, (const bf16*)(ws + WS_WUP) + (size_t)layer * 1024 * 2048};
                pg8::EpiMergeUp E{Rg, H}; pg8::gemm_phase(lds, g, G, bid, E, OPQ_TID()); }
            else if (p == 8) { pg8::Gemm<TP, 1024, 1024, T / 256, 4, 31, 0, 2 * (long long)TS> g{H, (const bf16*)(ws + WS_WOUT) + (size_t)layer * 1024 * 1024};
                const float* gate = (const float*)(ws + WS_MOD) + (size_t)layer * 8 * 3072 + 2048;
                if (layer == 0) { pg8::EpiOut<false> E{a.in[0], (bf16*)a.out, gate}; pg8::gemm_phase(lds, g, G, bid, E, OPQ_TID()); }
                else { pg8::EpiOut<true> E{a.out, proj, gate}; pg8::gemm_phase(lds, g, G, bid, E, OPQ_TID()); } }
            GRID_BARRIER();
        }
    }
    { const Args a = LOAD_ARGS(); p7_final(a, OPQ_TID(), OPQ_S(gridDim.x)); }
}
constexpr int N_PHASES = 1 + 2 * 8 + 1;

extern "C" void kernel_launch(void* const* d_in, const int* in_sizes, int n_in, void* d_out, int out_size, void* d_ws, size_t ws_size, hipStream_t stream) {
    static int grid = 0;
    if (grid == 0) {
        if (n_in != 18 || out_size != T * D || ws_size < WS_END) { fprintf(stderr, "kernel_launch: unexpected shapes (n_in %d out %d ws %zu); nothing launched\n", n_in, out_size, ws_size); grid = -1; return; }
        int dev = 0, cus = 0, per_cu = 0;
        if (hipGetDevice(&dev) != hipSuccess || hipDeviceGetAttribute(&cus, hipDeviceAttributeMultiprocessorCount, dev) != hipSuccess) { grid = -1; return; }
        if (hipFuncSetAttribute((const void*)mk_fwd, hipFuncAttributeMaxDynamicSharedMemorySize, LDS_BYTES) != hipSuccess) { fprintf(stderr, "kernel_launch: hipFuncSetAttribute failed\n"); grid = -1; return; }
        if (hipOccupancyMaxActiveBlocksPerMultiprocessor(&per_cu, (const void*)mk_fwd, 512, LDS_BYTES) != hipSuccess || per_cu < 1) { fprintf(stderr, "kernel_launch: occupancy query says %d\n", per_cu); per_cu = 1; }
        (void)hipGetLastError();
        grid = cus;
    }
    if (grid < 0) return;
    if (hipMemsetAsync((char*)d_ws + WS_CTL, 0, CTL_BYTES, stream) != hipSuccess) { fprintf(stderr, "kernel_launch: memset failed\n"); return; }
    Args a{};
    for (int i = 0; i < 18; ++i) a.in[i] = (const float*)d_in[i];
    a.out = (float*)d_out; a.ws = (unsigned char*)d_ws; a.ph_lo = 0; a.ph_hi = N_PHASES;
    void* args[] = {&a};
    hipError_t e = hipLaunchCooperativeKernel((void*)mk_fwd, dim3(grid), dim3(512), args, LDS_BYTES, stream);
    if (e != hipSuccess) fprintf(stderr, "cooperative launch failed: %s (grid %d)\n", hipGetErrorString(e), grid);
}
```
